# Optimizing an MI355X kernel written in HIP

```python
import math
import jax, jax.numpy as jnp
from jax import lax
import numpy as np

D_MODEL = 1024
BATCH = 16
SEQ = 2048
DEPTH = 2
DEC_BATCH = 128
DEC_SEQ = 8
PAST_LEN = 16384
PAGE_SIZE = 128

N_A_LAYERS = DEPTH // 2
N_B_LAYERS = DEPTH - N_A_LAYERS
A_HEADS = 8
A_DK = 128
A_DV = 128
A_KD = A_HEADS * A_DK
A_VD = A_HEADS * A_DV
A_CONV_CH = 2 * A_KD + A_VD
A_IN = A_CONV_CH + A_VD + 2 * A_HEADS
CONV_W = 4
CHUNK = 64
B_Q_HEADS = 16
B_KV_HEADS = 4
B_HEAD_DIM = 64
B_GROUP = B_Q_HEADS // B_KV_HEADS
WINDOW = 128
FFN_HIDDEN = -(-8 * D_MODEL // (3 * 256)) * 256
PLE_DIM = 256
EPS = 1e-6
L2_EPS = 1e-6
NEG_INF = -1e30

kernel_name = 'yoco_gated_delta_swa_sink_step'


def rmsnorm(x, g):
    x32 = x.astype(jnp.float32)
    y = x32 * lax.rsqrt(jnp.mean(x32 * x32, axis=-1, keepdims=True) + EPS)
    return (y * g.astype(jnp.float32)).astype(x.dtype)


def l2norm(x):
    x32 = x.astype(jnp.float32)
    return x32 * lax.rsqrt(jnp.sum(x32 * x32, axis=-1, keepdims=True) + L2_EPS)


def chunk_gated_delta(q, k, v, g, beta, s0):
    bsz, seqlen, nh, _ = q.shape
    dv = v.shape[-1]
    c = min(CHUNK, seqlen)
    n = -(-seqlen // c)
    pad = n * c - seqlen

    def prep(t):
        t = jnp.swapaxes(t, 1, 2)
        widths = [(0, 0)] * t.ndim
        widths[2] = (0, pad)
        t = jnp.pad(t, widths)
        return t.reshape(t.shape[:2] + (n, c) + t.shape[3:])

    q, k, v, g, beta = [prep(t) for t in (q, k, v, g, beta)]
    gc = jnp.cumsum(g, axis=-1)
    idx = jnp.arange(c)
    incl = idx[:, None] >= idx[None, :]
    strict = idx[:, None] > idx[None, :]
    diff = gc[..., :, None] - gc[..., None, :]
    decay = jnp.where(incl, jnp.exp(jnp.where(incl, diff, 0.0)), 0.0)
    kb = k * beta[..., None]
    a_mat = jnp.where(strict, jnp.einsum('bhnid,bhnjd->bhnij', kb, k) * decay, 0.0)
    eye = jnp.eye(c, dtype=jnp.float32)
    rhs = jnp.concatenate([v * beta[..., None], kb * jnp.exp(gc)[..., None]], axis=-1)
    sol = lax.linalg.triangular_solve(a_mat + eye, rhs, left_side=True, lower=True, unit_diagonal=True)
    u_base, w_dec = sol[..., :dv], sol[..., dv:]
    qk = jnp.where(incl, jnp.einsum('bhnid,bhnjd->bhnij', q, k) * decay, 0.0)
    q_dec = q * jnp.exp(gc)[..., None]
    k_dec = k * jnp.exp(gc[..., -1:] - gc)[..., None]
    g_last = jnp.exp(gc[..., -1])
    xs = tuple(jnp.moveaxis(t, 2, 0) for t in (u_base, w_dec, qk, q_dec, k_dec, g_last))

    def step(s, inp):
        ub, wd, qkc, qd, kd, gl = inp
        u = ub - jnp.einsum('bhck,bhkv->bhcv', wd, s)
        o = jnp.einsum('bhck,bhkv->bhcv', qd, s) + jnp.einsum('bhij,bhjv->bhiv', qkc, u)
        s = s * gl[..., None, None] + jnp.einsum('bhck,bhcv->bhkv', kd, u)
        return s, o

    s_fin, o = lax.scan(step, s0, xs)
    o = jnp.moveaxis(o, 0, 2).reshape(bsz, nh, n * c, dv)[:, :, :seqlen]
    return jnp.swapaxes(o, 1, 2), s_fin


def gated_delta_mixer(h, s0, conv_buf, norm_g, w_in, conv_w, a_log, dt_bias, out_g, w_out):
    bsz, seqlen, _ = h.shape
    proj = rmsnorm(h, norm_g) @ w_in
    qkv, z, a, b = jnp.split(proj, [A_CONV_CH, A_CONV_CH + A_VD, A_CONV_CH + A_VD + A_HEADS], axis=-1)
    full = jnp.concatenate([conv_buf.astype(qkv.dtype), qkv], axis=1)
    conv = full[:, 0:seqlen] * conv_w[0]
    for w in range(1, CONV_W):
        conv = conv + full[:, w:w + seqlen] * conv_w[w]
    new_buf = full[:, seqlen:]
    qkv = jax.nn.silu(conv)
    q, k, v = jnp.split(qkv, [A_KD, 2 * A_KD], axis=-1)
    q = l2norm(q.reshape(bsz, seqlen, A_HEADS, A_DK)) * (A_DK ** -0.5)
    k = l2norm(k.reshape(bsz, seqlen, A_HEADS, A_DK))
    v = v.reshape(bsz, seqlen, A_HEADS, A_DV).astype(jnp.float32)
    beta = jax.nn.sigmoid(b.astype(jnp.float32))
    g = -jnp.exp(a_log.astype(jnp.float32)) * jax.nn.softplus(a.astype(jnp.float32) + dt_bias.astype(jnp.float32))
    o, s_new = chunk_gated_delta(q, k, v, g, beta, s0.astype(jnp.float32))
    zf = jax.nn.silu(z.reshape(bsz, seqlen, A_HEADS, A_DV).astype(jnp.float32))
    o = o * lax.rsqrt(jnp.mean(o * o, axis=-1, keepdims=True) + EPS) * out_g.astype(jnp.float32) * zf
    out = o.reshape(bsz, seqlen, A_VD).astype(h.dtype) @ w_out
    return out, s_new.astype(s0.dtype), new_buf.astype(conv_buf.dtype)


def sink_attention(q, k, v, mask, sinks):
    s = jnp.einsum('...qhgd,...khd->...hgqk', q, k).astype(jnp.float32)
    s = jnp.where(mask, s, NEG_INF)
    sk = sinks.astype(jnp.float32).reshape(B_KV_HEADS, B_GROUP, 1, 1)
    m = jnp.maximum(jnp.max(s, axis=-1, keepdims=True), sk)
    p = jnp.exp(s - m)
    prob = p / (jnp.sum(p, axis=-1, keepdims=True) + jnp.exp(sk - m))
    return jnp.einsum('...hgqk,...khd->...qhgd', prob.astype(v.dtype), v)


def window_attention_prompt(q, k, v, sinks):
    bsz, seqlen = q.shape[:2]
    nb = seqlen // WINDOW
    qb = q.reshape(bsz, nb, WINDOW, B_KV_HEADS, B_GROUP, B_HEAD_DIM)

    def band(t):
        tb = t.reshape(bsz, nb, WINDOW, B_KV_HEADS, B_HEAD_DIM)
        prev = jnp.pad(tb[:, :-1], ((0, 0), (1, 0), (0, 0), (0, 0), (0, 0)))
        return jnp.concatenate([prev, tb], axis=2)

    qi = jnp.arange(WINDOW)[:, None]
    ki = jnp.arange(2 * WINDOW)[None, :]
    rel = qi + WINDOW - ki
    kpos = (jnp.arange(nb)[:, None, None] - 1) * WINDOW + ki
    mask = (rel >= 0) & (rel < WINDOW) & (kpos >= 0)
    o = sink_attention(qb, band(k), band(v), mask[:, None, None], sinks)
    return o.reshape(bsz, seqlen, B_Q_HEADS * B_HEAD_DIM)


def window_attention_sample(q, k_new, v_new, k_buf, v_buf, sinks):
    bsz, t = q.shape[:2]
    nbuf = k_buf.shape[1]
    kk = jnp.concatenate([k_buf.astype(k_new.dtype), k_new], axis=1)
    vv = jnp.concatenate([v_buf.astype(v_new.dtype), v_new], axis=1)
    qpos = PAST_LEN + jnp.arange(t)
    kpos = jnp.concatenate([PAST_LEN - nbuf + jnp.arange(nbuf), PAST_LEN + jnp.arange(t)])
    rel = qpos[:, None] - kpos[None, :]
    mask = (rel >= 0) & (rel < WINDOW)
    o = sink_attention(q, kk, vv, mask, sinks)
    return o.reshape(bsz, t, B_Q_HEADS * B_HEAD_DIM)


def swiglu(h, g, w_gu, w_down):
    gt, up = jnp.split(rmsnorm(h, g) @ w_gu, 2, axis=-1)
    return (jax.nn.silu(gt) * up) @ w_down


def ple_term(h, pe, g, w_proj, w_gate):
    gate = jax.nn.sigmoid(rmsnorm(h, g) @ w_gate)
    return (pe.astype(h.dtype) @ w_proj) * gate


def run_trunk(x, pe, s_init, c_init, k_buf, v_buf, win_buf, prm):
    bsz, seqlen, _ = x.shape
    h = x
    s_out, c_out = [], []
    k_sh = None
    v_sh = None
    for i in range(DEPTH):
        if i < N_A_LAYERS:
            mix, s_new, c_new = gated_delta_mixer(
                h, s_init[i], c_init[i], prm['a_norm'][i], prm['a_w_in'][i], prm['a_conv_w'][i],
                prm['a_a_log'][i], prm['a_dt_bias'][i], prm['a_out_norm'][i], prm['a_w_out'][i])
            s_out.append(s_new)
            c_out.append(c_new)
        else:
            if i == N_A_LAYERS:
                kv = (rmsnorm(h, prm['kv_norm']) @ prm['kv_w']).reshape(bsz, seqlen, 2, B_KV_HEADS, B_HEAD_DIM)
                k_sh = kv[:, :, 0]
                v_sh = kv[:, :, 1]
            j = i - N_A_LAYERS
            q = (rmsnorm(h, prm['b_norm'][j]) @ prm['b_w_q'][j]).reshape(
                bsz, seqlen, B_KV_HEADS, B_GROUP, B_HEAD_DIM) * (B_HEAD_DIM ** -0.5)
            if k_buf is None:
                o = window_attention_prompt(q, k_sh, v_sh, prm['b_sinks'][j])
            else:
                o = window_attention_sample(q, k_sh, v_sh, k_buf, v_buf, prm['b_sinks'][j])
            mix = o @ prm['b_w_o'][j]
        h = h + mix
        h = h + swiglu(h, prm['ffn_norm'][i], prm['ffn_w_gu'][i], prm['ffn_w_down'][i])
        h = h + ple_term(h, pe[i], prm['ple_norm'][i], prm['ple_w_proj'][i], prm['ple_w_gate'][i])
    y = rmsnorm(h, prm['final_norm'])
    if k_buf is None:
        k_win = k_sh[:, -win_buf:]
        v_win = v_sh[:, -win_buf:]
    else:
        k_win = jnp.concatenate([k_buf.astype(k_sh.dtype), k_sh], axis=1)[:, -win_buf:]
        v_win = jnp.concatenate([v_buf.astype(v_sh.dtype), v_sh], axis=1)[:, -win_buf:]
    return y, jnp.stack(s_out), jnp.stack(c_out), k_win, v_win


def setup_inputs(seed: int = 0) -> dict:
    key = jax.random.key(seed)
    ks = jax.random.split(key, 32)
    D = D_MODEL
    win_buf = min(WINDOW, PAST_LEN)

    def nrm(i, shape, scale):
        return jax.random.normal(ks[i], shape, jnp.float32) * scale

    def gain(i, shape):
        return 1.0 + nrm(i, shape, 0.02)

    dt = jnp.exp(jax.random.uniform(ks[22], (N_A_LAYERS, A_HEADS), jnp.float32,
                                    minval=math.log(1e-3), maxval=math.log(1e-1)))
    return {
        'x_prompt': nrm(0, (BATCH, SEQ, D), 1.0),
        'x_sample': nrm(1, (DEC_BATCH, DEC_SEQ, D), 1.0),
        'state_delta': nrm(2, (N_A_LAYERS, DEC_BATCH, A_HEADS, A_DK, A_DV), 0.1),
        'state_conv': nrm(3, (N_A_LAYERS, DEC_BATCH, CONV_W - 1, A_CONV_CH), 1.0),
        'cache_k_win': nrm(4, (DEC_BATCH, win_buf, B_KV_HEADS, B_HEAD_DIM), 1.0),
        'cache_v_win': nrm(5, (DEC_BATCH, win_buf, B_KV_HEADS, B_HEAD_DIM), 1.0),
        'p_prompt': nrm(6, (DEPTH, BATCH, SEQ, PLE_DIM), 1.0),
        'p_sample': nrm(7, (DEPTH, DEC_BATCH, DEC_SEQ, PLE_DIM), 1.0),
        'a_norm': gain(8, (N_A_LAYERS, D)),
        'a_w_in': nrm(9, (N_A_LAYERS, D, A_IN), D ** -0.5),
        'a_conv_w': nrm(10, (N_A_LAYERS, CONV_W, A_CONV_CH), CONV_W ** -0.5),
        'a_a_log': jnp.log(jax.random.uniform(ks[11], (N_A_LAYERS, A_HEADS), jnp.float32, minval=1.0, maxval=16.0)),
        'a_dt_bias': dt + jnp.log(-jnp.expm1(-dt)),
        'a_out_norm': gain(12, (N_A_LAYERS, A_DV)),
        'a_w_out': nrm(13, (N_A_LAYERS, A_VD, D), A_VD ** -0.5),
        'kv_norm': gain(14, (D,)),
        'kv_w': nrm(15, (D, 2 * B_KV_HEADS * B_HEAD_DIM), D ** -0.5),
        'b_norm': gain(16, (N_B_LAYERS, D)),
        'b_w_q': nrm(17, (N_B_LAYERS, D, B_Q_HEADS * B_HEAD_DIM), D ** -0.5),
        'b_sinks': nrm(18, (N_B_LAYERS, B_Q_HEADS), 1.0),
        'b_w_o': nrm(19, (N_B_LAYERS, B_Q_HEADS * B_HEAD_DIM, D), (B_Q_HEADS * B_HEAD_DIM) ** -0.5),
        'ffn_norm': gain(20, (DEPTH, D)),
        'ffn_w_gu': nrm(21, (DEPTH, D, 2 * FFN_HIDDEN), D ** -0.5),
        'ffn_w_down': nrm(23, (DEPTH, FFN_HIDDEN, D), FFN_HIDDEN ** -0.5),
        'ple_norm': gain(24, (DEPTH, D)),
        'ple_w_proj': nrm(25, (DEPTH, PLE_DIM, D), PLE_DIM ** -0.5),
        'ple_w_gate': nrm(26, (DEPTH, D, D), D ** -0.5),
        'final_norm': gain(27, (D,)),
    }


def reference(x_prompt, x_sample, state_delta, state_conv, cache_k_win, cache_v_win, p_prompt, p_sample,
              a_norm, a_w_in, a_conv_w, a_a_log, a_dt_bias, a_out_norm, a_w_out,
              kv_norm, kv_w, b_norm, b_w_q, b_sinks, b_w_o,
              ffn_norm, ffn_w_gu, ffn_w_down, ple_norm, ple_w_proj, ple_w_gate, final_norm):
    prm = {
        'a_norm': a_norm, 'a_w_in': a_w_in, 'a_conv_w': a_conv_w, 'a_a_log': a_a_log,
        'a_dt_bias': a_dt_bias, 'a_out_norm': a_out_norm, 'a_w_out': a_w_out,
        'kv_norm': kv_norm, 'kv_w': kv_w, 'b_norm': b_norm, 'b_w_q': b_w_q,
        'b_sinks': b_sinks, 'b_w_o': b_w_o, 'ffn_norm': ffn_norm, 'ffn_w_gu': ffn_w_gu,
        'ffn_w_down': ffn_w_down, 'ple_norm': ple_norm, 'ple_w_proj': ple_w_proj,
        'ple_w_gate': ple_w_gate, 'final_norm': final_norm,
    }
    win_buf = cache_k_win.shape[1]
    bsz = x_prompt.shape[0]
    s0 = jnp.zeros((N_A_LAYERS, bsz, A_HEADS, A_DK, A_DV), jnp.float32)
    c0 = jnp.zeros((N_A_LAYERS, bsz, CONV_W - 1, A_CONV_CH), x_prompt.dtype)
    y_prompt, sd_p, sc_p, kw_p, vw_p = run_trunk(x_prompt, p_prompt, s0, c0, None, None, win_buf, prm)
    y_sample, sd_s, sc_s, kw_s, vw_s = run_trunk(x_sample, p_sample, state_delta, state_conv,
                                                 cache_k_win, cache_v_win, win_buf, prm)
    return (y_prompt, y_sample, sd_p, sd_s, sc_p, sc_s, kw_p, kw_s, vw_p, vw_s)
```

```cpp
#include <hip/hip_runtime.h>
#include <cstdio>
#include <cstdint>
namespace pg8 {
#define PG8_LAS __attribute__((address_space(3)))
typedef unsigned short bf16_t;
typedef short bf16x8 __attribute__((ext_vector_type(8)));
typedef float f32x4 __attribute__((ext_vector_type(4)));
typedef unsigned u32x4 __attribute__((ext_vector_type(4)));
constexpr int BM = 256, BK = 64, HALF = 128, HTB = HALF * BK * 2  , STAGE_BYTES = 8 * HTB, NXCD = 8, WGM = 8;

__host__ __device__ __forceinline__ int lds_byte(int r, int c) { const int st = (r >> 4) * 2 + (c >> 5), rr = r & 15, cc = c & 31, ob = rr * 64 + cc * 2; return st * 1024 + (ob ^ (((ob >> 9) & 1) << 5)); }
__host__ __device__ __forceinline__ void stage_rc(int b, int& R, int& C) { const int st = b / 1024, sb = b % 1024, swz = sb ^ (((sb >> 9) & 1) << 5); R = (st >> 1) * 16 + swz / 64; C = (st & 1) * 32 + (swz % 64) / 2; }
__host__ __device__ __forceinline__ int perm32(int rho) { const int n = rho >> 4, i = rho & 15; return 8 * (i >> 2) + 4 * n + (i & 3); }

struct Unit { int pm, pn; };
struct Gemm { const bf16_t* A; const bf16_t* Bt; int M, N, K; };

struct StaticOrder {
    int nM, nN, nwg, G, c;
    __host__ __device__ void init(int M, int N, int G_, int c_) { nM = M / BM; nN = N / BM; nwg = nM * nN; G = G_; c = c_; }
    __host__ __device__ bool next(int i, Unit& u) const {
        const long L = (long)i * G + c; if (L >= nwg) return false;
        int wgid = (int)L; { const int q = nwg / NXCD, r = nwg % NXCD, xcd = wgid % NXCD, off = wgid / NXCD; wgid = (xcd < r ? xcd * (q + 1) : r * (q + 1) + (xcd - r) * q) + off; }
        const int nig = WGM * nN, gid = wgid / nig, fm = gid * WGM, gsz = (nM - fm) < WGM ? (nM - fm) : WGM;
        u.pm = fm + ((wgid % nig) % gsz); u.pn = (wgid % nig) / gsz; return true;
    }
    __device__ __forceinline__ void a_ready(const Unit&) const {}
    __device__ __forceinline__ void done(const Unit&) const {}
};

__device__ __forceinline__ unsigned cvt_pk_bf16(float lo, float hi) { unsigned r; asm volatile("v_cvt_pk_bf16_f32 %0, %1, %2" : "=v"(r) : "v"(lo), "v"(hi)); return r; }
__device__ __forceinline__ f32x4 bf_lo2(unsigned a, unsigned b) { return (f32x4){__uint_as_float(a << 16), __uint_as_float(a & 0xffff0000u), __uint_as_float(b << 16), __uint_as_float(b & 0xffff0000u)}; }
__device__ __forceinline__ u32x4 pack8(const f32x4 v0, const f32x4 v1) { u32x4 w; w.x = cvt_pk_bf16(v0[0], v0[1]); w.y = cvt_pk_bf16(v0[2], v0[3]); w.z = cvt_pk_bf16(v1[0], v1[1]); w.w = cvt_pk_bf16(v1[2], v1[3]); return w; }
__device__ __forceinline__ float dot4(const f32x4 a) { return (a[0] * a[0] + a[1] * a[1]) + (a[2] * a[2] + a[3] * a[3]); }
__device__ __forceinline__ float row_rstd(const float* ssq, int r, int fq) {
    const f32x4 p = *(const f32x4*)(ssq + (size_t)r * 16 + 4 * fq);
    float s = (p[0] + p[1]) + (p[2] + p[3]);
    s += __shfl_xor(s, 16); s += __shfl_xor(s, 32);
    return rsqrtf(s * (1.0f / 1024.0f) + 1e-6f);
}
__device__ __forceinline__ float sigmoidf_(float x) { return __builtin_amdgcn_rcpf(1.0f + __expf(-x)); }

constexpr int MP_ROWS = 32768;

struct EpiQKV {
    static constexpr bool PERM = true, AFTER_DRAIN = false;
    bf16_t* QKV; bf16_t* Z; float* AB; const float* ssq; float* sc_p; float* sc_s;
    __device__ __forceinline__ void operator()(const f32x4 (&acc)[2][2][4][2], const Unit& u, int wr, int wc, int fr, int fq) const {
        const int row0 = u.pm * BM + wr * 64 + fr, colt = u.pn * BM + wc * 32 + 8 * fq;
#pragma unroll
        for (int ai = 0; ai < 2; ++ai)
#pragma unroll
            for (int m = 0; m < 4; ++m) {
                const int r = row0 + ai * HALF + m * 16; const float rs = row_rstd(ssq, r, fq);
#pragma unroll
                for (int bj = 0; bj < 2; ++bj) {
                    const int col = colt + bj * HALF; const f32x4 v0 = acc[ai][bj][m][0] * rs, v1 = acc[ai][bj][m][1] * rs;
                    if (u.pn < 12) {
                        *(u32x4*)(QKV + (size_t)r * 3072 + col) = pack8(v0, v1);
                        if (r < MP_ROWS) { const int s = r & 2047; if (s >= 2045) { float* o = sc_p + ((size_t)((r >> 11) * 3 + (s - 2045))) * 3072 + col; *(f32x4*)o = v0; *(f32x4*)(o + 4) = v1; } }
                        else { const int rr = r - MP_ROWS, t = rr & 7; if (t >= 5) { float* o = sc_s + ((size_t)((rr >> 3) * 3 + (t - 5))) * 3072 + col; *(f32x4*)o = v0; *(f32x4*)(o + 4) = v1; } }
                    } else if (u.pn < 16) {
                        *(u32x4*)(Z + (size_t)r * 1024 + (col - 3072)) = pack8(v0, v1);
                    } else {
                        const int c = col - 4096; if (c < 16) { float* o = AB + (size_t)r * 16 + c; *(f32x4*)o = v0; *(f32x4*)(o + 4) = v1; }
                    }
                }
            }
    }
};
template <bool BASEF32> struct EpiRes {
    static constexpr bool PERM = true, AFTER_DRAIN = false;
    const float* xp; const float* xs; const bf16_t* hb; bf16_t* out; float* ssq_out;
    __device__ __forceinline__ void operator()(const f32x4 (&acc)[2][2][4][2], const Unit& u, int wr, int wc, int fr, int fq) const {
        const int row0 = u.pm * BM + wr * 64 + fr, colt = u.pn * BM + wc * 32 + 8 * fq;
#pragma unroll
        for (int ai = 0; ai < 2; ++ai)
#pragma unroll
            for (int m = 0; m < 4; ++m) {
                const int r = row0 + ai * HALF + m * 16; float q = 0.f;
#pragma unroll
                for (int bj = 0; bj < 2; ++bj) {
                    const int col = colt + bj * HALF; f32x4 b0, b1;
                    if (BASEF32) { const float* p = (r < MP_ROWS ? xp + (size_t)r * 1024 : xs + (size_t)(r - MP_ROWS) * 1024) + col; b0 = *(const f32x4*)p; b1 = *(const f32x4*)(p + 4); }
                    else { const u32x4 w = *(const u32x4*)(hb + (size_t)r * 1024 + col); b0 = bf_lo2(w.x, w.y); b1 = bf_lo2(w.z, w.w); }
                    const f32x4 v0 = acc[ai][bj][m][0] + b0, v1 = acc[ai][bj][m][1] + b1;
                    q += dot4(v0) + dot4(v1);
                    *(u32x4*)(out + (size_t)r * 1024 + col) = pack8(v0, v1);
                }
                q += __shfl_xor(q, 16); q += __shfl_xor(q, 32);
                if (fq == 0) ssq_out[(size_t)r * 16 + u.pn * 4 + wc] = q;
            }
    }
};
struct EpiGU {
    static constexpr bool PERM = true, AFTER_DRAIN = false;
    bf16_t* act; const float* ssq;
    __device__ __forceinline__ void operator()(const f32x4 (&acc)[2][2][4][2], const Unit& u, int wr, int wc, int fr, int fq) const {
        const int row0 = u.pm * BM + wr * 64 + fr, col = u.pn * HALF + wc * 32 + 8 * fq;
#pragma unroll
        for (int ai = 0; ai < 2; ++ai)
#pragma unroll
            for (int m = 0; m < 4; ++m) {
                const int r = row0 + ai * HALF + m * 16; const float rs = row_rstd(ssq, r, fq);
                f32x4 o[2];
#pragma unroll
                for (int n = 0; n < 2; ++n) {
                    const f32x4 g = acc[ai][0][m][n] * rs, up = acc[ai][1][m][n] * rs;
#pragma unroll
                    for (int j = 0; j < 4; ++j) o[n][j] = g[j] * sigmoidf_(g[j]) * up[j];
                }
                *(u32x4*)(act + (size_t)r * 2816 + col) = pack8(o[0], o[1]);
            }
    }
};
struct EpiPP {
    static constexpr bool PERM = true, AFTER_DRAIN = false;
    bf16_t* out;
    __device__ __forceinline__ void operator()(const f32x4 (&acc)[2][2][4][2], const Unit& u, int wr, int wc, int fr, int fq) const {
        const int row0 = u.pm * BM + wr * 64 + fr, colt = u.pn * BM + wc * 32 + 8 * fq;
#pragma unroll
        for (int ai = 0; ai < 2; ++ai)
#pragma unroll
            for (int m = 0; m < 4; ++m) {
                const int r = row0 + ai * HALF + m * 16;
#pragma unroll
                for (int bj = 0; bj < 2; ++bj) *(u32x4*)(out + (size_t)r * 1024 + colt + bj * HALF) = pack8(acc[ai][bj][m][0], acc[ai][bj][m][1]);
            }
    }
};
template <bool FINAL> struct EpiGate {
    static constexpr bool PERM = true, AFTER_DRAIN = false;
    const float* ssq_in; const bf16_t* pp; const bf16_t* hb; bf16_t* out; float* ssq_out; float* y;
    __device__ __forceinline__ void operator()(const f32x4 (&acc)[2][2][4][2], const Unit& u, int wr, int wc, int fr, int fq) const {
        const int row0 = u.pm * BM + wr * 64 + fr, colt = u.pn * BM + wc * 32 + 8 * fq;
#pragma unroll
        for (int ai = 0; ai < 2; ++ai)
#pragma unroll
            for (int m = 0; m < 4; ++m) {
                const int r = row0 + ai * HALF + m * 16; const float rs = row_rstd(ssq_in, r, fq); float q = 0.f;
#pragma unroll
                for (int bj = 0; bj < 2; ++bj) {
                    const int col = colt + bj * HALF;
                    const u32x4 wp = *(const u32x4*)(pp + (size_t)r * 1024 + col), wh = *(const u32x4*)(hb + (size_t)r * 1024 + col);
                    const f32x4 p0 = bf_lo2(wp.x, wp.y), p1 = bf_lo2(wp.z, wp.w), h0 = bf_lo2(wh.x, wh.y), h1 = bf_lo2(wh.z, wh.w);
                    f32x4 v0, v1;
#pragma unroll
                    for (int j = 0; j < 4; ++j) { v0[j] = h0[j] + p0[j] * sigmoidf_(acc[ai][bj][m][0][j] * rs); v1[j] = h1[j] + p1[j] * sigmoidf_(acc[ai][bj][m][1][j] * rs); }
                    if (FINAL) { float* o = y + (size_t)r * 1024 + col; *(f32x4*)o = v0; *(f32x4*)(o + 4) = v1; }
                    else { q += dot4(v0) + dot4(v1); *(u32x4*)(out + (size_t)r * 1024 + col) = pack8(v0, v1); }
                }
                if (!FINAL) { q += __shfl_xor(q, 16); q += __shfl_xor(q, 32); if (fq == 0) ssq_out[(size_t)r * 16 + u.pn * 4 + wc] = q; }
            }
    }
};
struct EpiKVQ {
    static constexpr bool PERM = true, AFTER_DRAIN = false;
    bf16_t* KV; bf16_t* Q; const float* ssq; float* kw_p; float* vw_p; float* kw_s; float* vw_s;
    __device__ __forceinline__ void operator()(const f32x4 (&acc)[2][2][4][2], const Unit& u, int wr, int wc, int fr, int fq) const {
        const int row0 = u.pm * BM + wr * 64 + fr, colt = u.pn * BM + wc * 32 + 8 * fq;
        const bool iskv = u.pn < 2;
        float* const cp = (u.pn == 0) ? kw_p : vw_p; float* const cs = (u.pn == 0) ? kw_s : vw_s;
        const int ccol = wc * 32 + 8 * fq;
#pragma unroll
        for (int ai = 0; ai < 2; ++ai)
#pragma unroll
            for (int m = 0; m < 4; ++m) {
                const int r = row0 + ai * HALF + m * 16; const float rs = row_rstd(ssq, r, fq);
                if (iskv) {
                    long crow = -1;
                    if (r < MP_ROWS) { const int s = r & 2047; if (s >= 1920) crow = (long)(r >> 11) * 128 + (s - 1920); }
                    else { const int rr = r - MP_ROWS; crow = (long)(rr >> 3) * 128 + 120 + (rr & 7); }
                    float* const cbase = (r < MP_ROWS) ? cp : cs;
#pragma unroll
                    for (int bj = 0; bj < 2; ++bj) {
                        const f32x4 v0 = acc[ai][bj][m][0] * rs, v1 = acc[ai][bj][m][1] * rs;
                        *(u32x4*)(KV + (size_t)r * 512 + colt + bj * HALF) = pack8(v0, v1);
                        if (crow >= 0) { float* o = cbase + (size_t)crow * 256 + ccol + bj * HALF; *(f32x4*)o = v0; *(f32x4*)(o + 4) = v1; }
                    }
                } else {
                    const float sc = rs * 0.125f;
#pragma unroll
                    for (int bj = 0; bj < 2; ++bj)
                        *(u32x4*)(Q + (size_t)r * 1024 + (colt - 512) + bj * HALF) = pack8(acc[ai][bj][m][0] * sc, acc[ai][bj][m][1] * sc);
                }
            }
    }
};
template <class Epi, class Sched, bool ALIGN_EPI = false, bool SP2 = false>
__device__ __forceinline__ void gemm_phase(PG8_LAS unsigned char* lds, const Gemm g, const Sched& S, const Epi& E) {
    const int tid = threadIdx.x, wid = __builtin_amdgcn_readfirstlane(tid >> 6), lane = tid & 63, wr = wid >> 2, wc = wid & 3, fr = lane & 15, fq = lane >> 4;
    const int K = g.K, nt = K / BK;
    unsigned voffA[2], voffB[2];
#pragma unroll
    for (int i = 0; i < 2; ++i) { int R, C; stage_rc(tid * 16 + i * 8192, R, C); const int Rb = Epi::PERM ? ((R & ~31) + perm32(R & 31)) : R;
        voffA[i] = (unsigned)(R * K + C) * 2u; voffB[i] = (unsigned)(Rb * K + C) * 2u; }
    const size_t kstep = (size_t)(BK * 2);
    const size_t hstep = (size_t)HALF * K * 2;
    const size_t tstep = 2 * hstep;
    const unsigned ldsw = (unsigned)wid * 1024u;
    const int aoff = lds_byte(wr * 64 + fr, fq * 8), boff = lds_byte(wc * 32 + fr, fq * 8);
#define PG8_SA(b, h) (((b) * 2 + (h)) * HTB)
#define PG8_SB(b, h) ((4 + (b) * 2 + (h)) * HTB)
#define PG8_STAGE(bufoff, gbase, voff) do { _Pragma("unroll") for (int _i = 0; _i < 2; ++_i) \
        __builtin_amdgcn_global_load_lds((const unsigned*)((const char*)(gbase) + (voff)[_i]), (PG8_LAS unsigned*)(lds + (bufoff) + ldsw + _i * 8192), 16, 0, 0); } while (0)
#define PG8_LDA(dst, b, h) do { _Pragma("unroll") for (int m = 0; m < 4; ++m) _Pragma("unroll") for (int k = 0; k < 2; ++k) dst[m][k] = *(const PG8_LAS bf16x8*)(lds + PG8_SA(b, h) + aoff + m * 2048 + k * 1024); } while (0)
#define PG8_LDB(dst, b, h) do { _Pragma("unroll") for (int n = 0; n < 2; ++n) _Pragma("unroll") for (int k = 0; k < 2; ++k) dst[n][k] = *(const PG8_LAS bf16x8*)(lds + PG8_SB(b, h) + boff + n * 2048 + k * 1024); } while (0)
#define PG8_MMA(ai, bj, At, Bt) do { __builtin_amdgcn_s_setprio(1); _Pragma("unroll") for (int m = 0; m < 4; ++m) _Pragma("unroll") for (int n = 0; n < 2; ++n) _Pragma("unroll") for (int k = 0; k < 2; ++k) \
        acc[ai][bj][m][n] = __builtin_amdgcn_mfma_f32_16x16x32_bf16(Bt[n][k], At[m][k], acc[ai][bj][m][n], 0, 0, 0); __builtin_amdgcn_s_setprio(0); } while (0)
#define PG8_WAIT_V(n) asm volatile("s_waitcnt vmcnt(" #n ")" ::: "memory")
#define PG8_WAIT_L(n) asm volatile("s_waitcnt lgkmcnt(" #n ")" ::: "memory")
#define PG8_BAR __builtin_amdgcn_s_barrier()
#define PG8_SCHED __builtin_amdgcn_sched_barrier(0)
    Unit cur, nxt; int ui = 0;
    if (!S.next(0, cur)) return;
    f32x4 acc[2][2][4][2];
#pragma unroll
    for (int a = 0; a < 2; ++a)
#pragma unroll
        for (int b = 0; b < 2; ++b)
#pragma unroll
            for (int m = 0; m < 4; ++m)
#pragma unroll
                for (int n = 0; n < 2; ++n) acc[a][b][m][n] = (f32x4){0.f, 0.f, 0.f, 0.f};
    bf16x8 At[4][2], B0[2][2], B1[2][2];
    const char* cA = (const char*)g.A + (size_t)cur.pm * tstep; const char* cB = (const char*)g.Bt + (size_t)cur.pn * tstep;
    S.a_ready(cur);
    if constexpr (SP2) {
        PG8_STAGE(PG8_SB(0, 0), cB, voffB); PG8_STAGE(PG8_SB(0, 1), cB + hstep, voffB); PG8_STAGE(PG8_SA(0, 0), cA, voffA); PG8_STAGE(PG8_SA(0, 1), cA + hstep, voffA);
        if (wr == 1) PG8_BAR;
        PG8_WAIT_V(2); PG8_BAR;
        PG8_STAGE(PG8_SB(1, 0), cB + kstep, voffB); PG8_STAGE(PG8_SA(1, 0), cA + kstep, voffA); PG8_STAGE(PG8_SB(1, 1), cB + hstep + kstep, voffB);
        PG8_WAIT_V(6); PG8_BAR;
    } else {
        PG8_STAGE(PG8_SB(0, 0), cB, voffB); PG8_STAGE(PG8_SA(0, 0), cA, voffA); PG8_STAGE(PG8_SB(0, 1), cB + hstep, voffB); PG8_STAGE(PG8_SA(0, 1), cA + hstep, voffA);
        if (wr == 1) PG8_BAR;
        PG8_WAIT_V(4); PG8_BAR;
        PG8_STAGE(PG8_SB(1, 0), cB + kstep, voffB); PG8_STAGE(PG8_SA(1, 0), cA + kstep, voffA); PG8_STAGE(PG8_SB(1, 1), cB + hstep + kstep, voffB);
        PG8_WAIT_V(6); PG8_BAR;
    }
    for (;;) {
        const bool has_next = S.next(ui + 1, nxt);
        const char* nA = has_next ? (const char*)g.A + (size_t)nxt.pm * tstep : cA; const char* nB = has_next ? (const char*)g.Bt + (size_t)nxt.pn * tstep : cB;
        for (int t = 0; t < nt; t += 2) {
            const bool last = (t == nt - 2);
            const char* a1 = cA + (size_t)(t + 1) * kstep;
            const char* a2 = last ? nA : cA + (size_t)(t + 2) * kstep; const char* b2 = last ? nB : cB + (size_t)(t + 2) * kstep;
            const char* a3 = a2 + kstep; const char* b3 = b2 + kstep;
            if (last && has_next) S.a_ready(nxt);
            if constexpr (SP2) {
            PG8_LDB(B0, 0, 0); PG8_LDB(B1, 0, 1); PG8_SCHED; PG8_LDA(At, 0, 0); PG8_STAGE(PG8_SA(1, 1), a1 + hstep, voffA);
            PG8_WAIT_V(8); PG8_WAIT_L(0); PG8_BAR; PG8_MMA(0, 0, At, B0); PG8_MMA(0, 1, At, B1); PG8_BAR; PG8_SCHED;
            PG8_LDA(At, 0, 1); PG8_STAGE(PG8_SB(0, 0), b2, voffB); PG8_STAGE(PG8_SB(0, 1), b2 + hstep, voffB); PG8_STAGE(PG8_SA(0, 0), a2, voffA);
            PG8_WAIT_V(8); PG8_WAIT_L(0); PG8_BAR; PG8_MMA(1, 0, At, B0); PG8_MMA(1, 1, At, B1); PG8_BAR; PG8_SCHED;
            PG8_LDB(B0, 1, 0); PG8_LDB(B1, 1, 1); PG8_SCHED; PG8_LDA(At, 1, 0); PG8_STAGE(PG8_SA(0, 1), a2 + hstep, voffA);
            PG8_WAIT_V(8); PG8_WAIT_L(0); PG8_BAR; PG8_MMA(0, 0, At, B0); PG8_MMA(0, 1, At, B1); PG8_BAR; PG8_SCHED;
            PG8_LDA(At, 1, 1); PG8_STAGE(PG8_SB(1, 0), b3, voffB); PG8_STAGE(PG8_SB(1, 1), b3 + hstep, voffB); PG8_STAGE(PG8_SA(1, 0), a3, voffA);
            PG8_WAIT_V(8); PG8_WAIT_L(0); PG8_BAR; PG8_MMA(1, 0, At, B0); PG8_MMA(1, 1, At, B1); PG8_BAR; PG8_SCHED;
            } else {
            PG8_LDB(B0, 0, 0); PG8_SCHED; PG8_LDA(At, 0, 0); PG8_STAGE(PG8_SA(1, 1), a1 + hstep, voffA);
            PG8_WAIT_L(8); PG8_BAR; PG8_WAIT_L(0); PG8_MMA(0, 0, At, B0); PG8_BAR; PG8_SCHED;
            PG8_LDB(B1, 0, 1); PG8_STAGE(PG8_SB(0, 0), b2, voffB);
            PG8_BAR; PG8_WAIT_L(0); PG8_MMA(0, 1, At, B1); PG8_BAR;
            PG8_LDA(At, 0, 1); PG8_STAGE(PG8_SA(0, 0), a2, voffA);
            PG8_BAR; PG8_WAIT_L(0); PG8_MMA(1, 0, At, B0); PG8_BAR; PG8_SCHED;
            PG8_STAGE(PG8_SB(0, 1), b2 + hstep, voffB);
            PG8_WAIT_V(6); PG8_BAR; PG8_MMA(1, 1, At, B1); PG8_BAR;
            PG8_LDB(B0, 1, 0); PG8_SCHED; PG8_LDA(At, 1, 0); PG8_STAGE(PG8_SA(0, 1), a2 + hstep, voffA);
            PG8_WAIT_L(8); PG8_BAR; PG8_WAIT_L(0); PG8_MMA(0, 0, At, B0); PG8_BAR; PG8_SCHED;
            PG8_LDB(B1, 1, 1); PG8_STAGE(PG8_SB(1, 0), b3, voffB);
            PG8_BAR; PG8_WAIT_L(0); PG8_MMA(0, 1, At, B1); PG8_BAR;
            PG8_LDA(At, 1, 1); PG8_STAGE(PG8_SA(1, 0), a3, voffA);
            PG8_BAR; PG8_WAIT_L(0); PG8_MMA(1, 0, At, B0); PG8_BAR; PG8_SCHED;
            PG8_STAGE(PG8_SB(1, 1), b3 + hstep, voffB);
            PG8_WAIT_V(6); PG8_BAR; PG8_MMA(1, 1, At, B1); PG8_BAR;
            }
        }
        if constexpr (ALIGN_EPI) { if (wr == 0) PG8_BAR; }
        if constexpr (!Epi::AFTER_DRAIN) { E(acc, cur, wr, wc, fr, fq); S.done(cur); }
        if (!has_next) break;
#pragma unroll
        for (int a = 0; a < 2; ++a)
#pragma unroll
            for (int b = 0; b < 2; ++b)
#pragma unroll
                for (int m = 0; m < 4; ++m)
#pragma unroll
                    for (int n = 0; n < 2; ++n) acc[a][b][m][n] = (f32x4){0.f, 0.f, 0.f, 0.f};
        cur = nxt; cA = nA; cB = nB; ++ui;
        if constexpr (ALIGN_EPI) { if (wr == 1) PG8_BAR; }
    }
    PG8_WAIT_V(0);
    if constexpr (!ALIGN_EPI) { if (wr == 0) PG8_BAR; }
    PG8_BAR;
    if constexpr (Epi::AFTER_DRAIN) { E.fused(acc, cur, wr, wc, fr, fq, lds, wid, lane); S.done(cur); }
#undef PG8_SA
#undef PG8_SB
#undef PG8_STAGE
#undef PG8_LDA
#undef PG8_LDB
#undef PG8_MMA
#undef PG8_WAIT_V
#undef PG8_WAIT_L
#undef PG8_BAR
#undef PG8_SCHED
}
}
constexpr int NWAVES = 8;
constexpr int DM = 1024, MP = 32768, MS = 1024, MT = MP + MS;
constexpr int NIN = 4352;
constexpr int FFH = 2816;
constexpr size_t MiB = 1u << 20;
constexpr size_t WS_CTL = 0, CTL_ZERO_BYTES = 1 * MiB;
constexpr size_t WS_SSQX = 2 * MiB, WS_SSQA = 5 * MiB, WS_SSQB = 8 * MiB, WS_AB = 11 * MiB;
constexpr size_t WS_WIN = 16 * MiB, WS_WOUT = 25 * MiB, WS_WGU0 = 27 * MiB, WS_WGU1 = 38 * MiB, WS_WDN0 = 49 * MiB, WS_WDN1 = 55 * MiB,
                 WS_WGT0 = 61 * MiB, WS_WGT1 = 63 * MiB, WS_WPJ0 = 65 * MiB, WS_WPJ1 = 66 * MiB, WS_WKVQ = 67 * MiB, WS_WO = 70 * MiB;
constexpr size_t WS_PEB = 72 * MiB, WS_XB = 106 * MiB, WS_QKV = 172 * MiB, WS_Z = 370 * MiB, WS_OG = 436 * MiB, WS_END = 502 * MiB;
constexpr size_t WS_HA = WS_XB, WS_HB = WS_Z, WS_PP = WS_OG, WS_ACT = WS_QKV, WS_KV = 172 * MiB, WS_Q = 205 * MiB, WS_OB = 271 * MiB;
constexpr int CW_BAR = 4096;
constexpr size_t O_Y = 0, O_SDP = (size_t)MT * DM, O_SDS = O_SDP + 2097152, O_SCP = O_SDS + 16777216, O_SCS = O_SCP + 147456,
                 O_KWP = O_SCS + 1179648, O_KWS = O_KWP + 524288, O_VWP = O_KWS + 4194304, O_VWS = O_VWP + 524288, O_END = O_VWS + 4194304;
constexpr int RING_OFF = 0, RING_BYTES = 131072, LDSCTL_OFF = RING_BYTES, MISC_OFF = LDSCTL_OFF + 320, LDS_BYTES = 147456;

#define GAS __attribute__((address_space(1)))
#define LAS __attribute__((address_space(3)))
typedef unsigned short bf16;
typedef unsigned v4u __attribute__((ext_vector_type(4)));
typedef float f32x4 __attribute__((ext_vector_type(4)));
typedef GAS unsigned gu32;
#define RLX_AGENT __ATOMIC_RELAXED, __HIP_MEMORY_SCOPE_AGENT
#define LDS_WAIT() asm volatile("s_waitcnt lgkmcnt(0)" ::: "memory")
#define VM_WAIT() asm volatile("s_waitcnt vmcnt(0)" ::: "memory")
__device__ __forceinline__ unsigned f2bf(float f) { unsigned u = __builtin_bit_cast(unsigned, f); return (u + 0x7fffu + ((u >> 16) & 1u)) >> 16; }
__device__ __forceinline__ unsigned pk2(float lo, float hi) { return f2bf(lo) | (f2bf(hi) << 16); }
__device__ __forceinline__ float bf2f(unsigned short b) { return __uint_as_float((unsigned)b << 16); }
using pg8::sigmoidf_;
__device__ __forceinline__ float wave_sum(float v) {
#pragma unroll
    for (int o = 1; o < 64; o <<= 1) v += __shfl_xor(v, o);
    return v;
}
#define XB_TMO      128
#define XB_XCNT(j)  (256  + 64 * (j))
#define XB_XSUB(j)  (1280 + 64 * (j))
#define XB_XGEN(j)  (2304 + 64 * (j))
#define XB_TOP      3328
#define XB_TOPGEN   3392
#define XCD_BAR_WORDS 3456
#define XB_SPIN_CAP (1u << 18)

__device__ __forceinline__ unsigned xb_ld(unsigned* p)              { return __hip_atomic_load(p, __ATOMIC_RELAXED, __HIP_MEMORY_SCOPE_AGENT); }
__device__ __forceinline__ unsigned xb_add(unsigned* p, unsigned v) { return __hip_atomic_fetch_add(p, v, __ATOMIC_RELAXED, __HIP_MEMORY_SCOPE_AGENT); }
__device__ __forceinline__ unsigned xb_xcc_id() { return (unsigned)__builtin_amdgcn_s_getreg((3 << 11) | 20) & 0xFu; }
#define XB_SPIN(cond, bar) do { unsigned _sp = 0; while (cond) { __builtin_amdgcn_s_sleep(1); \
    if ((++_sp & 255u) == 0u) { if (xb_ld(&(bar)[XB_TMO])) break; if (_sp > XB_SPIN_CAP) { atomicAdd(&(bar)[XB_TMO], 1u); break; } } } } while (0)

struct XcdBarrier {
    unsigned* bar; unsigned x;
    volatile LAS unsigned* st;
};

__device__ __forceinline__ XcdBarrier xcd_barrier_post(unsigned* bar, volatile LAS unsigned* st) {
    XcdBarrier b; b.bar = bar; b.x = xb_xcc_id(); b.st = st;
    if (threadIdx.x == 0) (void)xb_add(&bar[XB_XCNT(b.x)], 1u);
    return b;
}
__device__ __forceinline__ void xcd_barrier_complete(unsigned* bar, unsigned x, unsigned& nloc, unsigned& nx) {
    const unsigned G = gridDim.x * gridDim.y * gridDim.z;
    unsigned sum, cnt, mine, sp = 0u;
    for (;;) {
        sum = 0u; cnt = 0u; mine = 0u;
#pragma unroll
        for (unsigned j = 0; j < 16; ++j) { const unsigned c = xb_ld(&bar[XB_XCNT(j)]); sum += c; cnt += (c > 0u) ? 1u : 0u; mine = (j == x) ? c : mine; }
        if (sum == G) break;
        __builtin_amdgcn_s_sleep(1);
        if ((++sp & 255u) == 0u) { if (xb_ld(&bar[XB_TMO])) break; if (sp > XB_SPIN_CAP) { atomicAdd(&bar[XB_TMO], 1u); break; } }
    }
    nloc = mine > 0u ? mine : 1u; nx = cnt > 0u ? cnt : 1u;
}

__device__ __forceinline__ void xcd_barrier(const XcdBarrier& b) {
    asm volatile("s_waitcnt vmcnt(0)" ::: "memory");
    __syncthreads();
    if (threadIdx.x == 0) {
        unsigned* bar = b.bar;
        __builtin_amdgcn_s_waitcnt(0);
        unsigned nloc = b.st[0], nx = b.st[1];
        if (nloc == 0u) { xcd_barrier_complete(bar, b.x, nloc, nx); b.st[0] = nloc; b.st[1] = nx; }
        const unsigned old = xb_add(&bar[XB_XSUB(b.x)], 1u);
        const unsigned gen = old / nloc;
        if (old + 1u == (gen + 1u) * nloc) {
            __builtin_amdgcn_fence(__ATOMIC_RELEASE, "agent");
            asm volatile("s_waitcnt vmcnt(0)" ::: "memory");
            const unsigned og = xb_add(&bar[XB_TOP], 1u);
            const unsigned tg = og / nx;
            if (og + 1u == (tg + 1u) * nx) xb_add(&bar[XB_TOPGEN], 1u);
            else XB_SPIN(xb_ld(&bar[XB_TOPGEN]) == tg, bar);
            __builtin_amdgcn_fence(__ATOMIC_ACQUIRE, "agent");
            xb_add(&bar[XB_XGEN(b.x)], 1u);
            asm volatile("s_waitcnt vmcnt(0)" ::: "memory");
        } else {
            XB_SPIN(xb_ld(&bar[XB_XGEN(b.x)]) == gen, bar);
            __builtin_amdgcn_fence(__ATOMIC_ACQUIRE, "agent");
            asm volatile("s_waitcnt vmcnt(0)" ::: "memory");
        }
    }
    __syncthreads();
}
struct Args { const float* in[28]; float* out; unsigned char* ws; int ph_lo, ph_hi; };
typedef const __attribute__((address_space(4))) Args* cargs_t;
__device__ __forceinline__ cargs_t argp() { cargs_t p = (cargs_t)__builtin_amdgcn_kernarg_segment_ptr(); asm volatile("" : "+s"(p)); return p; }
struct Frame {
    LAS unsigned char* lds;
    volatile LAS unsigned* MISC;
    gu32* ctl;
    int tid, lane, wave, vcu, G;
    const float* const* in;
};

__device__ __forceinline__ void p0_transpose_item(const float* W, int K, int N, const float* gain, bf16* WT, int drow0, LAS float* scr, int k0, int n0, int lane) {
#pragma unroll 8
    for (int i = 0; i < 32; ++i) { const int kk = 2 * i + (lane >> 5); float w = W[(size_t)(k0 + kk) * N + n0 + (lane & 31)]; if (gain) w *= gain[k0 + kk]; scr[kk * 33 + (lane & 31)] = w; }
    LDS_WAIT(); asm volatile("" ::: "memory");
    const int c = lane & 7;
#pragma unroll
    for (int j = 0; j < 4; ++j) { const int n = (lane >> 3) + 8 * j; const LAS float* s = scr + (8 * c) * 33 + n;
        v4u o; o.x = pk2(s[0 * 33], s[1 * 33]); o.y = pk2(s[2 * 33], s[3 * 33]); o.z = pk2(s[4 * 33], s[5 * 33]); o.w = pk2(s[6 * 33], s[7 * 33]);
        *(GAS v4u*)(WT + (size_t)(drow0 + n) * K + k0 + 8 * c) = o; }
    LDS_WAIT(); asm volatile("" ::: "memory");
}
struct WDesc { const float* W; const float* gain; bf16* WT; int K, N, Nuse, kind, roff; };
__device__ __forceinline__ void p0_weight(const WDesc& d, int item, LAS float* scr, int lane) {
    const int nblk = d.Nuse / 32, kb = item / nblk, nb = item % nblk, n0 = 32 * nb;
    int drow0;
    if (d.kind == 0) drow0 = d.roff + n0;
    else { const int up = n0 >= FFH, j = up ? n0 - FFH : n0; drow0 = (j >> 7) * 256 + (up ? 128 : 0) + (j & 127); }
    p0_transpose_item(d.W, d.K, d.N, d.gain, d.WT, drow0, scr, 64 * kb, n0, lane);
}
__device__ __forceinline__ void p0_prologue(Frame& F, cargs_t a) {
    unsigned char* ws = a->ws;
    LAS float* scr = (LAS float*)(F.lds + RING_OFF + F.wave * 16384);
    const int gw = F.vcu * NWAVES + F.wave, NGW = F.G * NWAVES;
    constexpr int NW = 13;
    int it0 = 0;
#pragma unroll 1
    for (int w = 0; w < NW; ++w) {
        WDesc d;
        switch (w) {
        case 0:  d = WDesc{a->in[9],  a->in[8],  (bf16*)(ws + WS_WIN),  1024, 4112, 4096, 0, 0}; break;
        case 1:  d = WDesc{a->in[14], nullptr,  (bf16*)(ws + WS_WOUT), 1024, 1024, 1024, 0, 0}; break;
        case 2:  d = WDesc{a->in[22], a->in[21], (bf16*)(ws + WS_WGU0), 1024, 5632, 5632, 1, 0}; break;
        case 3:  d = WDesc{a->in[22] + (size_t)1024 * 5632, a->in[21] + 1024, (bf16*)(ws + WS_WGU1), 1024, 5632, 5632, 1, 0}; break;
        case 4:  d = WDesc{a->in[23], nullptr,  (bf16*)(ws + WS_WDN0), 2816, 1024, 1024, 0, 0}; break;
        case 5:  d = WDesc{a->in[23] + (size_t)2816 * 1024, nullptr, (bf16*)(ws + WS_WDN1), 2816, 1024, 1024, 0, 0}; break;
        case 6:  d = WDesc{a->in[26], a->in[24], (bf16*)(ws + WS_WGT0), 1024, 1024, 1024, 0, 0}; break;
        case 7:  d = WDesc{a->in[26] + (size_t)1024 * 1024, a->in[24] + 1024, (bf16*)(ws + WS_WGT1), 1024, 1024, 1024, 0, 0}; break;
        case 8:  d = WDesc{a->in[25], nullptr,  (bf16*)(ws + WS_WPJ0), 256, 1024, 1024, 0, 0}; break;
        case 9:  d = WDesc{a->in[25] + (size_t)256 * 1024, nullptr, (bf16*)(ws + WS_WPJ1), 256, 1024, 1024, 0, 0}; break;
        case 10: d = WDesc{a->in[16], a->in[15], (bf16*)(ws + WS_WKVQ), 1024, 512, 512, 0, 0}; break;
        case 11: d = WDesc{a->in[18], a->in[17], (bf16*)(ws + WS_WKVQ), 1024, 1024, 1024, 0, 512}; break;
        default: d = WDesc{a->in[20], nullptr,  (bf16*)(ws + WS_WO),   1024, 1024, 1024, 0, 0}; break;
        }
        const int nitems = (d.K / 64) * (d.Nuse / 32);
        int first = (gw - (it0 % NGW) + NGW) % NGW;
        for (int item = first; item < nitems; item += NGW) p0_weight(d, item, scr, F.lane);
        it0 += nitems;
    }
    {
        bf16* WT = (bf16*)(ws + WS_WIN); const float* W = a->in[9]; const float* g = a->in[8];
        const int gt = (F.vcu * NWAVES + F.wave) * 64 + F.lane, NGT = F.G * NWAVES * 64;
        for (int e = gt; e < 256 * 1024; e += NGT) { const int n = 4096 + (e >> 10), k = e & 1023; WT[(size_t)n * 1024 + k] = (n < 4112) ? (bf16)f2bf(W[(size_t)k * 4112 + n] * g[k]) : (bf16)0; }
    }
    {
        bf16* XB = (bf16*)(ws + WS_XB); float* SSQ = (float*)(ws + WS_SSQX);
        for (int m = gw; m < MT; m += NGW) {
            const float* xrow = (m < MP) ? a->in[0] + (size_t)m * DM : a->in[1] + (size_t)(m - MP) * DM;
            const GAS f32x4* xr = (const GAS f32x4*)xrow + F.lane;
            f32x4 v[4]; float s = 0.f;
#pragma unroll
            for (int j = 0; j < 4; ++j) { v[j] = xr[64 * j]; s += (v[j].x * v[j].x + v[j].y * v[j].y) + (v[j].z * v[j].z + v[j].w * v[j].w); }
            s = wave_sum(s);
            GAS unsigned long long* o8 = (GAS unsigned long long*)(XB + (size_t)m * DM) + F.lane;
#pragma unroll
            for (int j = 0; j < 4; ++j) o8[64 * j] = (unsigned long long)pk2(v[j].x, v[j].y) | ((unsigned long long)pk2(v[j].z, v[j].w) << 32);
            if (F.lane < 16) SSQ[(size_t)m * 16 + F.lane] = (F.lane == 0) ? s : 0.f;
        }
    }
    {
        bf16* PEB = (bf16*)(ws + WS_PEB);
        const size_t gt = (size_t)(F.vcu * NWAVES + F.wave) * 64 + F.lane, NGT = (size_t)F.G * NWAVES * 64;
        const size_t nchunk = (size_t)2 * MT * 256 / 8;
        for (size_t c = gt; c < nchunk; c += NGT) {
            const size_t e = c * 8; const int l = (int)(e / ((size_t)MT * 256)); const size_t rem = e - (size_t)l * MT * 256; const size_t row = rem >> 8; const int col = (int)(rem & 255);
            const float* src = (row < (size_t)MP) ? a->in[6] + ((size_t)l * MP + row) * 256 + col : a->in[7] + ((size_t)l * MS + (row - MP)) * 256 + col;
            const f32x4 v0 = *(const GAS f32x4*)src, v1 = *(const GAS f32x4*)(src + 4);
            v4u o; o.x = pk2(v0.x, v0.y); o.y = pk2(v0.z, v0.w); o.z = pk2(v1.x, v1.y); o.w = pk2(v1.z, v1.w);
            *(GAS v4u*)(PEB + e) = o;
        }
    }
}

__device__ __forceinline__ void delta_seq_item(Frame& F, cargs_t a, int item) {
    unsigned char* ws = a->ws;
    const int tid = F.tid, kq = tid >> 7, v = tid & 127, wave = F.wave, lane = F.lane;
    const bool prompt = item < 128;
    int b, h, T; size_t rowbase;
    if (prompt) { b = item >> 3; h = item & 7; T = 2048; rowbase = (size_t)b * 2048; }
    else { const int it = item - 128; b = it >> 3; h = it & 7; T = 8; rowbase = (size_t)MP + (size_t)b * 8; }
    LAS float* L = (LAS float*)(F.lds + RING_OFF);
    LAS float* vec = L;
    LAS float* red = L + 384;
    LAS float* part = L + 512;
    LAS float* opart = L + 1024;
    LAS float* red2 = L + 1536;
    float S[32];
    if (prompt) {
#pragma unroll
        for (int i = 0; i < 32; ++i) S[i] = 0.f;
    } else {
        const float* sd = a->in[2] + ((size_t)(b * 8 + h) * 128 + 32 * kq) * 128 + v;
#pragma unroll
        for (int i = 0; i < 32; ++i) S[i] = sd[(size_t)i * 128];
    }
    const int ch = kq * 1024 + h * 128 + v;
    float cw0 = 0.f, cw1 = 0.f, cw2 = 0.f, cw3 = 0.f, xm3 = 0.f, xm2 = 0.f, xm1 = 0.f;
    if (kq < 3) {
        const float* cw = a->in[10];
        cw0 = cw[ch]; cw1 = cw[3072 + ch]; cw2 = cw[2 * 3072 + ch]; cw3 = cw[3 * 3072 + ch];
        if (!prompt) { const float* sc = a->in[3] + (size_t)b * 3 * 3072 + ch; xm3 = sc[0]; xm2 = sc[3072]; xm1 = sc[2 * 3072]; }
    }
    const float Aneg = -__expf(a->in[11][h]), dtb = a->in[12][h], outg = a->in[13][v];
    const bf16* xsrc = (kq < 3) ? (const bf16*)(ws + WS_QKV) + rowbase * 3072 + ch : (const bf16*)(ws + WS_Z) + rowbase * 1024 + h * 128 + v;
    const size_t xstride = (kq < 3) ? 3072 : 1024;
    const float* absrc = (const float*)(ws + WS_AB) + rowbase * 16 + h;
    bf16* og = (bf16*)(ws + WS_OG) + rowbase * 1024 + h * 128 + v;
    unsigned short xs[8]; float aa[8], bb[8];
#pragma unroll
    for (int j = 0; j < 8; ++j) { xs[j] = xsrc[(size_t)j * xstride]; aa[j] = absrc[(size_t)j * 16]; bb[j] = absrc[(size_t)j * 16 + 8]; }
    float o_prev = 0.f, z_prev = 0.f; bool have_prev = false;
    __syncthreads();
    for (int t0 = 0; t0 < T; t0 += 8) {
        unsigned short xc[8]; float ac[8], bc[8];
#pragma unroll
        for (int j = 0; j < 8; ++j) { xc[j] = xs[j]; ac[j] = aa[j]; bc[j] = bb[j]; }
        if (t0 + 8 < T) {
#pragma unroll
            for (int j = 0; j < 8; ++j) { xs[j] = xsrc[(size_t)(t0 + 8 + j) * xstride]; aa[j] = absrc[(size_t)(t0 + 8 + j) * 16]; bb[j] = absrc[(size_t)(t0 + 8 + j) * 16 + 8]; }
        }
#pragma unroll
        for (int tt = 0; tt < 8; ++tt) {
            const float x = bf2f(xc[tt]);
            float zcur = 0.f;
            if (kq < 3) {
                const float c = (xm3 * cw0 + xm2 * cw1) + (xm1 * cw2 + x * cw3);
                xm3 = xm2; xm2 = xm1; xm1 = x;
                const float s = c * sigmoidf_(c);
                vec[kq * 128 + v] = s;
                if (kq < 2) { const float q2 = wave_sum(s * s); if (lane == 0) red[wave] = q2; }
            } else zcur = x;
            __syncthreads();
            if (kq == 3 && have_prev) {
                const float tot = red2[0] + red2[1];
                const float ov = o_prev * rsqrtf(tot * (1.0f / 128.0f) + 1e-6f) * outg * (z_prev * sigmoidf_(z_prev));
                og[(size_t)(t0 + tt - 1) * 1024] = (bf16)f2bf(ov);
            }
            const float rq = rsqrtf(red[0] + red[1] + 1e-6f) * 0.08838834764831845f, rk = rsqrtf(red[2] + red[3] + 1e-6f);
            const float beta = sigmoidf_(bc[tt]);
            const float sp_in = ac[tt] + dtb; const float sp = (sp_in > 15.f) ? sp_in : log1pf(__expf(sp_in));
            const float adec = __expf(Aneg * sp);
            float kv[32];
            {
                float p = 0.f;
#pragma unroll
                for (int i = 0; i < 8; ++i) { const f32x4 k4 = *(const LAS f32x4*)(vec + 128 + 32 * kq + 4 * i); kv[4 * i] = k4[0]; kv[4 * i + 1] = k4[1]; kv[4 * i + 2] = k4[2]; kv[4 * i + 3] = k4[3];
                    p += (k4[0] * S[4 * i] + k4[1] * S[4 * i + 1]) + (k4[2] * S[4 * i + 2] + k4[3] * S[4 * i + 3]); }
                part[kq * 128 + v] = p;
            }
            __syncthreads();
            {
                const float kS = rk * ((part[v] + part[128 + v]) + (part[256 + v] + part[384 + v]));
                const float d = beta * (vec[256 + v] - adec * kS) * rk;
                float po = 0.f;
#pragma unroll
                for (int i = 0; i < 8; ++i) { const f32x4 q4 = *(const LAS f32x4*)(vec + 32 * kq + 4 * i);
#pragma unroll
                    for (int j = 0; j < 4; ++j) { S[4 * i + j] = adec * S[4 * i + j] + kv[4 * i + j] * d; po += q4[j] * S[4 * i + j]; } }
                opart[kq * 128 + v] = po * rq;
            }
            __syncthreads();
            if (kq == 3) {
                const float o = (opart[v] + opart[128 + v]) + (opart[256 + v] + opart[384 + v]);
                const float o2 = wave_sum(o * o); if (lane == 0) red2[wave - 6] = o2;
                o_prev = o; z_prev = zcur;
            }
            have_prev = true;
        }
    }
    __syncthreads();
    if (kq == 3) {
        const float tot = red2[0] + red2[1];
        const float ov = o_prev * rsqrtf(tot * (1.0f / 128.0f) + 1e-6f) * outg * (z_prev * sigmoidf_(z_prev));
        og[(size_t)(T - 1) * 1024] = (bf16)f2bf(ov);
    }
    {
        float* so = a->out + (prompt ? O_SDP : O_SDS) + ((size_t)(b * 8 + h) * 128 + 32 * kq) * 128 + v;
#pragma unroll
        for (int i = 0; i < 32; ++i) so[(size_t)i * 128] = S[i];
    }
}

__device__ __forceinline__ void attn_prompt_item(Frame& F, cargs_t a, int item) {
    unsigned char* ws = a->ws;
    const int qblk = item & 15, kvh = (item >> 4) & 3, b = item >> 6;
    const int tid = F.tid, wave = F.wave, lane = F.lane;
    LAS float* Kf = (LAS float*)(F.lds + RING_OFF);
    LAS float* Vf = Kf + 256 * 64;
    const bf16* KV = (const bf16*)(ws + WS_KV);
    __syncthreads();
    for (int idx = tid; idx < 256 * 16; idx += 512) {
        const int key = idx >> 4, c = idx & 15;
        const long srow = (long)qblk * 128 - 128 + key;
        f32x4 v0 = (f32x4){0.f, 0.f, 0.f, 0.f}, v1 = v0;
        if (srow >= 0) {
            const v4u w = *(const GAS v4u*)(KV + ((size_t)b * 2048 + (size_t)srow) * 512 + (c < 8 ? kvh * 64 + c * 8 : 256 + kvh * 64 + (c - 8) * 8));
            v0 = (f32x4){__uint_as_float(w.x << 16), __uint_as_float(w.x & 0xffff0000u), __uint_as_float(w.y << 16), __uint_as_float(w.y & 0xffff0000u)};
            v1 = (f32x4){__uint_as_float(w.z << 16), __uint_as_float(w.z & 0xffff0000u), __uint_as_float(w.w << 16), __uint_as_float(w.w & 0xffff0000u)};
        }
        LAS float* dst = (c < 8 ? Kf + key * 64 + c * 8 : Vf + key * 64 + (c - 8) * 8);
        *(LAS f32x4*)dst = v0; *(LAS f32x4*)(dst + 4) = v1;
    }
    __syncthreads();
    const int g = wave >> 1, qi = (wave & 1) * 64 + lane, head = kvh * 4 + g;
    const size_t row = (size_t)b * 2048 + (size_t)qblk * 128 + qi;
    float q[64];
    {
        const bf16* qp = (const bf16*)(ws + WS_Q) + row * 1024 + head * 64;
#pragma unroll
        for (int c = 0; c < 8; ++c) { const v4u w = *(const GAS v4u*)(qp + c * 8);
            q[c * 8 + 0] = __uint_as_float(w.x << 16); q[c * 8 + 1] = __uint_as_float(w.x & 0xffff0000u); q[c * 8 + 2] = __uint_as_float(w.y << 16); q[c * 8 + 3] = __uint_as_float(w.y & 0xffff0000u);
            q[c * 8 + 4] = __uint_as_float(w.z << 16); q[c * 8 + 5] = __uint_as_float(w.z & 0xffff0000u); q[c * 8 + 6] = __uint_as_float(w.w << 16); q[c * 8 + 7] = __uint_as_float(w.w & 0xffff0000u); }
    }
    float mrun = a->in[19][head], l = 1.0f;
    float acc[64];
#pragma unroll
    for (int d = 0; d < 64; ++d) acc[d] = 0.f;
    int jlo = (wave & 1) * 64; const int jhi = (wave & 1) * 64 + 192; if (qblk == 0 && jlo < 128) jlo = 128;
#pragma unroll 1
    for (int j = jlo; j < jhi; ++j) {
        const LAS float* kr = Kf + j * 64; float t = 0.f;
#pragma unroll
        for (int d = 0; d < 16; ++d) { const f32x4 k4 = *(const LAS f32x4*)(kr + 4 * d); t += (q[4 * d] * k4[0] + q[4 * d + 1] * k4[1]) + (q[4 * d + 2] * k4[2] + q[4 * d + 3] * k4[3]); }
        const bool ok = (j >= qi + 1) && (j <= qi + 128) && (qblk > 0 || j >= 128);
        t = ok ? t : -1e30f;
        if (t > mrun) {
            const float f = __expf(mrun - t); mrun = t; l *= f;
#pragma unroll
            for (int d = 0; d < 64; ++d) acc[d] *= f;
        }
        const float p = __expf(t - mrun); l += p;
        const LAS float* vr = Vf + j * 64;
#pragma unroll
        for (int d = 0; d < 16; ++d) { const f32x4 v4 = *(const LAS f32x4*)(vr + 4 * d); acc[4 * d] += p * v4[0]; acc[4 * d + 1] += p * v4[1]; acc[4 * d + 2] += p * v4[2]; acc[4 * d + 3] += p * v4[3]; }
    }
    const float inv = 1.0f / l;
    bf16* op = (bf16*)(ws + WS_OB) + row * 1024 + head * 64;
#pragma unroll
    for (int c = 0; c < 8; ++c) { v4u o; o.x = pk2(acc[c * 8] * inv, acc[c * 8 + 1] * inv); o.y = pk2(acc[c * 8 + 2] * inv, acc[c * 8 + 3] * inv); o.z = pk2(acc[c * 8 + 4] * inv, acc[c * 8 + 5] * inv); o.w = pk2(acc[c * 8 + 6] * inv, acc[c * 8 + 7] * inv); *(GAS v4u*)(op + c * 8) = o; }
}
__device__ __forceinline__ void attn_sample_item(Frame& F, cargs_t a, int item) {
    unsigned char* ws = a->ws;
    const int kvh = item & 3, b = item >> 2;
    const int tid = F.tid;
    LAS float* Kf = (LAS float*)(F.lds + RING_OFF);
    LAS float* Vf = Kf + 136 * 64;
    LAS float* Sc = Vf + 136 * 64;
    const bf16* KV = (const bf16*)(ws + WS_KV);
    __syncthreads();
    for (int idx = tid; idx < 128 * 32; idx += 512) {
        const int key = idx >> 5, c = idx & 31; const int isv = c >> 4, cc = c & 15;
        const float* src = a->in[isv ? 5 : 4] + ((size_t)(b * 128 + key) * 4 + kvh) * 64 + cc * 4;
        const f32x4 v = *(const GAS f32x4*)src;
        *(LAS f32x4*)((isv ? Vf : Kf) + key * 64 + cc * 4) = v;
        if (key >= 8) *(GAS f32x4*)(a->out + (isv ? O_VWS : O_KWS) + ((size_t)(b * 128 + key - 8) * 4 + kvh) * 64 + cc * 4) = v;
    }
    for (int idx = tid; idx < 8 * 16; idx += 512) {
        const int t = idx >> 4, c = idx & 15;
        const v4u w = *(const GAS v4u*)(KV + ((size_t)MP + (size_t)b * 8 + t) * 512 + (c < 8 ? kvh * 64 + c * 8 : 256 + kvh * 64 + (c - 8) * 8));
        LAS float* dst = (c < 8 ? Kf + (128 + t) * 64 + c * 8 : Vf + (128 + t) * 64 + (c - 8) * 8);
        *(LAS f32x4*)dst = (f32x4){__uint_as_float(w.x << 16), __uint_as_float(w.x & 0xffff0000u), __uint_as_float(w.y << 16), __uint_as_float(w.y & 0xffff0000u)};
        *(LAS f32x4*)(dst + 4) = (f32x4){__uint_as_float(w.z << 16), __uint_as_float(w.z & 0xffff0000u), __uint_as_float(w.w << 16), __uint_as_float(w.w & 0xffff0000u)};
    }
    __syncthreads();
    const int r = tid & 31, ks = tid >> 5;
    const int t = r >> 2, g = r & 3, head = kvh * 4 + g;
    const size_t row = (size_t)MP + (size_t)b * 8 + t;
    {
        float q[64];
        const bf16* qp = (const bf16*)(ws + WS_Q) + row * 1024 + head * 64;
#pragma unroll
        for (int c = 0; c < 8; ++c) { const v4u w = *(const GAS v4u*)(qp + c * 8);
            q[c * 8 + 0] = __uint_as_float(w.x << 16); q[c * 8 + 1] = __uint_as_float(w.x & 0xffff0000u); q[c * 8 + 2] = __uint_as_float(w.y << 16); q[c * 8 + 3] = __uint_as_float(w.y & 0xffff0000u);
            q[c * 8 + 4] = __uint_as_float(w.z << 16); q[c * 8 + 5] = __uint_as_float(w.z & 0xffff0000u); q[c * 8 + 6] = __uint_as_float(w.w << 16); q[c * 8 + 7] = __uint_as_float(w.w & 0xffff0000u); }
        for (int j = ks; j < 136; j += 16) {
            const LAS float* kr = Kf + j * 64; float s = 0.f;
#pragma unroll
            for (int d = 0; d < 16; ++d) { const f32x4 k4 = *(const LAS f32x4*)(kr + 4 * d); s += (q[4 * d] * k4[0] + q[4 * d + 1] * k4[1]) + (q[4 * d + 2] * k4[2] + q[4 * d + 3] * k4[3]); }
            const bool ok = (j < 128) ? (j >= t + 1) : (j - 128 <= t);
            Sc[r * 136 + j] = ok ? s : -1e30f;
        }
    }
    __syncthreads();
    {
        const float sink = a->in[19][head];
        float mx = sink;
        for (int j = 0; j < 136; ++j) mx = fmaxf(mx, Sc[r * 136 + j]);
        float l = __expf(sink - mx); f32x4 o = (f32x4){0.f, 0.f, 0.f, 0.f};
        for (int j = 0; j < 136; ++j) { const float p = __expf(Sc[r * 136 + j] - mx); l += p; const f32x4 v4 = *(const LAS f32x4*)(Vf + j * 64 + ks * 4); o += v4 * p; }
        const float inv = 1.0f / l;
        bf16* op = (bf16*)(ws + WS_OB) + row * 1024 + head * 64 + ks * 4;
        *(GAS unsigned long long*)op = (unsigned long long)pk2(o[0] * inv, o[1] * inv) | ((unsigned long long)pk2(o[2] * inv, o[3] * inv) << 32);
    }
}

__device__ __forceinline__ void final_norm(Frame& F, cargs_t a) {
    const int gw = F.vcu * NWAVES + F.wave, NGW = F.G * NWAVES;
    const GAS f32x4* gn = (const GAS f32x4*)a->in[27] + F.lane;
    f32x4 g[4];
#pragma unroll
    for (int j = 0; j < 4; ++j) g[j] = gn[64 * j];
    for (int m = gw; m < MT; m += NGW) {
        GAS f32x4* yr = (GAS f32x4*)(a->out + O_Y + (size_t)m * DM) + F.lane;
        f32x4 v[4]; float s = 0.f;
#pragma unroll
        for (int j = 0; j < 4; ++j) { v[j] = yr[64 * j]; s += (v[j].x * v[j].x + v[j].y * v[j].y) + (v[j].z * v[j].z + v[j].w * v[j].w); }
        const float rstd = rsqrtf(wave_sum(s) * (1.f / DM) + 1e-6f);
#pragma unroll
        for (int j = 0; j < 4; ++j) yr[64 * j] = v[j] * rstd * g[j];
    }
}
#ifndef MK_N_LAUNCHES
#define MK_N_LAUNCHES 16
#endif
constexpr int N_PHASES = 16;
constexpr int N_LAUNCHES = MK_N_LAUNCHES;

template <class Epi> __device__ __forceinline__ void run_gemm(Frame& F, const bf16* A, const bf16* Bt, int N, int K, const Epi& E) {
    pg8::Gemm g{A, Bt, MT, N, K}; pg8::StaticOrder S; S.init(MT, N, F.G, (int)blockIdx.x);
    pg8::gemm_phase<Epi, pg8::StaticOrder, true, true>(F.lds + RING_OFF, g, S, E);
}

__global__ void __launch_bounds__(NWAVES * 64, 2) yoco_fwd(Args args) {
    extern __shared__ __attribute__((aligned(16))) unsigned char lds[];
    Frame F;
    F.lds = (LAS unsigned char*)lds;
    F.MISC = (volatile LAS unsigned*)(F.lds + MISC_OFF);
    F.tid = threadIdx.x; F.lane = F.tid & 63; F.wave = __builtin_amdgcn_readfirstlane(F.tid >> 6);
    F.G = gridDim.x; { const int bx = blockIdx.x; F.vcu = (F.G % 8 == 0) ? (bx % 8) * (F.G / 8) + bx / 8 : bx; }
    F.ctl = (gu32*)(argp()->ws + WS_CTL);
    for (int u = F.tid; u < (LDS_BYTES - LDSCTL_OFF) / 4; u += NWAVES * 64) ((LAS unsigned*)(F.lds + LDSCTL_OFF))[u] = 0u;
    __syncthreads();
    XcdBarrier bar; bar.bar = (unsigned*)(F.ctl + CW_BAR); bar.x = 0; bar.st = nullptr;
    if (N_LAUNCHES == 1) bar = xcd_barrier_post((unsigned*)(F.ctl + CW_BAR), F.MISC + 8);
#define GRID_BAR() do { if (N_LAUNCHES == 1) xcd_barrier(bar); } while (0)
    const int lo = argp()->ph_lo, hi = argp()->ph_hi;
#ifndef PH_MASK
#define PH_MASK 0xffff
#endif
#define IN(k) (((PH_MASK >> (k)) & 1) && lo <= (k) && (k) < hi)
#define SEAM(k) do { if (IN(k) && IN((k) + 1)) GRID_BAR(); } while (0)
#define XB ((bf16*)(argp()->ws + WS_XB))
#define HA ((bf16*)(argp()->ws + WS_HA))
#define HB ((bf16*)(argp()->ws + WS_HB))
#define OG ((bf16*)(argp()->ws + WS_OG))
#define PP ((bf16*)(argp()->ws + WS_PP))
#define ACT ((bf16*)(argp()->ws + WS_ACT))
#define KVb ((bf16*)(argp()->ws + WS_KV))
#define Qb ((bf16*)(argp()->ws + WS_Q))
#define OB ((bf16*)(argp()->ws + WS_OB))
#define PEB ((bf16*)(argp()->ws + WS_PEB))
#define SSQX ((float*)(argp()->ws + WS_SSQX))
#define SSQA ((float*)(argp()->ws + WS_SSQA))
#define SSQB ((float*)(argp()->ws + WS_SSQB))

    if (IN(0)) { p0_prologue(F, argp()); } SEAM(0);
    if (IN(1)) { pg8::EpiQKV E{(bf16*)(argp()->ws + WS_QKV), (bf16*)(argp()->ws + WS_Z), (float*)(argp()->ws + WS_AB), SSQX, argp()->out + O_SCP, argp()->out + O_SCS};
                 run_gemm(F, XB, (const bf16*)(argp()->ws + WS_WIN), NIN, 1024, E); } SEAM(1);
    if (IN(2)) { for (int item = blockIdx.x; item < 128 + 1024; item += F.G) delta_seq_item(F, argp(), item); } SEAM(2);
    if (IN(3)) { pg8::EpiRes<true> E{argp()->in[0], argp()->in[1], nullptr, HA, SSQA}; run_gemm(F, OG, (const bf16*)(argp()->ws + WS_WOUT), 1024, 1024, E); } SEAM(3);
    if (IN(4)) { pg8::EpiGU E{ACT, SSQA}; run_gemm(F, HA, (const bf16*)(argp()->ws + WS_WGU0), 5632, 1024, E); } SEAM(4);
    if (IN(5)) { pg8::EpiRes<false> E{nullptr, nullptr, HA, HB, SSQB}; run_gemm(F, ACT, (const bf16*)(argp()->ws + WS_WDN0), 1024, FFH, E); } SEAM(5);
    if (IN(6)) { pg8::EpiPP E{PP}; run_gemm(F, PEB, (const bf16*)(argp()->ws + WS_WPJ0), 1024, 256, E); } SEAM(6);
    if (IN(7)) { pg8::EpiGate<false> E{SSQB, PP, HB, HA, SSQA, nullptr}; run_gemm(F, HB, (const bf16*)(argp()->ws + WS_WGT0), 1024, 1024, E); } SEAM(7);
    if (IN(8)) { pg8::EpiKVQ E{KVb, Qb, SSQA, argp()->out + O_KWP, argp()->out + O_VWP, argp()->out + O_KWS, argp()->out + O_VWS};
                 run_gemm(F, HA, (const bf16*)(argp()->ws + WS_WKVQ), 1536, 1024, E); } SEAM(8);
    if (IN(9)) { for (int item = blockIdx.x; item < 1024 + 512; item += F.G) { if (item < 1024) attn_prompt_item(F, argp(), item); else attn_sample_item(F, argp(), item - 1024); } } SEAM(9);
    if (IN(10)) { pg8::EpiRes<false> E{nullptr, nullptr, HA, HB, SSQB}; run_gemm(F, OB, (const bf16*)(argp()->ws + WS_WO), 1024, 1024, E); } SEAM(10);
    if (IN(11)) { pg8::EpiGU E{ACT, SSQB}; run_gemm(F, HB, (const bf16*)(argp()->ws + WS_WGU1), 5632, 1024, E); } SEAM(11);
    if (IN(12)) { pg8::EpiRes<false> E{nullptr, nullptr, HB, HA, SSQA}; run_gemm(F, ACT, (const bf16*)(argp()->ws + WS_WDN1), 1024, FFH, E); } SEAM(12);
    if (IN(13)) { pg8::EpiPP E{PP}; run_gemm(F, PEB + (size_t)MT * 256, (const bf16*)(argp()->ws + WS_WPJ1), 1024, 256, E); } SEAM(13);
    if (IN(14)) { pg8::EpiGate<true> E{SSQA, PP, HA, nullptr, nullptr, argp()->out + O_Y}; run_gemm(F, HA, (const bf16*)(argp()->ws + WS_WGT1), 1024, 1024, E); } SEAM(14);
    if (IN(15)) { final_norm(F, argp()); }
#undef IN
#undef SEAM
}

extern "C" void kernel_launch(void* const* d_in, const int* in_sizes, int n_in, void* d_out, int out_size, void* d_ws, size_t ws_size, hipStream_t stream) {
    static int grid = 0;
    if (grid == 0) {
        if (n_in != 28 || out_size != (int)O_END || ws_size < WS_END) { fprintf(stderr, "kernel_launch: unexpected shapes: n_in %d out %d ws %zu (need %zu)\n", n_in, out_size, ws_size, (size_t)WS_END); grid = -1; return; }
        int dev = 0, cus = 0;
        if (hipGetDevice(&dev) != hipSuccess || hipDeviceGetAttribute(&cus, hipDeviceAttributeMultiprocessorCount, dev) != hipSuccess) { grid = -1; return; }
        if (hipFuncSetAttribute((const void*)yoco_fwd, hipFuncAttributeMaxDynamicSharedMemorySize, LDS_BYTES) != hipSuccess) { fprintf(stderr, "kernel_launch: hipFuncSetAttribute failed\n"); grid = -1; return; }
        (void)hipGetLastError();
        grid = cus;
    }
    if (grid < 0) return;
    (void)hipMemsetAsync((char*)d_ws + WS_CTL, 0, CTL_ZERO_BYTES, stream);
    Args a{};
    for (int i = 0; i < 28; ++i) a.in[i] = (const float*)d_in[i];
    a.out = (float*)d_out; a.ws = (unsigned char*)d_ws;
    if (N_LAUNCHES == 1) { a.ph_lo = 0; a.ph_hi = N_PHASES; hipLaunchKernelGGL(yoco_fwd, dim3(grid), dim3(NWAVES * 64), LDS_BYTES, stream, a); }
    else for (int p = 0; p < N_PHASES; ++p) { a.ph_lo = p; a.ph_hi = p + 1; hipLaunchKernelGGL(yoco_fwd, dim3(grid), dim3(NWAVES * 64), LDS_BYTES, stream, a); }
}
```

```cpp
#include <hip/hip_runtime.h>
#include <cstdio>
#include <cstdint>
namespace pg8 {
#define PG8_LAS __attribute__((address_space(3)))
typedef unsigned short bf16_t;
typedef short bf16x8 __attribute__((ext_vector_type(8)));
typedef float f32x4 __attribute__((ext_vector_type(4)));
typedef unsigned u32x4 __attribute__((ext_vector_type(4)));
constexpr int BM = 256, BK = 64, HALF = 128, HTB = HALF * BK * 2  , STAGE_BYTES = 8 * HTB, NXCD = 8, WGM = 8;

__host__ __device__ __forceinline__ int lds_byte(int r, int c) { const int st = (r >> 4) * 2 + (c >> 5), rr = r & 15, cc = c & 31, ob = rr * 64 + cc * 2; return st * 1024 + (ob ^ (((ob >> 9) & 1) << 5)); }
__host__ __device__ __forceinline__ void stage_rc(int b, int& R, int& C) { const int st = b / 1024, sb = b % 1024, swz = sb ^ (((sb >> 9) & 1) << 5); R = (st >> 1) * 16 + swz / 64; C = (st & 1) * 32 + (swz % 64) / 2; }
__host__ __device__ __forceinline__ int perm32(int rho) { const int n = rho >> 4, i = rho & 15; return 8 * (i >> 2) + 4 * n + (i & 3); }

struct Unit { int pm, pn; };
struct Gemm { const bf16_t* A; const bf16_t* Bt; int M, N, K; };

struct StaticOrder {
    int nM, nN, nwg, G, c;
    __host__ __device__ void init(int M, int N, int G_, int c_) { nM = M / BM; nN = N / BM; nwg = nM * nN; G = G_; c = c_; }
    __host__ __device__ bool next(int i, Unit& u) const {
        const long L = (long)i * G + c; if (L >= nwg) return false;
        int wgid = (int)L; { const int q = nwg / NXCD, r = nwg % NXCD, xcd = wgid % NXCD, off = wgid / NXCD; wgid = (xcd < r ? xcd * (q + 1) : r * (q + 1) + (xcd - r) * q) + off; }
        const int nig = WGM * nN, gid = wgid / nig, fm = gid * WGM, gsz = (nM - fm) < WGM ? (nM - fm) : WGM;
        u.pm = fm + ((wgid % nig) % gsz); u.pn = (wgid % nig) / gsz; return true;
    }
    __device__ __forceinline__ void a_ready(const Unit&) const {}
    __device__ __forceinline__ void done(const Unit&) const {}
};

__device__ __forceinline__ unsigned cvt_pk_bf16(float lo, float hi) { unsigned r; asm volatile("v_cvt_pk_bf16_f32 %0, %1, %2" : "=v"(r) : "v"(lo), "v"(hi)); return r; }
__device__ __forceinline__ f32x4 bf_lo2(unsigned a, unsigned b) { return (f32x4){__uint_as_float(a << 16), __uint_as_float(a & 0xffff0000u), __uint_as_float(b << 16), __uint_as_float(b & 0xffff0000u)}; }
__device__ __forceinline__ u32x4 pack8(const f32x4 v0, const f32x4 v1) { u32x4 w; w.x = cvt_pk_bf16(v0[0], v0[1]); w.y = cvt_pk_bf16(v0[2], v0[3]); w.z = cvt_pk_bf16(v1[0], v1[1]); w.w = cvt_pk_bf16(v1[2], v1[3]); return w; }
__device__ __forceinline__ float dot4(const f32x4 a) { return (a[0] * a[0] + a[1] * a[1]) + (a[2] * a[2] + a[3] * a[3]); }
__device__ __forceinline__ float row_rstd(const float* ssq, int r, int fq) {
    const f32x4 p = *(const f32x4*)(ssq + (size_t)r * 16 + 4 * fq);
    float s = (p[0] + p[1]) + (p[2] + p[3]);
    s += __shfl_xor(s, 16); s += __shfl_xor(s, 32);
    return rsqrtf(s * (1.0f / 1024.0f) + 1e-6f);
}
__device__ __forceinline__ float sigmoidf_(float x) { return __builtin_amdgcn_rcpf(1.0f + __expf(-x)); }

constexpr int MP_ROWS = 32768;

struct EpiQKV {
    static constexpr bool PERM = true, AFTER_DRAIN = false;
    bf16_t* QKV; bf16_t* Z; float* AB; const float* ssq; float* sc_p; float* sc_s;
    __device__ __forceinline__ void operator()(const f32x4 (&acc)[2][2][4][2], const Unit& u, int wr, int wc, int fr, int fq) const {
        const int row0 = u.pm * BM + wr * 64 + fr, colt = u.pn * BM + wc * 32 + 8 * fq;
#pragma unroll
        for (int ai = 0; ai < 2; ++ai)
#pragma unroll
            for (int m = 0; m < 4; ++m) {
                const int r = row0 + ai * HALF + m * 16; const float rs = row_rstd(ssq, r, fq);
#pragma unroll
                for (int bj = 0; bj < 2; ++bj) {
                    const int col = colt + bj * HALF; const f32x4 v0 = acc[ai][bj][m][0] * rs, v1 = acc[ai][bj][m][1] * rs;
                    if (u.pn < 12) {
                        *(u32x4*)(QKV + (size_t)r * 3072 + col) = pack8(v0, v1);
                        if (r < MP_ROWS) { const int s = r & 2047; if (s >= 2045) { float* o = sc_p + ((size_t)((r >> 11) * 3 + (s - 2045))) * 3072 + col; *(f32x4*)o = v0; *(f32x4*)(o + 4) = v1; } }
                        else { const int rr = r - MP_ROWS, t = rr & 7; if (t >= 5) { float* o = sc_s + ((size_t)((rr >> 3) * 3 + (t - 5))) * 3072 + col; *(f32x4*)o = v0; *(f32x4*)(o + 4) = v1; } }
                    } else if (u.pn < 16) {
                        *(u32x4*)(Z + (size_t)r * 1024 + (col - 3072)) = pack8(v0, v1);
                    } else {
                        const int c = col - 4096; if (c < 16) { float* o = AB + (size_t)r * 16 + c; *(f32x4*)o = v0; *(f32x4*)(o + 4) = v1; }
                    }
                }
            }
    }
};
template <bool BASEF32> struct EpiRes {
    static constexpr bool PERM = true, AFTER_DRAIN = false;
    const float* xp; const float* xs; const bf16_t* hb; bf16_t* out; float* ssq_out;
    __device__ __forceinline__ void operator()(const f32x4 (&acc)[2][2][4][2], const Unit& u, int wr, int wc, int fr, int fq) const {
        const int row0 = u.pm * BM + wr * 64 + fr, colt = u.pn * BM + wc * 32 + 8 * fq;
#pragma unroll
        for (int ai = 0; ai < 2; ++ai)
#pragma unroll
            for (int m = 0; m < 4; ++m) {
                const int r = row0 + ai * HALF + m * 16; float q = 0.f;
#pragma unroll
                for (int bj = 0; bj < 2; ++bj) {
                    const int col = colt + bj * HALF; f32x4 b0, b1;
                    if (BASEF32) { const float* p = (r < MP_ROWS ? xp + (size_t)r * 1024 : xs + (size_t)(r - MP_ROWS) * 1024) + col; b0 = *(const f32x4*)p; b1 = *(const f32x4*)(p + 4); }
                    else { const u32x4 w = *(const u32x4*)(hb + (size_t)r * 1024 + col); b0 = bf_lo2(w.x, w.y); b1 = bf_lo2(w.z, w.w); }
                    const f32x4 v0 = acc[ai][bj][m][0] + b0, v1 = acc[ai][bj][m][1] + b1;
                    q += dot4(v0) + dot4(v1);
                    *(u32x4*)(out + (size_t)r * 1024 + col) = pack8(v0, v1);
                }
                q += __shfl_xor(q, 16); q += __shfl_xor(q, 32);
                if (fq == 0) ssq_out[(size_t)r * 16 + u.pn * 4 + wc] = q;
            }
    }
};
struct EpiGU {
    static constexpr bool PERM = true, AFTER_DRAIN = false;
    bf16_t* act; const float* ssq;
    __device__ __forceinline__ void operator()(const f32x4 (&acc)[2][2][4][2], const Unit& u, int wr, int wc, int fr, int fq) const {
        const int row0 = u.pm * BM + wr * 64 + fr, col = u.pn * HALF + wc * 32 + 8 * fq;
#pragma unroll
        for (int ai = 0; ai < 2; ++ai)
#pragma unroll
            for (int m = 0; m < 4; ++m) {
                const int r = row0 + ai * HALF + m * 16; const float rs = row_rstd(ssq, r, fq);
                f32x4 o[2];
#pragma unroll
                for (int n = 0; n < 2; ++n) {
                    const f32x4 g = acc[ai][0][m][n] * rs, up = acc[ai][1][m][n] * rs;
#pragma unroll
                    for (int j = 0; j < 4; ++j) o[n][j] = g[j] * sigmoidf_(g[j]) * up[j];
                }
                *(u32x4*)(act + (size_t)r * 2816 + col) = pack8(o[0], o[1]);
            }
    }
};
struct EpiPP {
    static constexpr bool PERM = true, AFTER_DRAIN = false;
    bf16_t* out;
    __device__ __forceinline__ void operator()(const f32x4 (&acc)[2][2][4][2], const Unit& u, int wr, int wc, int fr, int fq) const {
        const int row0 = u.pm * BM + wr * 64 + fr, colt = u.pn * BM + wc * 32 + 8 * fq;
#pragma unroll
        for (int ai = 0; ai < 2; ++ai)
#pragma unroll
            for (int m = 0; m < 4; ++m) {
                const int r = row0 + ai * HALF + m * 16;
#pragma unroll
                for (int bj = 0; bj < 2; ++bj) *(u32x4*)(out + (size_t)r * 1024 + colt + bj * HALF) = pack8(acc[ai][bj][m][0], acc[ai][bj][m][1]);
            }
    }
};
template <bool FINAL> struct EpiGate {
    static constexpr bool PERM = true, AFTER_DRAIN = false;
    const float* ssq_in; const bf16_t* pp; const bf16_t* hb; bf16_t* out; float* ssq_out; float* y;
    __device__ __forceinline__ void operator()(const f32x4 (&acc)[2][2][4][2], const Unit& u, int wr, int wc, int fr, int fq) const {
        const int row0 = u.pm * BM + wr * 64 + fr, colt = u.pn * BM + wc * 32 + 8 * fq;
#pragma unroll
        for (int ai = 0; ai < 2; ++ai)
#pragma unroll
            for (int m = 0; m < 4; ++m) {
                const int r = row0 + ai * HALF + m * 16; const float rs = row_rstd(ssq_in, r, fq); float q = 0.f;
#pragma unroll
                for (int bj = 0; bj < 2; ++bj) {
                    const int col = colt + bj * HALF;
                    const u32x4 wp = *(const u32x4*)(pp + (size_t)r * 1024 + col), wh = *(const u32x4*)(hb + (size_t)r * 1024 + col);
                    const f32x4 p0 = bf_lo2(wp.x, wp.y), p1 = bf_lo2(wp.z, wp.w), h0 = bf_lo2(wh.x, wh.y), h1 = bf_lo2(wh.z, wh.w);
                    f32x4 v0, v1;
#pragma unroll
                    for (int j = 0; j < 4; ++j) { v0[j] = h0[j] + p0[j] * sigmoidf_(acc[ai][bj][m][0][j] * rs); v1[j] = h1[j] + p1[j] * sigmoidf_(acc[ai][bj][m][1][j] * rs); }
                    if (FINAL) { float* o = y + (size_t)r * 1024 + col; *(f32x4*)o = v0; *(f32x4*)(o + 4) = v1; }
                    else { q += dot4(v0) + dot4(v1); *(u32x4*)(out + (size_t)r * 1024 + col) = pack8(v0, v1); }
                }
                if (!FINAL) { q += __shfl_xor(q, 16); q += __shfl_xor(q, 32); if (fq == 0) ssq_out[(size_t)r * 16 + u.pn * 4 + wc] = q; }
            }
    }
};
struct EpiKVQ {
    static constexpr bool PERM = true, AFTER_DRAIN = false;
    bf16_t* KV; bf16_t* Q; const float* ssq; float* kw_p; float* vw_p; float* kw_s; float* vw_s;
    __device__ __forceinline__ void operator()(const f32x4 (&acc)[2][2][4][2], const Unit& u, int wr, int wc, int fr, int fq) const {
        const int row0 = u.pm * BM + wr * 64 + fr, colt = u.pn * BM + wc * 32 + 8 * fq;
        const bool iskv = u.pn < 2;
        float* const cp = (u.pn == 0) ? kw_p : vw_p; float* const cs = (u.pn == 0) ? kw_s : vw_s;
        const int ccol = wc * 32 + 8 * fq;
#pragma unroll
        for (int ai = 0; ai < 2; ++ai)
#pragma unroll
            for (int m = 0; m < 4; ++m) {
                const int r = row0 + ai * HALF + m * 16; const float rs = row_rstd(ssq, r, fq);
                if (iskv) {
                    long crow = -1;
                    if (r < MP_ROWS) { const int s = r & 2047; if (s >= 1920) crow = (long)(r >> 11) * 128 + (s - 1920); }
                    else { const int rr = r - MP_ROWS; crow = (long)(rr >> 3) * 128 + 120 + (rr & 7); }
                    float* const cbase = (r < MP_ROWS) ? cp : cs;
#pragma unroll
                    for (int bj = 0; bj < 2; ++bj) {
                        const f32x4 v0 = acc[ai][bj][m][0] * rs, v1 = acc[ai][bj][m][1] * rs;
                        *(u32x4*)(KV + (size_t)r * 512 + colt + bj * HALF) = pack8(v0, v1);
                        if (crow >= 0) { float* o = cbase + (size_t)crow * 256 + ccol + bj * HALF; *(f32x4*)o = v0; *(f32x4*)(o + 4) = v1; }
                    }
                } else {
                    const float sc = rs * 0.125f;
#pragma unroll
                    for (int bj = 0; bj < 2; ++bj)
                        *(u32x4*)(Q + (size_t)r * 1024 + (colt - 512) + bj * HALF) = pack8(acc[ai][bj][m][0] * sc, acc[ai][bj][m][1] * sc);
                }
            }
    }
};
template <class Epi, class Sched, bool ALIGN_EPI = false, bool SP2 = false>
__device__ __forceinline__ void gemm_phase(PG8_LAS unsigned char* lds, const Gemm g, const Sched& S, const Epi& E) {
    const int tid = threadIdx.x, wid = __builtin_amdgcn_readfirstlane(tid >> 6), lane = tid & 63, wr = wid >> 2, wc = wid & 3, fr = lane & 15, fq = lane >> 4;
    const int K = g.K, nt = K / BK;
    unsigned voffA[2], voffB[2];
#pragma unroll
    for (int i = 0; i < 2; ++i) { int R, C; stage_rc(tid * 16 + i * 8192, R, C); const int Rb = Epi::PERM ? ((R & ~31) + perm32(R & 31)) : R;
        voffA[i] = (unsigned)(R * K + C) * 2u; voffB[i] = (unsigned)(Rb * K + C) * 2u; }
    const size_t kstep = (size_t)(BK * 2);
    const size_t hstep = (size_t)HALF * K * 2;
    const size_t tstep = 2 * hstep;
    const unsigned ldsw = (unsigned)wid * 1024u;
    const int aoff = lds_byte(wr * 64 + fr, fq * 8), boff = lds_byte(wc * 32 + fr, fq * 8);
#define PG8_SA(b, h) (((b) * 2 + (h)) * HTB)
#define PG8_SB(b, h) ((4 + (b) * 2 + (h)) * HTB)
#define PG8_STAGE(bufoff, gbase, voff) do { _Pragma("unroll") for (int _i = 0; _i < 2; ++_i) \
        __builtin_amdgcn_global_load_lds((const unsigned*)((const char*)(gbase) + (voff)[_i]), (PG8_LAS unsigned*)(lds + (bufoff) + ldsw + _i * 8192), 16, 0, 0); } while (0)
#define PG8_LDA(dst, b, h) do { _Pragma("unroll") for (int m = 0; m < 4; ++m) _Pragma("unroll") for (int k = 0; k < 2; ++k) dst[m][k] = *(const PG8_LAS bf16x8*)(lds + PG8_SA(b, h) + aoff + m * 2048 + k * 1024); } while (0)
#define PG8_LDB(dst, b, h) do { _Pragma("unroll") for (int n = 0; n < 2; ++n) _Pragma("unroll") for (int k = 0; k < 2; ++k) dst[n][k] = *(const PG8_LAS bf16x8*)(lds + PG8_SB(b, h) + boff + n * 2048 + k * 1024); } while (0)
#define PG8_MMA(ai, bj, At, Bt) do { __builtin_amdgcn_s_setprio(1); _Pragma("unroll") for (int m = 0; m < 4; ++m) _Pragma("unroll") for (int n = 0; n < 2; ++n) _Pragma("unroll") for (int k = 0; k < 2; ++k) \
        acc[ai][bj][m][n] = __builtin_amdgcn_mfma_f32_16x16x32_bf16(Bt[n][k], At[m][k], acc[ai][bj][m][n], 0, 0, 0); __builtin_amdgcn_s_setprio(0); } while (0)
#define PG8_WAIT_V(n) asm volatile("s_waitcnt vmcnt(" #n ")" ::: "memory")
#define PG8_WAIT_L(n) asm volatile("s_waitcnt lgkmcnt(" #n ")" ::: "memory")
#define PG8_BAR __builtin_amdgcn_s_barrier()
#define PG8_SCHED __builtin_amdgcn_sched_barrier(0)
    Unit cur, nxt; int ui = 0;
    if (!S.next(0, cur)) return;
    f32x4 acc[2][2][4][2];
#pragma unroll
    for (int a = 0; a < 2; ++a)
#pragma unroll
        for (int b = 0; b < 2; ++b)
#pragma unroll
            for (int m = 0; m < 4; ++m)
#pragma unroll
                for (int n = 0; n < 2; ++n) acc[a][b][m][n] = (f32x4){0.f, 0.f, 0.f, 0.f};
    bf16x8 At[4][2], B0[2][2], B1[2][2];
    const char* cA = (const char*)g.A + (size_t)cur.pm * tstep; const char* cB = (const char*)g.Bt + (size_t)cur.pn * tstep;
    S.a_ready(cur);
    if constexpr (SP2) {
        PG8_STAGE(PG8_SB(0, 0), cB, voffB); PG8_STAGE(PG8_SB(0, 1), cB + hstep, voffB); PG8_STAGE(PG8_SA(0, 0), cA, voffA); PG8_STAGE(PG8_SA(0, 1), cA + hstep, voffA);
        if (wr == 1) PG8_BAR;
        PG8_WAIT_V(2); PG8_BAR;
        PG8_STAGE(PG8_SB(1, 0), cB + kstep, voffB); PG8_STAGE(PG8_SA(1, 0), cA + kstep, voffA); PG8_STAGE(PG8_SB(1, 1), cB + hstep + kstep, voffB);
        PG8_WAIT_V(6); PG8_BAR;
    } else {
        PG8_STAGE(PG8_SB(0, 0), cB, voffB); PG8_STAGE(PG8_SA(0, 0), cA, voffA); PG8_STAGE(PG8_SB(0, 1), cB + hstep, voffB); PG8_STAGE(PG8_SA(0, 1), cA + hstep, voffA);
        if (wr == 1) PG8_BAR;
        PG8_WAIT_V(4); PG8_BAR;
        PG8_STAGE(PG8_SB(1, 0), cB + kstep, voffB); PG8_STAGE(PG8_SA(1, 0), cA + kstep, voffA); PG8_STAGE(PG8_SB(1, 1), cB + hstep + kstep, voffB);
        PG8_WAIT_V(6); PG8_BAR;
    }
    for (;;) {
        const bool has_next = S.next(ui + 1, nxt);
        const char* nA = has_next ? (const char*)g.A + (size_t)nxt.pm * tstep : cA; const char* nB = has_next ? (const char*)g.Bt + (size_t)nxt.pn * tstep : cB;
        for (int t = 0; t < nt; t += 2) {
            const bool last = (t == nt - 2);
            const char* a1 = cA + (size_t)(t + 1) * kstep;
            const char* a2 = last ? nA : cA + (size_t)(t + 2) * kstep; const char* b2 = last ? nB : cB + (size_t)(t + 2) * kstep;
            const char* a3 = a2 + kstep; const char* b3 = b2 + kstep;
            if (last && has_next) S.a_ready(nxt);
            if constexpr (SP2) {
            PG8_LDB(B0, 0, 0); PG8_LDB(B1, 0, 1); PG8_SCHED; PG8_LDA(At, 0, 0); PG8_STAGE(PG8_SA(1, 1), a1 + hstep, voffA);
            PG8_WAIT_V(8); PG8_WAIT_L(0); PG8_BAR; PG8_MMA(0, 0, At, B0); PG8_MMA(0, 1, At, B1); PG8_BAR; PG8_SCHED;
            PG8_LDA(At, 0, 1); PG8_STAGE(PG8_SB(0, 0), b2, voffB); PG8_STAGE(PG8_SB(0, 1), b2 + hstep, voffB); PG8_STAGE(PG8_SA(0, 0), a2, voffA);
            PG8_WAIT_V(8); PG8_WAIT_L(0); PG8_BAR; PG8_MMA(1, 0, At, B0); PG8_MMA(1, 1, At, B1); PG8_BAR; PG8_SCHED;
            PG8_LDB(B0, 1, 0); PG8_LDB(B1, 1, 1); PG8_SCHED; PG8_LDA(At, 1, 0); PG8_STAGE(PG8_SA(0, 1), a2 + hstep, voffA);
            PG8_WAIT_V(8); PG8_WAIT_L(0); PG8_BAR; PG8_MMA(0, 0, At, B0); PG8_MMA(0, 1, At, B1); PG8_BAR; PG8_SCHED;
            PG8_LDA(At, 1, 1); PG8_STAGE(PG8_SB(1, 0), b3, voffB); PG8_STAGE(PG8_SB(1, 1), b3 + hstep, voffB); PG8_STAGE(PG8_SA(1, 0), a3, voffA);
            PG8_WAIT_V(8); PG8_WAIT_L(0); PG8_BAR; PG8_MMA(1, 0, At, B0); PG8_MMA(1, 1, At, B1); PG8_BAR; PG8_SCHED;
            } else {
            PG8_LDB(B0, 0, 0); PG8_SCHED; PG8_LDA(At, 0, 0); PG8_STAGE(PG8_SA(1, 1), a1 + hstep, voffA);
            PG8_WAIT_L(8); PG8_BAR; PG8_WAIT_L(0); PG8_MMA(0, 0, At, B0); PG8_BAR; PG8_SCHED;
            PG8_LDB(B1, 0, 1); PG8_STAGE(PG8_SB(0, 0), b2, voffB);
            PG8_BAR; PG8_WAIT_L(0); PG8_MMA(0, 1, At, B1); PG8_BAR;
            PG8_LDA(At, 0, 1); PG8_STAGE(PG8_SA(0, 0), a2, voffA);
            PG8_BAR; PG8_WAIT_L(0); PG8_MMA(1, 0, At, B0); PG8_BAR; PG8_SCHED;
            PG8_STAGE(PG8_SB(0, 1), b2 + hstep, voffB);
            PG8_WAIT_V(6); PG8_BAR; PG8_MMA(1, 1, At, B1); PG8_BAR;
            PG8_LDB(B0, 1, 0); PG8_SCHED; PG8_LDA(At, 1, 0); PG8_STAGE(PG8_SA(0, 1), a2 + hstep, voffA);
            PG8_WAIT_L(8); PG8_BAR; PG8_WAIT_L(0); PG8_MMA(0, 0, At, B0); PG8_BAR; PG8_SCHED;
            PG8_LDB(B1, 1, 1); PG8_STAGE(PG8_SB(1, 0), b3, voffB);
            PG8_BAR; PG8_WAIT_L(0); PG8_MMA(0, 1, At, B1); PG8_BAR;
            PG8_LDA(At, 1, 1); PG8_STAGE(PG8_SA(1, 0), a3, voffA);
            PG8_BAR; PG8_WAIT_L(0); PG8_MMA(1, 0, At, B0); PG8_BAR; PG8_SCHED;
            PG8_STAGE(PG8_SB(1, 1), b3 + hstep, voffB);
            PG8_WAIT_V(6); PG8_BAR; PG8_MMA(1, 1, At, B1); PG8_BAR;
            }
        }
        if constexpr (ALIGN_EPI) { if (wr == 0) PG8_BAR; }
        if constexpr (!Epi::AFTER_DRAIN) { E(acc, cur, wr, wc, fr, fq); S.done(cur); }
        if (!has_next) break;
#pragma unroll
        for (int a = 0; a < 2; ++a)
#pragma unroll
            for (int b = 0; b < 2; ++b)
#pragma unroll
                for (int m = 0; m < 4; ++m)
#pragma unroll
                    for (int n = 0; n < 2; ++n) acc[a][b][m][n] = (f32x4){0.f, 0.f, 0.f, 0.f};
        cur = nxt; cA = nA; cB = nB; ++ui;
        if constexpr (ALIGN_EPI) { if (wr == 1) PG8_BAR; }
    }
    PG8_WAIT_V(0);
    if constexpr (!ALIGN_EPI) { if (wr == 0) PG8_BAR; }
    PG8_BAR;
    if constexpr (Epi::AFTER_DRAIN) { E.fused(acc, cur, wr, wc, fr, fq, lds, wid, lane); S.done(cur); }
#undef PG8_SA
#undef PG8_SB
#undef PG8_STAGE
#undef PG8_LDA
#undef PG8_LDB
#undef PG8_MMA
#undef PG8_WAIT_V
#undef PG8_WAIT_L
#undef PG8_BAR
#undef PG8_SCHED
}
}
constexpr int NWAVES = 8;
constexpr int DM = 1024, MP = 32768, MS = 1024, MT = MP + MS;
constexpr int NIN = 4352;
constexpr int FFH = 2816;
constexpr size_t MiB = 1u << 20;
constexpr size_t WS_CTL = 0, CTL_ZERO_BYTES = 1 * MiB;
constexpr size_t WS_SSQX = 2 * MiB, WS_SSQA = 5 * MiB, WS_SSQB = 8 * MiB, WS_AB = 11 * MiB;
constexpr size_t WS_WIN = 16 * MiB, WS_WOUT = 25 * MiB, WS_WGU0 = 27 * MiB, WS_WGU1 = 38 * MiB, WS_WDN0 = 49 * MiB, WS_WDN1 = 55 * MiB,
                 WS_WGT0 = 61 * MiB, WS_WGT1 = 63 * MiB, WS_WPJ0 = 65 * MiB, WS_WPJ1 = 66 * MiB, WS_WKVQ = 67 * MiB, WS_WO = 70 * MiB;
constexpr size_t WS_PEB = 72 * MiB, WS_XB = 106 * MiB, WS_QKV = 172 * MiB, WS_Z = 370 * MiB, WS_OG = 436 * MiB, WS_END = 502 * MiB;
constexpr size_t WS_HA = WS_XB, WS_HB = WS_Z, WS_PP = WS_OG, WS_ACT = WS_QKV, WS_KV = 172 * MiB, WS_Q = 205 * MiB, WS_OB = 271 * MiB;
constexpr int CW_BAR = 4096;
constexpr size_t O_Y = 0, O_SDP = (size_t)MT * DM, O_SDS = O_SDP + 2097152, O_SCP = O_SDS + 16777216, O_SCS = O_SCP + 147456,
                 O_KWP = O_SCS + 1179648, O_KWS = O_KWP + 524288, O_VWP = O_KWS + 4194304, O_VWS = O_VWP + 524288, O_END = O_VWS + 4194304;
constexpr int RING_OFF = 0, RING_BYTES = 131072, LDSCTL_OFF = RING_BYTES, MISC_OFF = LDSCTL_OFF + 320, LDS_BYTES = 147456;

#define GAS __attribute__((address_space(1)))
#define LAS __attribute__((address_space(3)))
typedef unsigned short bf16;
typedef unsigned v4u __attribute__((ext_vector_type(4)));
typedef float f32x4 __attribute__((ext_vector_type(4)));
typedef GAS unsigned gu32;
#define RLX_AGENT __ATOMIC_RELAXED, __HIP_MEMORY_SCOPE_AGENT
#define LDS_WAIT() asm volatile("s_waitcnt lgkmcnt(0)" ::: "memory")
#define VM_WAIT() asm volatile("s_waitcnt vmcnt(0)" ::: "memory")
__device__ __forceinline__ unsigned f2bf(float f) { unsigned u = __builtin_bit_cast(unsigned, f); return (u + 0x7fffu + ((u >> 16) & 1u)) >> 16; }
__device__ __forceinline__ unsigned pk2(float lo, float hi) { return f2bf(lo) | (f2bf(hi) << 16); }
__device__ __forceinline__ float bf2f(unsigned short b) { return __uint_as_float((unsigned)b << 16); }
using pg8::sigmoidf_;
__device__ __forceinline__ float wave_sum(float v) {
#pragma unroll
    for (int o = 1; o < 64; o <<= 1) v += __shfl_xor(v, o);
    return v;
}
#define XB_TMO      128
#define XB_XCNT(j)  (256  + 64 * (j))
#define XB_XSUB(j)  (1280 + 64 * (j))
#define XB_XGEN(j)  (2304 + 64 * (j))
#define XB_TOP      3328
#define XB_TOPGEN   3392
#define XCD_BAR_WORDS 3456
#define XB_SPIN_CAP (1u << 18)

__device__ __forceinline__ unsigned xb_ld(unsigned* p)              { return __hip_atomic_load(p, __ATOMIC_RELAXED, __HIP_MEMORY_SCOPE_AGENT); }
__device__ __forceinline__ unsigned xb_add(unsigned* p, unsigned v) { return __hip_atomic_fetch_add(p, v, __ATOMIC_RELAXED, __HIP_MEMORY_SCOPE_AGENT); }
__device__ __forceinline__ unsigned xb_xcc_id() { return (unsigned)__builtin_amdgcn_s_getreg((3 << 11) | 20) & 0xFu; }
#define XB_SPIN(cond, bar) do { unsigned _sp = 0; while (cond) { __builtin_amdgcn_s_sleep(1); \
    if ((++_sp & 255u) == 0u) { if (xb_ld(&(bar)[XB_TMO])) break; if (_sp > XB_SPIN_CAP) { atomicAdd(&(bar)[XB_TMO], 1u); break; } } } } while (0)

struct XcdBarrier {
    unsigned* bar; unsigned x;
    volatile LAS unsigned* st;
};

__device__ __forceinline__ XcdBarrier xcd_barrier_post(unsigned* bar, volatile LAS unsigned* st) {
    XcdBarrier b; b.bar = bar; b.x = xb_xcc_id(); b.st = st;
    if (threadIdx.x == 0) (void)xb_add(&bar[XB_XCNT(b.x)], 1u);
    return b;
}
__device__ __forceinline__ void xcd_barrier_complete(unsigned* bar, unsigned x, unsigned& nloc, unsigned& nx) {
    const unsigned G = gridDim.x * gridDim.y * gridDim.z;
    unsigned sum, cnt, mine, sp = 0u;
    for (;;) {
        sum = 0u; cnt = 0u; mine = 0u;
#pragma unroll
        for (unsigned j = 0; j < 16; ++j) { const unsigned c = xb_ld(&bar[XB_XCNT(j)]); sum += c; cnt += (c > 0u) ? 1u : 0u; mine = (j == x) ? c : mine; }
        if (sum == G) break;
        __builtin_amdgcn_s_sleep(1);
        if ((++sp & 255u) == 0u) { if (xb_ld(&bar[XB_TMO])) break; if (sp > XB_SPIN_CAP) { atomicAdd(&bar[XB_TMO], 1u); break; } }
    }
    nloc = mine > 0u ? mine : 1u; nx = cnt > 0u ? cnt : 1u;
}

__device__ __forceinline__ void xcd_barrier(const XcdBarrier& b) {
    asm volatile("s_waitcnt vmcnt(0)" ::: "memory");
    __syncthreads();
    if (threadIdx.x == 0) {
        unsigned* bar = b.bar;
        __builtin_amdgcn_s_waitcnt(0);
        unsigned nloc = b.st[0], nx = b.st[1];
        if (nloc == 0u) { xcd_barrier_complete(bar, b.x, nloc, nx); b.st[0] = nloc; b.st[1] = nx; }
        const unsigned old = xb_add(&bar[XB_XSUB(b.x)], 1u);
        const unsigned gen = old / nloc;
        if (old + 1u == (gen + 1u) * nloc) {
            __builtin_amdgcn_fence(__ATOMIC_RELEASE, "agent");
            asm volatile("s_waitcnt vmcnt(0)" ::: "memory");
            const unsigned og = xb_add(&bar[XB_TOP], 1u);
            const unsigned tg = og / nx;
            if (og + 1u == (tg + 1u) * nx) xb_add(&bar[XB_TOPGEN], 1u);
            else XB_SPIN(xb_ld(&bar[XB_TOPGEN]) == tg, bar);
            __builtin_amdgcn_fence(__ATOMIC_ACQUIRE, "agent");
            xb_add(&bar[XB_XGEN(b.x)], 1u);
            asm volatile("s_waitcnt vmcnt(0)" ::: "memory");
        } else {
            XB_SPIN(xb_ld(&bar[XB_XGEN(b.x)]) == gen, bar);
            __builtin_amdgcn_fence(__ATOMIC_ACQUIRE, "agent");
            asm volatile("s_waitcnt vmcnt(0)" ::: "memory");
        }
    }
    __syncthreads();
}
struct Args { const float* in[28]; float* out; unsigned char* ws; int ph_lo, ph_hi; };
typedef const __attribute__((address_space(4))) Args* cargs_t;
__device__ __forceinline__ cargs_t argp() { cargs_t p = (cargs_t)__builtin_amdgcn_kernarg_segment_ptr(); asm volatile("" : "+s"(p)); return p; }
struct Frame {
    LAS unsigned char* lds;
    volatile LAS unsigned* MISC;
    gu32* ctl;
    int tid, lane, wave, vcu, G;
    const float* const* in;
};

__device__ __forceinline__ void p0_transpose_item(const float* W, int K, int N, const float* gain, bf16* WT, int drow0, LAS float* scr, int k0, int n0, int lane) {
#pragma unroll 8
    for (int i = 0; i < 32; ++i) { const int kk = 2 * i + (lane >> 5); float w = W[(size_t)(k0 + kk) * N + n0 + (lane & 31)]; if (gain) w *= gain[k0 + kk]; scr[kk * 33 + (lane & 31)] = w; }
    LDS_WAIT(); asm volatile("" ::: "memory");
    const int c = lane & 7;
#pragma unroll
    for (int j = 0; j < 4; ++j) { const int n = (lane >> 3) + 8 * j; const LAS float* s = scr + (8 * c) * 33 + n;
        v4u o; o.x = pk2(s[0 * 33], s[1 * 33]); o.y = pk2(s[2 * 33], s[3 * 33]); o.z = pk2(s[4 * 33], s[5 * 33]); o.w = pk2(s[6 * 33], s[7 * 33]);
        *(GAS v4u*)(WT + (size_t)(drow0 + n) * K + k0 + 8 * c) = o; }
    LDS_WAIT(); asm volatile("" ::: "memory");
}
struct WDesc { const float* W; const float* gain; bf16* WT; int K, N, Nuse, kind, roff; };
__device__ __forceinline__ void p0_weight(const WDesc& d, int item, LAS float* scr, int lane) {
    const int nblk = d.Nuse / 32, kb = item / nblk, nb = item % nblk, n0 = 32 * nb;
    int drow0;
    if (d.kind == 0) drow0 = d.roff + n0;
    else { const int up = n0 >= FFH, j = up ? n0 - FFH : n0; drow0 = (j >> 7) * 256 + (up ? 128 : 0) + (j & 127); }
    p0_transpose_item(d.W, d.K, d.N, d.gain, d.WT, drow0, scr, 64 * kb, n0, lane);
}
__device__ __forceinline__ void p0_prologue(Frame& F, cargs_t a) {
    unsigned char* ws = a->ws;
    LAS float* scr = (LAS float*)(F.lds + RING_OFF + F.wave * 16384);
    const int gw = F.vcu * NWAVES + F.wave, NGW = F.G * NWAVES;
    constexpr int NW = 13;
    int it0 = 0;
#pragma unroll 1
    for (int w = 0; w < NW; ++w) {
        WDesc d;
        switch (w) {
        case 0:  d = WDesc{a->in[9],  a->in[8],  (bf16*)(ws + WS_WIN),  1024, 4112, 4096, 0, 0}; break;
        case 1:  d = WDesc{a->in[14], nullptr,  (bf16*)(ws + WS_WOUT), 1024, 1024, 1024, 0, 0}; break;
        case 2:  d = WDesc{a->in[22], a->in[21], (bf16*)(ws + WS_WGU0), 1024, 5632, 5632, 1, 0}; break;
        case 3:  d = WDesc{a->in[22] + (size_t)1024 * 5632, a->in[21] + 1024, (bf16*)(ws + WS_WGU1), 1024, 5632, 5632, 1, 0}; break;
        case 4:  d = WDesc{a->in[23], nullptr,  (bf16*)(ws + WS_WDN0), 2816, 1024, 1024, 0, 0}; break;
        case 5:  d = WDesc{a->in[23] + (size_t)2816 * 1024, nullptr, (bf16*)(ws + WS_WDN1), 2816, 1024, 1024, 0, 0}; break;
        case 6:  d = WDesc{a->in[26], a->in[24], (bf16*)(ws + WS_WGT0), 1024, 1024, 1024, 0, 0}; break;
        case 7:  d = WDesc{a->in[26] + (size_t)1024 * 1024, a->in[24] + 1024, (bf16*)(ws + WS_WGT1), 1024, 1024, 1024, 0, 0}; break;
        case 8:  d = WDesc{a->in[25], nullptr,  (bf16*)(ws + WS_WPJ0), 256, 1024, 1024, 0, 0}; break;
        case 9:  d = WDesc{a->in[25] + (size_t)256 * 1024, nullptr, (bf16*)(ws + WS_WPJ1), 256, 1024, 1024, 0, 0}; break;
        case 10: d = WDesc{a->in[16], a->in[15], (bf16*)(ws + WS_WKVQ), 1024, 512, 512, 0, 0}; break;
        case 11: d = WDesc{a->in[18], a->in[17], (bf16*)(ws + WS_WKVQ), 1024, 1024, 1024, 0, 512}; break;
        default: d = WDesc{a->in[20], nullptr,  (bf16*)(ws + WS_WO),   1024, 1024, 1024, 0, 0}; break;
        }
        const int nitems = (d.K / 64) * (d.Nuse / 32);
        int first = (gw - (it0 % NGW) + NGW) % NGW;
        for (int item = first; item < nitems; item += NGW) p0_weight(d, item, scr, F.lane);
        it0 += nitems;
    }
    {
        bf16* WT = (bf16*)(ws + WS_WIN); const float* W = a->in[9]; const float* g = a->in[8];
        const int gt = (F.vcu * NWAVES + F.wave) * 64 + F.lane, NGT = F.G * NWAVES * 64;
        for (int e = gt; e < 256 * 1024; e += NGT) { const int n = 4096 + (e >> 10), k = e & 1023; WT[(size_t)n * 1024 + k] = (n < 4112) ? (bf16)f2bf(W[(size_t)k * 4112 + n] * g[k]) : (bf16)0; }
    }
    {
        bf16* XB = (bf16*)(ws + WS_XB); float* SSQ = (float*)(ws + WS_SSQX);
        for (int m = gw; m < MT; m += NGW) {
            const float* xrow = (m < MP) ? a->in[0] + (size_t)m * DM : a->in[1] + (size_t)(m - MP) * DM;
            const GAS f32x4* xr = (const GAS f32x4*)xrow + F.lane;
            f32x4 v[4]; float s = 0.f;
#pragma unroll
            for (int j = 0; j < 4; ++j) { v[j] = xr[64 * j]; s += (v[j].x * v[j].x + v[j].y * v[j].y) + (v[j].z * v[j].z + v[j].w * v[j].w); }
            s = wave_sum(s);
            GAS unsigned long long* o8 = (GAS unsigned long long*)(XB + (size_t)m * DM) + F.lane;
#pragma unroll
            for (int j = 0; j < 4; ++j) o8[64 * j] = (unsigned long long)pk2(v[j].x, v[j].y) | ((unsigned long long)pk2(v[j].z, v[j].w) << 32);
            if (F.lane < 16) SSQ[(size_t)m * 16 + F.lane] = (F.lane == 0) ? s : 0.f;
        }
    }
    {
        bf16* PEB = (bf16*)(ws + WS_PEB);
        const size_t gt = (size_t)(F.vcu * NWAVES + F.wave) * 64 + F.lane, NGT = (size_t)F.G * NWAVES * 64;
        const size_t nchunk = (size_t)2 * MT * 256 / 8;
        for (size_t c = gt; c < nchunk; c += NGT) {
            const size_t e = c * 8; const int l = (int)(e / ((size_t)MT * 256)); const size_t rem = e - (size_t)l * MT * 256; const size_t row = rem >> 8; const int col = (int)(rem & 255);
            const float* src = (row < (size_t)MP) ? a->in[6] + ((size_t)l * MP + row) * 256 + col : a->in[7] + ((size_t)l * MS + (row - MP)) * 256 + col;
            const f32x4 v0 = *(const GAS f32x4*)src, v1 = *(const GAS f32x4*)(src + 4);
            v4u o; o.x = pk2(v0.x, v0.y); o.y = pk2(v0.z, v0.w); o.z = pk2(v1.x, v1.y); o.w = pk2(v1.z, v1.w);
            *(GAS v4u*)(PEB + e) = o;
        }
    }
}

__device__ __forceinline__ void delta_seq_item(Frame& F, cargs_t a, int item) {
    unsigned char* ws = a->ws;
    const int tid = F.tid, kq = tid >> 7, v = tid & 127, wave = F.wave, lane = F.lane;
    const bool prompt = item < 128;
    int b, h, T; size_t rowbase;
    if (prompt) { b = item >> 3; h = item & 7; T = 2048; rowbase = (size_t)b * 2048; }
    else { const int it = item - 128; b = it >> 3; h = it & 7; T = 8; rowbase = (size_t)MP + (size_t)b * 8; }
    LAS float* L = (LAS float*)(F.lds + RING_OFF);
    LAS float* vec = L;
    LAS float* red = L + 384;
    LAS float* part = L + 512;
    LAS float* opart = L + 1024;
    LAS float* red2 = L + 1536;
    float S[32];
    if (prompt) {
#pragma unroll
        for (int i = 0; i < 32; ++i) S[i] = 0.f;
    } else {
        const float* sd = a->in[2] + ((size_t)(b * 8 + h) * 128 + 32 * kq) * 128 + v;
#pragma unroll
        for (int i = 0; i < 32; ++i) S[i] = sd[(size_t)i * 128];
    }
    const int ch = kq * 1024 + h * 128 + v;
    float cw0 = 0.f, cw1 = 0.f, cw2 = 0.f, cw3 = 0.f, xm3 = 0.f, xm2 = 0.f, xm1 = 0.f;
    if (kq < 3) {
        const float* cw = a->in[10];
        cw0 = cw[ch]; cw1 = cw[3072 + ch]; cw2 = cw[2 * 3072 + ch]; cw3 = cw[3 * 3072 + ch];
        if (!prompt) { const float* sc = a->in[3] + (size_t)b * 3 * 3072 + ch; xm3 = sc[0]; xm2 = sc[3072]; xm1 = sc[2 * 3072]; }
    }
    const float Aneg = -__expf(a->in[11][h]), dtb = a->in[12][h], outg = a->in[13][v];
    const bf16* xsrc = (kq < 3) ? (const bf16*)(ws + WS_QKV) + rowbase * 3072 + ch : (const bf16*)(ws + WS_Z) + rowbase * 1024 + h * 128 + v;
    const size_t xstride = (kq < 3) ? 3072 : 1024;
    const float* absrc = (const float*)(ws + WS_AB) + rowbase * 16 + h;
    bf16* og = (bf16*)(ws + WS_OG) + rowbase * 1024 + h * 128 + v;
    unsigned short xs[8]; float aa[8], bb[8];
#pragma unroll
    for (int j = 0; j < 8; ++j) { xs[j] = xsrc[(size_t)j * xstride]; aa[j] = absrc[(size_t)j * 16]; bb[j] = absrc[(size_t)j * 16 + 8]; }
    float o_prev = 0.f, z_prev = 0.f; bool have_prev = false;
    __syncthreads();
    for (int t0 = 0; t0 < T; t0 += 8) {
        unsigned short xc[8]; float ac[8], bc[8];
#pragma unroll
        for (int j = 0; j < 8; ++j) { xc[j] = xs[j]; ac[j] = aa[j]; bc[j] = bb[j]; }
        if (t0 + 8 < T) {
#pragma unroll
            for (int j = 0; j < 8; ++j) { xs[j] = xsrc[(size_t)(t0 + 8 + j) * xstride]; aa[j] = absrc[(size_t)(t0 + 8 + j) * 16]; bb[j] = absrc[(size_t)(t0 + 8 + j) * 16 + 8]; }
        }
#pragma unroll
        for (int tt = 0; tt < 8; ++tt) {
            const float x = bf2f(xc[tt]);
            float zcur = 0.f;
            if (kq < 3) {
                const float c = (xm3 * cw0 + xm2 * cw1) + (xm1 * cw2 + x * cw3);
                xm3 = xm2; xm2 = xm1; xm1 = x;
                const float s = c * sigmoidf_(c);
                vec[kq * 128 + v] = s;
                if (kq < 2) { const float q2 = wave_sum(s * s); if (lane == 0) red[wave] = q2; }
            } else zcur = x;
            __syncthreads();
            if (kq == 3 && have_prev) {
                const float tot = red2[0] + red2[1];
                const float ov = o_prev * rsqrtf(tot * (1.0f / 128.0f) + 1e-6f) * outg * (z_prev * sigmoidf_(z_prev));
                og[(size_t)(t0 + tt - 1) * 1024] = (bf16)f2bf(ov);
            }
            const float rq = rsqrtf(red[0] + red[1] + 1e-6f) * 0.08838834764831845f, rk = rsqrtf(red[2] + red[3] + 1e-6f);
            const float beta = sigmoidf_(bc[tt]);
            const float sp_in = ac[tt] + dtb; const float sp = (sp_in > 15.f) ? sp_in : log1pf(__expf(sp_in));
            const float adec = __expf(Aneg * sp);
            float kv[32];
            {
                float p = 0.f;
#pragma unroll
                for (int i = 0; i < 8; ++i) { const f32x4 k4 = *(const LAS f32x4*)(vec + 128 + 32 * kq + 4 * i); kv[4 * i] = k4[0]; kv[4 * i + 1] = k4[1]; kv[4 * i + 2] = k4[2]; kv[4 * i + 3] = k4[3];
                    p += (k4[0] * S[4 * i] + k4[1] * S[4 * i + 1]) + (k4[2] * S[4 * i + 2] + k4[3] * S[4 * i + 3]); }
                part[kq * 128 + v] = p;
            }
            __syncthreads();
            {
                const float kS = rk * ((part[v] + part[128 + v]) + (part[256 + v] + part[384 + v]));
                const float d = beta * (vec[256 + v] - adec * kS) * rk;
                float po = 0.f;
#pragma unroll
                for (int i = 0; i < 8; ++i) { const f32x4 q4 = *(const LAS f32x4*)(vec + 32 * kq + 4 * i);
#pragma unroll
                    for (int j = 0; j < 4; ++j) { S[4 * i + j] = adec * S[4 * i + j] + kv[4 * i + j] * d; po += q4[j] * S[4 * i + j]; } }
                opart[kq * 128 + v] = po * rq;
            }
            __syncthreads();
            if (kq == 3) {
                const float o = (opart[v] + opart[128 + v]) + (opart[256 + v] + opart[384 + v]);
                const float o2 = wave_sum(o * o); if (lane == 0) red2[wave - 6] = o2;
                o_prev = o; z_prev = zcur;
            }
            have_prev = true;
        }
    }
    __syncthreads();
    if (kq == 3) {
        const float tot = red2[0] + red2[1];
        const float ov = o_prev * rsqrtf(tot * (1.0f / 128.0f) + 1e-6f) * outg * (z_prev * sigmoidf_(z_prev));
        og[(size_t)(T - 1) * 1024] = (bf16)f2bf(ov);
    }
    {
        float* so = a->out + (prompt ? O_SDP : O_SDS) + ((size_t)(b * 8 + h) * 128 + 32 * kq) * 128 + v;
#pragma unroll
        for (int i = 0; i < 32; ++i) so[(size_t)i * 128] = S[i];
    }
}

__device__ __forceinline__ void attn_prompt_item(Frame& F, cargs_t a, int item) {
    unsigned char* ws = a->ws;
    const int qblk = item & 15, kvh = (item >> 4) & 3, b = item >> 6;
    const int tid = F.tid, wave = F.wave, lane = F.lane;
    LAS float* Kf = (LAS float*)(F.lds + RING_OFF);
    LAS float* Vf = Kf + 256 * 64;
    const bf16* KV = (const bf16*)(ws + WS_KV);
    __syncthreads();
    for (int idx = tid; idx < 256 * 16; idx += 512) {
        const int key = idx >> 4, c = idx & 15;
        const long srow = (long)qblk * 128 - 128 + key;
        f32x4 v0 = (f32x4){0.f, 0.f, 0.f, 0.f}, v1 = v0;
        if (srow >= 0) {
            const v4u w = *(const GAS v4u*)(KV + ((size_t)b * 2048 + (size_t)srow) * 512 + (c < 8 ? kvh * 64 + c * 8 : 256 + kvh * 64 + (c - 8) * 8));
            v0 = (f32x4){__uint_as_float(w.x << 16), __uint_as_float(w.x & 0xffff0000u), __uint_as_float(w.y << 16), __uint_as_float(w.y & 0xffff0000u)};
            v1 = (f32x4){__uint_as_float(w.z << 16), __uint_as_float(w.z & 0xffff0000u), __uint_as_float(w.w << 16), __uint_as_float(w.w & 0xffff0000u)};
        }
        LAS float* dst = (c < 8 ? Kf + key * 64 + c * 8 : Vf + key * 64 + (c - 8) * 8);
        *(LAS f32x4*)dst = v0; *(LAS f32x4*)(dst + 4) = v1;
    }
    __syncthreads();
    const int g = wave >> 1, qi = (wave & 1) * 64 + lane, head = kvh * 4 + g;
    const size_t row = (size_t)b * 2048 + (size_t)qblk * 128 + qi;
    float q[64];
    {
        const bf16* qp = (const bf16*)(ws + WS_Q) + row * 1024 + head * 64;
#pragma unroll
        for (int c = 0; c < 8; ++c) { const v4u w = *(const GAS v4u*)(qp + c * 8);
            q[c * 8 + 0] = __uint_as_float(w.x << 16); q[c * 8 + 1] = __uint_as_float(w.x & 0xffff0000u); q[c * 8 + 2] = __uint_as_float(w.y << 16); q[c * 8 + 3] = __uint_as_float(w.y & 0xffff0000u);
            q[c * 8 + 4] = __uint_as_float(w.z << 16); q[c * 8 + 5] = __uint_as_float(w.z & 0xffff0000u); q[c * 8 + 6] = __uint_as_float(w.w << 16); q[c * 8 + 7] = __uint_as_float(w.w & 0xffff0000u); }
    }
    float mrun = a->in[19][head], l = 1.0f;
    float acc[64];
#pragma unroll
    for (int d = 0; d < 64; ++d) acc[d] = 0.f;
    int jlo = (wave & 1) * 64; const int jhi = (wave & 1) * 64 + 192; if (qblk == 0 && jlo < 128) jlo = 128;
#pragma unroll 1
    for (int j = jlo; j < jhi; ++j) {
        const LAS float* kr = Kf + j * 64; float t = 0.f;
#pragma unroll
        for (int d = 0; d < 16; ++d) { const f32x4 k4 = *(const LAS f32x4*)(kr + 4 * d); t += (q[4 * d] * k4[0] + q[4 * d + 1] * k4[1]) + (q[4 * d + 2] * k4[2] + q[4 * d + 3] * k4[3]); }
        const bool ok = (j >= qi + 1) && (j <= qi + 128) && (qblk > 0 || j >= 128);
        t = ok ? t : -1e30f;
        if (t > mrun) {
            const float f = __expf(mrun - t); mrun = t; l *= f;
#pragma unroll
            for (int d = 0; d < 64; ++d) acc[d] *= f;
        }
        const float p = __expf(t - mrun); l += p;
        const LAS float* vr = Vf + j * 64;
#pragma unroll
        for (int d = 0; d < 16; ++d) { const f32x4 v4 = *(const LAS f32x4*)(vr + 4 * d); acc[4 * d] += p * v4[0]; acc[4 * d + 1] += p * v4[1]; acc[4 * d + 2] += p * v4[2]; acc[4 * d + 3] += p * v4[3]; }
    }
    const float inv = 1.0f / l;
    bf16* op = (bf16*)(ws + WS_OB) + row * 1024 + head * 64;
#pragma unroll
    for (int c = 0; c < 8; ++c) { v4u o; o.x = pk2(acc[c * 8] * inv, acc[c * 8 + 1] * inv); o.y = pk2(acc[c * 8 + 2] * inv, acc[c * 8 + 3] * inv); o.z = pk2(acc[c * 8 + 4] * inv, acc[c * 8 + 5] * inv); o.w = pk2(acc[c * 8 + 6] * inv, acc[c * 8 + 7] * inv); *(GAS v4u*)(op + c * 8) = o; }
}
__device__ __forceinline__ void attn_sample_item(Frame& F, cargs_t a, int item) {
    unsigned char* ws = a->ws;
    const int kvh = item & 3, b = item >> 2;
    const int tid = F.tid;
    LAS float* Kf = (LAS float*)(F.lds + RING_OFF);
    LAS float* Vf = Kf + 136 * 64;
    LAS float* Sc = Vf + 136 * 64;
    const bf16* KV = (const bf16*)(ws + WS_KV);
    __syncthreads();
    for (int idx = tid; idx < 128 * 32; idx += 512) {
        const int key = idx >> 5, c = idx & 31; const int isv = c >> 4, cc = c & 15;
        const float* src = a->in[isv ? 5 : 4] + ((size_t)(b * 128 + key) * 4 + kvh) * 64 + cc * 4;
        const f32x4 v = *(const GAS f32x4*)src;
        *(LAS f32x4*)((isv ? Vf : Kf) + key * 64 + cc * 4) = v;
        if (key >= 8) *(GAS f32x4*)(a->out + (isv ? O_VWS : O_KWS) + ((size_t)(b * 128 + key - 8) * 4 + kvh) * 64 + cc * 4) = v;
    }
    for (int idx = tid; idx < 8 * 16; idx += 512) {
        const int t = idx >> 4, c = idx & 15;
        const v4u w = *(const GAS v4u*)(KV + ((size_t)MP + (size_t)b * 8 + t) * 512 + (c < 8 ? kvh * 64 + c * 8 : 256 + kvh * 64 + (c - 8) * 8));
        LAS float* dst = (c < 8 ? Kf + (128 + t) * 64 + c * 8 : Vf + (128 + t) * 64 + (c - 8) * 8);
        *(LAS f32x4*)dst = (f32x4){__uint_as_float(w.x << 16), __uint_as_float(w.x & 0xffff0000u), __uint_as_float(w.y << 16), __uint_as_float(w.y & 0xffff0000u)};
        *(LAS f32x4*)(dst + 4) = (f32x4){__uint_as_float(w.z << 16), __uint_as_float(w.z & 0xffff0000u), __uint_as_float(w.w << 16), __uint_as_float(w.w & 0xffff0000u)};
    }
    __syncthreads();
    const int r = tid & 31, ks = tid >> 5;
    const int t = r >> 2, g = r & 3, head = kvh * 4 + g;
    const size_t row = (size_t)MP + (size_t)b * 8 + t;
    {
        float q[64];
        const bf16* qp = (const bf16*)(ws + WS_Q) + row * 1024 + head * 64;
#pragma unroll
        for (int c = 0; c < 8; ++c) { const v4u w = *(const GAS v4u*)(qp + c * 8);
            q[c * 8 + 0] = __uint_as_float(w.x << 16); q[c * 8 + 1] = __uint_as_float(w.x & 0xffff0000u); q[c * 8 + 2] = __uint_as_float(w.y << 16); q[c * 8 + 3] = __uint_as_float(w.y & 0xffff0000u);
            q[c * 8 + 4] = __uint_as_float(w.z << 16); q[c * 8 + 5] = __uint_as_float(w.z & 0xffff0000u); q[c * 8 + 6] = __uint_as_float(w.w << 16); q[c * 8 + 7] = __uint_as_float(w.w & 0xffff0000u); }
        for (int j = ks; j < 136; j += 16) {
            const LAS float* kr = Kf + j * 64; float s = 0.f;
#pragma unroll
            for (int d = 0; d < 16; ++d) { const f32x4 k4 = *(const LAS f32x4*)(kr + 4 * d); s += (q[4 * d] * k4[0] + q[4 * d + 1] * k4[1]) + (q[4 * d + 2] * k4[2] + q[4 * d + 3] * k4[3]); }
            const bool ok = (j < 128) ? (j >= t + 1) : (j - 128 <= t);
            Sc[r * 136 + j] = ok ? s : -1e30f;
        }
    }
    __syncthreads();
    {
        const float sink = a->in[19][head];
        float mx = sink;
        for (int j = 0; j < 136; ++j) mx = fmaxf(mx, Sc[r * 136 + j]);
        float l = __expf(sink - mx); f32x4 o = (f32x4){0.f, 0.f, 0.f, 0.f};
        for (int j = 0; j < 136; ++j) { const float p = __expf(Sc[r * 136 + j] - mx); l += p; const f32x4 v4 = *(const LAS f32x4*)(Vf + j * 64 + ks * 4); o += v4 * p; }
        const float inv = 1.0f / l;
        bf16* op = (bf16*)(ws + WS_OB) + row * 1024 + head * 64 + ks * 4;
        *(GAS unsigned long long*)op = (unsigned long long)pk2(o[0] * inv, o[1] * inv) | ((unsigned long long)pk2(o[2] * inv, o[3] * inv) << 32);
    }
}

__device__ __forceinline__ void final_norm(Frame& F, cargs_t a) {
    const int gw = F.vcu * NWAVES + F.wave, NGW = F.G * NWAVES;
    const GAS f32x4* gn = (const GAS f32x4*)a->in[27] + F.lane;
    f32x4 g[4];
#pragma unroll
    for (int j = 0; j < 4; ++j) g[j] = gn[64 * j];
    for (int m = gw; m < MT; m += NGW) {
        GAS f32x4* yr = (GAS f32x4*)(a->out + O_Y + (size_t)m * DM) + F.lane;
        f32x4 v[4]; float s = 0.f;
#pragma unroll
        for (int j = 0; j < 4; ++j) { v[j] = yr[64 * j]; s += (v[j].x * v[j].x + v[j].y * v[j].y) + (v[j].z * v[j].z + v[j].w * v[j].w); }
        const float rstd = rsqrtf(wave_sum(s) * (1.f / DM) + 1e-6f);
#pragma unroll
        for (int j = 0; j < 4; ++j) yr[64 * j] = v[j] * rstd * g[j];
    }
}
#ifndef MK_N_LAUNCHES
#define MK_N_LAUNCHES 1
#endif
constexpr int N_PHASES = 16;
constexpr int N_LAUNCHES = MK_N_LAUNCHES;

template <class Epi> __device__ __forceinline__ void run_gemm(Frame& F, const bf16* A, const bf16* Bt, int N, int K, const Epi& E) {
    pg8::Gemm g{A, Bt, MT, N, K}; pg8::StaticOrder S; S.init(MT, N, F.G, (int)blockIdx.x);
    pg8::gemm_phase<Epi, pg8::StaticOrder, true, true>(F.lds + RING_OFF, g, S, E);
}

__global__ void __launch_bounds__(NWAVES * 64, 2) yoco_fwd(Args args) {
    extern __shared__ __attribute__((aligned(16))) unsigned char lds[];
    Frame F;
    F.lds = (LAS unsigned char*)lds;
    F.MISC = (volatile LAS unsigned*)(F.lds + MISC_OFF);
    F.tid = threadIdx.x; F.lane = F.tid & 63; F.wave = __builtin_amdgcn_readfirstlane(F.tid >> 6);
    F.G = gridDim.x; { const int bx = blockIdx.x; F.vcu = (F.G % 8 == 0) ? (bx % 8) * (F.G / 8) + bx / 8 : bx; }
    F.ctl = (gu32*)(argp()->ws + WS_CTL);
    for (int u = F.tid; u < (LDS_BYTES - LDSCTL_OFF) / 4; u += NWAVES * 64) ((LAS unsigned*)(F.lds + LDSCTL_OFF))[u] = 0u;
    __syncthreads();
    XcdBarrier bar; bar.bar = (unsigned*)(F.ctl + CW_BAR); bar.x = 0; bar.st = nullptr;
    if (N_LAUNCHES == 1) bar = xcd_barrier_post((unsigned*)(F.ctl + CW_BAR), F.MISC + 8);
#define GRID_BAR() do { if (N_LAUNCHES == 1) xcd_barrier(bar); } while (0)
    const int lo = argp()->ph_lo, hi = argp()->ph_hi;
#ifndef PH_MASK
#define PH_MASK 0xffff
#endif
#define IN(k) (((PH_MASK >> (k)) & 1) && lo <= (k) && (k) < hi)
#define SEAM(k) do { if (IN(k) && IN((k) + 1)) GRID_BAR(); } while (0)
#define XB ((bf16*)(argp()->ws + WS_XB))
#define HA ((bf16*)(argp()->ws + WS_HA))
#define HB ((bf16*)(argp()->ws + WS_HB))
#define OG ((bf16*)(argp()->ws + WS_OG))
#define PP ((bf16*)(argp()->ws + WS_PP))
#define ACT ((bf16*)(argp()->ws + WS_ACT))
#define KVb ((bf16*)(argp()->ws + WS_KV))
#define Qb ((bf16*)(argp()->ws + WS_Q))
#define OB ((bf16*)(argp()->ws + WS_OB))
#define PEB ((bf16*)(argp()->ws + WS_PEB))
#define SSQX ((float*)(argp()->ws + WS_SSQX))
#define SSQA ((float*)(argp()->ws + WS_SSQA))
#define SSQB ((float*)(argp()->ws + WS_SSQB))

    if (IN(0)) { p0_prologue(F, argp()); } SEAM(0);
    if (IN(1)) { pg8::EpiQKV E{(bf16*)(argp()->ws + WS_QKV), (bf16*)(argp()->ws + WS_Z), (float*)(argp()->ws + WS_AB), SSQX, argp()->out + O_SCP, argp()->out + O_SCS};
                 run_gemm(F, XB, (const bf16*)(argp()->ws + WS_WIN), NIN, 1024, E); } SEAM(1);
    if (IN(2)) { for (int item = blockIdx.x; item < 128 + 1024; item += F.G) delta_seq_item(F, argp(), item); } SEAM(2);
    if (IN(3)) { pg8::EpiRes<true> E{argp()->in[0], argp()->in[1], nullptr, HA, SSQA}; run_gemm(F, OG, (const bf16*)(argp()->ws + WS_WOUT), 1024, 1024, E); } SEAM(3);
    if (IN(4)) { pg8::EpiGU E{ACT, SSQA}; run_gemm(F, HA, (const bf16*)(argp()->ws + WS_WGU0), 5632, 1024, E); } SEAM(4);
    if (IN(5)) { pg8::EpiRes<false> E{nullptr, nullptr, HA, HB, SSQB}; run_gemm(F, ACT, (const bf16*)(argp()->ws + WS_WDN0), 1024, FFH, E); } SEAM(5);
    if (IN(6)) { pg8::EpiPP E{PP}; run_gemm(F, PEB, (const bf16*)(argp()->ws + WS_WPJ0), 1024, 256, E); } SEAM(6);
    if (IN(7)) { pg8::EpiGate<false> E{SSQB, PP, HB, HA, SSQA, nullptr}; run_gemm(F, HB, (const bf16*)(argp()->ws + WS_WGT0), 1024, 1024, E); } SEAM(7);
    if (IN(8)) { pg8::EpiKVQ E{KVb, Qb, SSQA, argp()->out + O_KWP, argp()->out + O_VWP, argp()->out + O_KWS, argp()->out + O_VWS};
                 run_gemm(F, HA, (const bf16*)(argp()->ws + WS_WKVQ), 1536, 1024, E); } SEAM(8);
    if (IN(9)) { for (int item = blockIdx.x; item < 1024 + 512; item += F.G) { if (item < 1024) attn_prompt_item(F, argp(), item); else attn_sample_item(F, argp(), item - 1024); } } SEAM(9);
    if (IN(10)) { pg8::EpiRes<false> E{nullptr, nullptr, HA, HB, SSQB}; run_gemm(F, OB, (const bf16*)(argp()->ws + WS_WO), 1024, 1024, E); } SEAM(10);
    if (IN(11)) { pg8::EpiGU E{ACT, SSQB}; run_gemm(F, HB, (const bf16*)(argp()->ws + WS_WGU1), 5632, 1024, E); } SEAM(11);
    if (IN(12)) { pg8::EpiRes<false> E{nullptr, nullptr, HB, HA, SSQA}; run_gemm(F, ACT, (const bf16*)(argp()->ws + WS_WDN1), 1024, FFH, E); } SEAM(12);
    if (IN(13)) { pg8::EpiPP E{PP}; run_gemm(F, PEB + (size_t)MT * 256, (const bf16*)(argp()->ws + WS_WPJ1), 1024, 256, E); } SEAM(13);
    if (IN(14)) { pg8::EpiGate<true> E{SSQA, PP, HA, nullptr, nullptr, argp()->out + O_Y}; run_gemm(F, HA, (const bf16*)(argp()->ws + WS_WGT1), 1024, 1024, E); } SEAM(14);
    if (IN(15)) { final_norm(F, argp()); }
#undef IN
#undef SEAM
}

extern "C" void kernel_launch(void* const* d_in, const int* in_sizes, int n_in, void* d_out, int out_size, void* d_ws, size_t ws_size, hipStream_t stream) {
    static int grid = 0;
    if (grid == 0) {
        if (n_in != 28 || out_size != (int)O_END || ws_size < WS_END) { fprintf(stderr, "kernel_launch: unexpected shapes: n_in %d out %d ws %zu (need %zu)\n", n_in, out_size, ws_size, (size_t)WS_END); grid = -1; return; }
        int dev = 0, cus = 0;
        if (hipGetDevice(&dev) != hipSuccess || hipDeviceGetAttribute(&cus, hipDeviceAttributeMultiprocessorCount, dev) != hipSuccess) { grid = -1; return; }
        if (hipFuncSetAttribute((const void*)yoco_fwd, hipFuncAttributeMaxDynamicSharedMemorySize, LDS_BYTES) != hipSuccess) { fprintf(stderr, "kernel_launch: hipFuncSetAttribute failed\n"); grid = -1; return; }
        (void)hipGetLastError();
        grid = cus;
    }
    if (grid < 0) return;
    (void)hipMemsetAsync((char*)d_ws + WS_CTL, 0, CTL_ZERO_BYTES, stream);
    Args a{};
    for (int i = 0; i < 28; ++i) a.in[i] = (const float*)d_in[i];
    a.out = (float*)d_out; a.ws = (unsigned char*)d_ws;
    if (N_LAUNCHES == 1) { a.ph_lo = 0; a.ph_hi = N_PHASES; hipLaunchKernelGGL(yoco_fwd, dim3(grid), dim3(NWAVES * 64), LDS_BYTES, stream, a); }
    else for (int p = 0; p < N_PHASES; ++p) { a.ph_lo = p; a.ph_hi = p + 1; hipLaunchKernelGGL(yoco_fwd, dim3(grid), dim3(NWAVES * 64), LDS_BYTES, stream, a); }
}
```

```cpp
#include <hip/hip_runtime.h>
#include <cstdio>
#include <cstdint>
namespace pg8 {
#define PG8_LAS __attribute__((address_space(3)))
typedef unsigned short bf16_t;
typedef short bf16x8 __attribute__((ext_vector_type(8)));
typedef float f32x4 __attribute__((ext_vector_type(4)));
typedef unsigned u32x4 __attribute__((ext_vector_type(4)));
constexpr int BM = 256, BK = 64, HALF = 128, HTB = HALF * BK * 2  , STAGE_BYTES = 8 * HTB, NXCD = 8, WGM = 8;

__host__ __device__ __forceinline__ int lds_byte(int r, int c) { const int st = (r >> 4) * 2 + (c >> 5), rr = r & 15, cc = c & 31, ob = rr * 64 + cc * 2; return st * 1024 + (ob ^ (((ob >> 9) & 1) << 5)); }
__host__ __device__ __forceinline__ void stage_rc(int b, int& R, int& C) { const int st = b / 1024, sb = b % 1024, swz = sb ^ (((sb >> 9) & 1) << 5); R = (st >> 1) * 16 + swz / 64; C = (st & 1) * 32 + (swz % 64) / 2; }
__host__ __device__ __forceinline__ int perm32(int rho) { const int n = rho >> 4, i = rho & 15; return 8 * (i >> 2) + 4 * n + (i & 3); }

struct Unit { int pm, pn; };
struct Gemm { const bf16_t* A; const bf16_t* Bt; int M, N, K; };

struct StaticOrder {
    int nM, nN, nwg, G, c;
    __host__ __device__ void init(int M, int N, int G_, int c_) { nM = M / BM; nN = N / BM; nwg = nM * nN; G = G_; c = c_; }
    __host__ __device__ bool next(int i, Unit& u) const {
        const long L = (long)i * G + c; if (L >= nwg) return false;
        int wgid = (int)L; { const int q = nwg / NXCD, r = nwg % NXCD, xcd = wgid % NXCD, off = wgid / NXCD; wgid = (xcd < r ? xcd * (q + 1) : r * (q + 1) + (xcd - r) * q) + off; }
        const int nig = WGM * nN, gid = wgid / nig, fm = gid * WGM, gsz = (nM - fm) < WGM ? (nM - fm) : WGM;
        u.pm = fm + ((wgid % nig) % gsz); u.pn = (wgid % nig) / gsz; return true;
    }
    __device__ __forceinline__ void a_ready(const Unit&) const {}
    __device__ __forceinline__ void done(const Unit&) const {}
};

__device__ __forceinline__ unsigned cvt_pk_bf16(float lo, float hi) { unsigned r; asm volatile("v_cvt_pk_bf16_f32 %0, %1, %2" : "=v"(r) : "v"(lo), "v"(hi)); return r; }
__device__ __forceinline__ f32x4 bf_lo2(unsigned a, unsigned b) { return (f32x4){__uint_as_float(a << 16), __uint_as_float(a & 0xffff0000u), __uint_as_float(b << 16), __uint_as_float(b & 0xffff0000u)}; }
__device__ __forceinline__ u32x4 pack8(const f32x4 v0, const f32x4 v1) { u32x4 w; w.x = cvt_pk_bf16(v0[0], v0[1]); w.y = cvt_pk_bf16(v0[2], v0[3]); w.z = cvt_pk_bf16(v1[0], v1[1]); w.w = cvt_pk_bf16(v1[2], v1[3]); return w; }
__device__ __forceinline__ float dot4(const f32x4 a) { return (a[0] * a[0] + a[1] * a[1]) + (a[2] * a[2] + a[3] * a[3]); }
__device__ __forceinline__ float row_rstd(const float* ssq, int r, int fq) {
    const f32x4 p = *(const f32x4*)(ssq + (size_t)r * 16 + 4 * fq);
    float s = (p[0] + p[1]) + (p[2] + p[3]);
    s += __shfl_xor(s, 16); s += __shfl_xor(s, 32);
    return rsqrtf(s * (1.0f / 1024.0f) + 1e-6f);
}
__device__ __forceinline__ float sigmoidf_(float x) { return __builtin_amdgcn_rcpf(1.0f + __expf(-x)); }

constexpr int MP_ROWS = 32768;

struct EpiQKV {
    static constexpr bool PERM = true, AFTER_DRAIN = false;
    bf16_t* QKV; bf16_t* Z; float* AB; const float* ssq; float* sc_p; float* sc_s; bf16_t* halo;
    __device__ __forceinline__ void operator()(const f32x4 (&acc)[2][2][4][2], const Unit& u, int wr, int wc, int fr, int fq) const {
        const int row0 = u.pm * BM + wr * 64 + fr, colt = u.pn * BM + wc * 32 + 8 * fq;
#pragma unroll
        for (int ai = 0; ai < 2; ++ai)
#pragma unroll
            for (int m = 0; m < 4; ++m) {
                const int r = row0 + ai * HALF + m * 16; const float rs = row_rstd(ssq, r, fq);
#pragma unroll
                for (int bj = 0; bj < 2; ++bj) {
                    const int col = colt + bj * HALF; const f32x4 v0 = acc[ai][bj][m][0] * rs, v1 = acc[ai][bj][m][1] * rs;
                    if (u.pn < 12) {
                        const u32x4 pk = pack8(v0, v1);
                        *(u32x4*)(QKV + (size_t)r * 3072 + col) = pk;
                        if (r < MP_ROWS && (r & 63) >= 61) *(u32x4*)(halo + ((size_t)(r >> 6) * 3 + ((r & 63) - 61)) * 3072 + col) = pk;
                        if (r < MP_ROWS) { const int s = r & 2047; if (s >= 2045) { float* o = sc_p + ((size_t)((r >> 11) * 3 + (s - 2045))) * 3072 + col; *(f32x4*)o = v0; *(f32x4*)(o + 4) = v1; } }
                        else { const int rr = r - MP_ROWS, t = rr & 7; if (t >= 5) { float* o = sc_s + ((size_t)((rr >> 3) * 3 + (t - 5))) * 3072 + col; *(f32x4*)o = v0; *(f32x4*)(o + 4) = v1; } }
                    } else if (u.pn < 16) {
                        *(u32x4*)(Z + (size_t)r * 1024 + (col - 3072)) = pack8(v0, v1);
                    } else {
                        const int c = col - 4096; if (c < 16) { float* o = AB + (size_t)r * 16 + c; *(f32x4*)o = v0; *(f32x4*)(o + 4) = v1; }
                    }
                }
            }
    }
};
template <bool BASEF32> struct EpiRes {
    static constexpr bool PERM = true, AFTER_DRAIN = false;
    const float* xp; const float* xs; const bf16_t* hb; bf16_t* out; float* ssq_out;
    __device__ __forceinline__ void operator()(const f32x4 (&acc)[2][2][4][2], const Unit& u, int wr, int wc, int fr, int fq) const {
        const int row0 = u.pm * BM + wr * 64 + fr, colt = u.pn * BM + wc * 32 + 8 * fq;
#pragma unroll
        for (int ai = 0; ai < 2; ++ai)
#pragma unroll
            for (int m = 0; m < 4; ++m) {
                const int r = row0 + ai * HALF + m * 16; float q = 0.f;
#pragma unroll
                for (int bj = 0; bj < 2; ++bj) {
                    const int col = colt + bj * HALF; f32x4 b0, b1;
                    if (BASEF32) { const float* p = (r < MP_ROWS ? xp + (size_t)r * 1024 : xs + (size_t)(r - MP_ROWS) * 1024) + col; b0 = *(const f32x4*)p; b1 = *(const f32x4*)(p + 4); }
                    else { const u32x4 w = *(const u32x4*)(hb + (size_t)r * 1024 + col); b0 = bf_lo2(w.x, w.y); b1 = bf_lo2(w.z, w.w); }
                    const f32x4 v0 = acc[ai][bj][m][0] + b0, v1 = acc[ai][bj][m][1] + b1;
                    q += dot4(v0) + dot4(v1);
                    *(u32x4*)(out + (size_t)r * 1024 + col) = pack8(v0, v1);
                }
                q += __shfl_xor(q, 16); q += __shfl_xor(q, 32);
                if (fq == 0) ssq_out[(size_t)r * 16 + u.pn * 4 + wc] = q;
            }
    }
};
struct EpiGU {
    static constexpr bool PERM = true, AFTER_DRAIN = false;
    bf16_t* act; const float* ssq;
    __device__ __forceinline__ void operator()(const f32x4 (&acc)[2][2][4][2], const Unit& u, int wr, int wc, int fr, int fq) const {
        const int row0 = u.pm * BM + wr * 64 + fr, col = u.pn * HALF + wc * 32 + 8 * fq;
#pragma unroll
        for (int ai = 0; ai < 2; ++ai)
#pragma unroll
            for (int m = 0; m < 4; ++m) {
                const int r = row0 + ai * HALF + m * 16; const float rs = row_rstd(ssq, r, fq);
                f32x4 o[2];
#pragma unroll
                for (int n = 0; n < 2; ++n) {
                    const f32x4 g = acc[ai][0][m][n] * rs, up = acc[ai][1][m][n] * rs;
#pragma unroll
                    for (int j = 0; j < 4; ++j) o[n][j] = g[j] * sigmoidf_(g[j]) * up[j];
                }
                *(u32x4*)(act + (size_t)r * 2816 + col) = pack8(o[0], o[1]);
            }
    }
};
struct EpiPP {
    static constexpr bool PERM = true, AFTER_DRAIN = false;
    bf16_t* out;
    __device__ __forceinline__ void operator()(const f32x4 (&acc)[2][2][4][2], const Unit& u, int wr, int wc, int fr, int fq) const {
        const int row0 = u.pm * BM + wr * 64 + fr, colt = u.pn * BM + wc * 32 + 8 * fq;
#pragma unroll
        for (int ai = 0; ai < 2; ++ai)
#pragma unroll
            for (int m = 0; m < 4; ++m) {
                const int r = row0 + ai * HALF + m * 16;
#pragma unroll
                for (int bj = 0; bj < 2; ++bj) *(u32x4*)(out + (size_t)r * 1024 + colt + bj * HALF) = pack8(acc[ai][bj][m][0], acc[ai][bj][m][1]);
            }
    }
};
template <bool FINAL> struct EpiGate {
    static constexpr bool PERM = true, AFTER_DRAIN = false;
    const float* ssq_in; const bf16_t* pp; const bf16_t* hb; bf16_t* out; float* ssq_out; float* y;
    __device__ __forceinline__ void operator()(const f32x4 (&acc)[2][2][4][2], const Unit& u, int wr, int wc, int fr, int fq) const {
        const int row0 = u.pm * BM + wr * 64 + fr, colt = u.pn * BM + wc * 32 + 8 * fq;
#pragma unroll
        for (int ai = 0; ai < 2; ++ai)
#pragma unroll
            for (int m = 0; m < 4; ++m) {
                const int r = row0 + ai * HALF + m * 16; const float rs = row_rstd(ssq_in, r, fq); float q = 0.f;
#pragma unroll
                for (int bj = 0; bj < 2; ++bj) {
                    const int col = colt + bj * HALF;
                    const u32x4 wp = *(const u32x4*)(pp + (size_t)r * 1024 + col), wh = *(const u32x4*)(hb + (size_t)r * 1024 + col);
                    const f32x4 p0 = bf_lo2(wp.x, wp.y), p1 = bf_lo2(wp.z, wp.w), h0 = bf_lo2(wh.x, wh.y), h1 = bf_lo2(wh.z, wh.w);
                    f32x4 v0, v1;
#pragma unroll
                    for (int j = 0; j < 4; ++j) { v0[j] = h0[j] + p0[j] * sigmoidf_(acc[ai][bj][m][0][j] * rs); v1[j] = h1[j] + p1[j] * sigmoidf_(acc[ai][bj][m][1][j] * rs); }
                    if (FINAL) { float* o = y + (size_t)r * 1024 + col; *(f32x4*)o = v0; *(f32x4*)(o + 4) = v1; }
                    else { q += dot4(v0) + dot4(v1); *(u32x4*)(out + (size_t)r * 1024 + col) = pack8(v0, v1); }
                }
                if (!FINAL) { q += __shfl_xor(q, 16); q += __shfl_xor(q, 32); if (fq == 0) ssq_out[(size_t)r * 16 + u.pn * 4 + wc] = q; }
            }
    }
};
struct EpiKVQ {
    static constexpr bool PERM = true, AFTER_DRAIN = false;
    bf16_t* KV; bf16_t* Q; const float* ssq; float* kw_p; float* vw_p; float* kw_s; float* vw_s;
    __device__ __forceinline__ void operator()(const f32x4 (&acc)[2][2][4][2], const Unit& u, int wr, int wc, int fr, int fq) const {
        const int row0 = u.pm * BM + wr * 64 + fr, colt = u.pn * BM + wc * 32 + 8 * fq;
        const bool iskv = u.pn < 2;
        float* const cp = (u.pn == 0) ? kw_p : vw_p; float* const cs = (u.pn == 0) ? kw_s : vw_s;
        const int ccol = wc * 32 + 8 * fq;
#pragma unroll
        for (int ai = 0; ai < 2; ++ai)
#pragma unroll
            for (int m = 0; m < 4; ++m) {
                const int r = row0 + ai * HALF + m * 16; const float rs = row_rstd(ssq, r, fq);
                if (iskv) {
                    long crow = -1;
                    if (r < MP_ROWS) { const int s = r & 2047; if (s >= 1920) crow = (long)(r >> 11) * 128 + (s - 1920); }
                    else { const int rr = r - MP_ROWS; crow = (long)(rr >> 3) * 128 + 120 + (rr & 7); }
                    float* const cbase = (r < MP_ROWS) ? cp : cs;
#pragma unroll
                    for (int bj = 0; bj < 2; ++bj) {
                        const f32x4 v0 = acc[ai][bj][m][0] * rs, v1 = acc[ai][bj][m][1] * rs;
                        *(u32x4*)(KV + (size_t)r * 512 + colt + bj * HALF) = pack8(v0, v1);
                        if (crow >= 0) { float* o = cbase + (size_t)crow * 256 + ccol + bj * HALF; *(f32x4*)o = v0; *(f32x4*)(o + 4) = v1; }
                    }
                } else {
                    const float sc = rs * 0.125f;
#pragma unroll
                    for (int bj = 0; bj < 2; ++bj)
                        *(u32x4*)(Q + (size_t)r * 1024 + (colt - 512) + bj * HALF) = pack8(acc[ai][bj][m][0] * sc, acc[ai][bj][m][1] * sc);
                }
            }
    }
};
template <class Epi, class Sched, bool ALIGN_EPI = false, bool SP2 = false>
__device__ __forceinline__ void gemm_phase(PG8_LAS unsigned char* lds, const Gemm g, const Sched& S, const Epi& E) {
    int tid_ = threadIdx.x; asm volatile("" : "+v"(tid_));
    const int tid = tid_, wid = __builtin_amdgcn_readfirstlane(tid >> 6), lane = tid & 63, wr = wid >> 2, wc = wid & 3, fr = lane & 15, fq = lane >> 4;
    const int K = g.K, nt = K / BK;
    unsigned voffA[2], voffB[2];
#pragma unroll
    for (int i = 0; i < 2; ++i) { int R, C; stage_rc(tid * 16 + i * 8192, R, C); const int Rb = Epi::PERM ? ((R & ~31) + perm32(R & 31)) : R;
        voffA[i] = (unsigned)(R * K + C) * 2u; voffB[i] = (unsigned)(Rb * K + C) * 2u; }
    const size_t kstep = (size_t)(BK * 2);
    const size_t hstep = (size_t)HALF * K * 2;
    const size_t tstep = 2 * hstep;
    const unsigned ldsw = (unsigned)wid * 1024u;
    const int aoff = lds_byte(wr * 64 + fr, fq * 8), boff = lds_byte(wc * 32 + fr, fq * 8);
#define PG8_SA(b, h) (((b) * 2 + (h)) * HTB)
#define PG8_SB(b, h) ((4 + (b) * 2 + (h)) * HTB)
#define PG8_STAGE(bufoff, gbase, voff) do { _Pragma("unroll") for (int _i = 0; _i < 2; ++_i) \
        __builtin_amdgcn_global_load_lds((const unsigned*)((const char*)(gbase) + (voff)[_i]), (PG8_LAS unsigned*)(lds + (bufoff) + ldsw + _i * 8192), 16, 0, 0); } while (0)
#define PG8_LDA(dst, b, h) do { _Pragma("unroll") for (int m = 0; m < 4; ++m) _Pragma("unroll") for (int k = 0; k < 2; ++k) dst[m][k] = *(const PG8_LAS bf16x8*)(lds + PG8_SA(b, h) + aoff + m * 2048 + k * 1024); } while (0)
#define PG8_LDB(dst, b, h) do { _Pragma("unroll") for (int n = 0; n < 2; ++n) _Pragma("unroll") for (int k = 0; k < 2; ++k) dst[n][k] = *(const PG8_LAS bf16x8*)(lds + PG8_SB(b, h) + boff + n * 2048 + k * 1024); } while (0)
#define PG8_MMA(ai, bj, At, Bt) do { __builtin_amdgcn_s_setprio(1); _Pragma("unroll") for (int m = 0; m < 4; ++m) _Pragma("unroll") for (int n = 0; n < 2; ++n) _Pragma("unroll") for (int k = 0; k < 2; ++k) \
        acc[ai][bj][m][n] = __builtin_amdgcn_mfma_f32_16x16x32_bf16(Bt[n][k], At[m][k], acc[ai][bj][m][n], 0, 0, 0); __builtin_amdgcn_s_setprio(0); } while (0)
#define PG8_WAIT_V(n) asm volatile("s_waitcnt vmcnt(" #n ")" ::: "memory")
#define PG8_WAIT_L(n) asm volatile("s_waitcnt lgkmcnt(" #n ")" ::: "memory")
#define PG8_BAR __builtin_amdgcn_s_barrier()
#define PG8_SCHED __builtin_amdgcn_sched_barrier(0)
    Unit cur, nxt; int ui = 0;
    if (!S.next(0, cur)) return;
    f32x4 acc[2][2][4][2];
#pragma unroll
    for (int a = 0; a < 2; ++a)
#pragma unroll
        for (int b = 0; b < 2; ++b)
#pragma unroll
            for (int m = 0; m < 4; ++m)
#pragma unroll
                for (int n = 0; n < 2; ++n) acc[a][b][m][n] = (f32x4){0.f, 0.f, 0.f, 0.f};
    bf16x8 At[4][2], B0[2][2], B1[2][2];
    const char* cA = (const char*)g.A + (size_t)cur.pm * tstep; const char* cB = (const char*)g.Bt + (size_t)cur.pn * tstep;
    S.a_ready(cur);
    if constexpr (SP2) {
        PG8_STAGE(PG8_SB(0, 0), cB, voffB); PG8_STAGE(PG8_SB(0, 1), cB + hstep, voffB); PG8_STAGE(PG8_SA(0, 0), cA, voffA); PG8_STAGE(PG8_SA(0, 1), cA + hstep, voffA);
        if (wr == 1) PG8_BAR;
        PG8_WAIT_V(2); PG8_BAR;
        PG8_STAGE(PG8_SB(1, 0), cB + kstep, voffB); PG8_STAGE(PG8_SA(1, 0), cA + kstep, voffA); PG8_STAGE(PG8_SB(1, 1), cB + hstep + kstep, voffB);
        PG8_WAIT_V(6); PG8_BAR;
    } else {
        PG8_STAGE(PG8_SB(0, 0), cB, voffB); PG8_STAGE(PG8_SA(0, 0), cA, voffA); PG8_STAGE(PG8_SB(0, 1), cB + hstep, voffB); PG8_STAGE(PG8_SA(0, 1), cA + hstep, voffA);
        if (wr == 1) PG8_BAR;
        PG8_WAIT_V(4); PG8_BAR;
        PG8_STAGE(PG8_SB(1, 0), cB + kstep, voffB); PG8_STAGE(PG8_SA(1, 0), cA + kstep, voffA); PG8_STAGE(PG8_SB(1, 1), cB + hstep + kstep, voffB);
        PG8_WAIT_V(6); PG8_BAR;
    }
    for (;;) {
        const bool has_next = S.next(ui + 1, nxt);
        const char* nA = has_next ? (const char*)g.A + (size_t)nxt.pm * tstep : cA; const char* nB = has_next ? (const char*)g.Bt + (size_t)nxt.pn * tstep : cB;
        for (int t = 0; t < nt; t += 2) {
            const bool last = (t == nt - 2);
            const char* a1 = cA + (size_t)(t + 1) * kstep;
            const char* a2 = last ? nA : cA + (size_t)(t + 2) * kstep; const char* b2 = last ? nB : cB + (size_t)(t + 2) * kstep;
            const char* a3 = a2 + kstep; const char* b3 = b2 + kstep;
            if (last && has_next) S.a_ready(nxt);
            if constexpr (SP2) {
            PG8_LDB(B0, 0, 0); PG8_LDB(B1, 0, 1); PG8_SCHED; PG8_LDA(At, 0, 0); PG8_STAGE(PG8_SA(1, 1), a1 + hstep, voffA);
            PG8_WAIT_V(8); PG8_WAIT_L(0); PG8_BAR; PG8_MMA(0, 0, At, B0); PG8_MMA(0, 1, At, B1); PG8_BAR; PG8_SCHED;
            PG8_LDA(At, 0, 1); PG8_STAGE(PG8_SB(0, 0), b2, voffB); PG8_STAGE(PG8_SB(0, 1), b2 + hstep, voffB); PG8_STAGE(PG8_SA(0, 0), a2, voffA);
            PG8_WAIT_V(8); PG8_WAIT_L(0); PG8_BAR; PG8_MMA(1, 0, At, B0); PG8_MMA(1, 1, At, B1); PG8_BAR; PG8_SCHED;
            PG8_LDB(B0, 1, 0); PG8_LDB(B1, 1, 1); PG8_SCHED; PG8_LDA(At, 1, 0); PG8_STAGE(PG8_SA(0, 1), a2 + hstep, voffA);
            PG8_WAIT_V(8); PG8_WAIT_L(0); PG8_BAR; PG8_MMA(0, 0, At, B0); PG8_MMA(0, 1, At, B1); PG8_BAR; PG8_SCHED;
            PG8_LDA(At, 1, 1); PG8_STAGE(PG8_SB(1, 0), b3, voffB); PG8_STAGE(PG8_SB(1, 1), b3 + hstep, voffB); PG8_STAGE(PG8_SA(1, 0), a3, voffA);
            PG8_WAIT_V(8); PG8_WAIT_L(0); PG8_BAR; PG8_MMA(1, 0, At, B0); PG8_MMA(1, 1, At, B1); PG8_BAR; PG8_SCHED;
            } else {
            PG8_LDB(B0, 0, 0); PG8_SCHED; PG8_LDA(At, 0, 0); PG8_STAGE(PG8_SA(1, 1), a1 + hstep, voffA);
            PG8_WAIT_L(8); PG8_BAR; PG8_WAIT_L(0); PG8_MMA(0, 0, At, B0); PG8_BAR; PG8_SCHED;
            PG8_LDB(B1, 0, 1); PG8_STAGE(PG8_SB(0, 0), b2, voffB);
            PG8_BAR; PG8_WAIT_L(0); PG8_MMA(0, 1, At, B1); PG8_BAR;
            PG8_LDA(At, 0, 1); PG8_STAGE(PG8_SA(0, 0), a2, voffA);
            PG8_BAR; PG8_WAIT_L(0); PG8_MMA(1, 0, At, B0); PG8_BAR; PG8_SCHED;
            PG8_STAGE(PG8_SB(0, 1), b2 + hstep, voffB);
            PG8_WAIT_V(6); PG8_BAR; PG8_MMA(1, 1, At, B1); PG8_BAR;
            PG8_LDB(B0, 1, 0); PG8_SCHED; PG8_LDA(At, 1, 0); PG8_STAGE(PG8_SA(0, 1), a2 + hstep, voffA);
            PG8_WAIT_L(8); PG8_BAR; PG8_WAIT_L(0); PG8_MMA(0, 0, At, B0); PG8_BAR; PG8_SCHED;
            PG8_LDB(B1, 1, 1); PG8_STAGE(PG8_SB(1, 0), b3, voffB);
            PG8_BAR; PG8_WAIT_L(0); PG8_MMA(0, 1, At, B1); PG8_BAR;
            PG8_LDA(At, 1, 1); PG8_STAGE(PG8_SA(1, 0), a3, voffA);
            PG8_BAR; PG8_WAIT_L(0); PG8_MMA(1, 0, At, B0); PG8_BAR; PG8_SCHED;
            PG8_STAGE(PG8_SB(1, 1), b3 + hstep, voffB);
            PG8_WAIT_V(6); PG8_BAR; PG8_MMA(1, 1, At, B1); PG8_BAR;
            }
        }
        if constexpr (ALIGN_EPI) { if (wr == 0) PG8_BAR; }
        if constexpr (!Epi::AFTER_DRAIN) { E(acc, cur, wr, wc, fr, fq); S.done(cur); }
        if (!has_next) break;
#pragma unroll
        for (int a = 0; a < 2; ++a)
#pragma unroll
            for (int b = 0; b < 2; ++b)
#pragma unroll
                for (int m = 0; m < 4; ++m)
#pragma unroll
                    for (int n = 0; n < 2; ++n) acc[a][b][m][n] = (f32x4){0.f, 0.f, 0.f, 0.f};
        cur = nxt; cA = nA; cB = nB; ++ui;
        if constexpr (ALIGN_EPI) { if (wr == 1) PG8_BAR; }
    }
    PG8_WAIT_V(0);
    if constexpr (!ALIGN_EPI) { if (wr == 0) PG8_BAR; }
    PG8_BAR;
    if constexpr (Epi::AFTER_DRAIN) { E.fused(acc, cur, wr, wc, fr, fq, lds, wid, lane); S.done(cur); }
#undef PG8_SA
#undef PG8_SB
#undef PG8_STAGE
#undef PG8_LDA
#undef PG8_LDB
#undef PG8_MMA
#undef PG8_WAIT_V
#undef PG8_WAIT_L
#undef PG8_BAR
#undef PG8_SCHED
}
}
constexpr int NWAVES = 8;
constexpr int DM = 1024, MP = 32768, MS = 1024, MT = MP + MS;
constexpr int NIN = 4352;
constexpr int FFH = 2816;
constexpr size_t MiB = 1u << 20;
constexpr size_t WS_CTL = 0, CTL_ZERO_BYTES = 1 * MiB;
constexpr size_t WS_SSQX = 2 * MiB, WS_SSQA = 5 * MiB, WS_SSQB = 8 * MiB, WS_AB = 11 * MiB;
constexpr size_t WS_WIN = 16 * MiB, WS_WOUT = 25 * MiB, WS_WGU0 = 27 * MiB, WS_WGU1 = 38 * MiB, WS_WDN0 = 49 * MiB, WS_WDN1 = 55 * MiB,
                 WS_WGT0 = 61 * MiB, WS_WGT1 = 63 * MiB, WS_WPJ0 = 65 * MiB, WS_WPJ1 = 66 * MiB, WS_WKVQ = 67 * MiB, WS_WO = 70 * MiB;
constexpr size_t WS_PEB = 72 * MiB, WS_XB = 106 * MiB, WS_QKV = 172 * MiB, WS_Z = 370 * MiB, WS_END = 502 * MiB;
constexpr size_t WS_UTB = WS_XB, WS_OG = WS_UTB;
constexpr size_t WS_QKM = 436 * MiB, WS_SCL = 468 * MiB, WS_HALO = 471 * MiB;
constexpr size_t WS_HA = 436 * MiB, WS_HB = WS_Z, WS_PP = 106 * MiB, WS_ACT = WS_QKV, WS_KV = 172 * MiB, WS_Q = 205 * MiB, WS_OB = 271 * MiB;
constexpr int CW_BAR = 4096;
constexpr size_t O_Y = 0, O_SDP = (size_t)MT * DM, O_SDS = O_SDP + 2097152, O_SCP = O_SDS + 16777216, O_SCS = O_SCP + 147456,
                 O_KWP = O_SCS + 1179648, O_KWS = O_KWP + 524288, O_VWP = O_KWS + 4194304, O_VWS = O_VWP + 524288, O_END = O_VWS + 4194304;
constexpr int RING_OFF = 0, RING_BYTES = 131072, LDS_BYTES = 147456, LDSCTL_OFF = LDS_BYTES - 1024, MISC_OFF = LDSCTL_OFF + 320;

#define GAS __attribute__((address_space(1)))
#define LAS __attribute__((address_space(3)))
typedef unsigned short bf16;
typedef unsigned v4u __attribute__((ext_vector_type(4)));
typedef float f32x4 __attribute__((ext_vector_type(4)));
typedef GAS unsigned gu32;
#define RLX_AGENT __ATOMIC_RELAXED, __HIP_MEMORY_SCOPE_AGENT
#define LDS_WAIT() asm volatile("s_waitcnt lgkmcnt(0)" ::: "memory")
#define VM_WAIT() asm volatile("s_waitcnt vmcnt(0)" ::: "memory")
__device__ __forceinline__ unsigned f2bf(float f) { unsigned u = __builtin_bit_cast(unsigned, f); return (u + 0x7fffu + ((u >> 16) & 1u)) >> 16; }
__device__ __forceinline__ unsigned pk2(float lo, float hi) { return f2bf(lo) | (f2bf(hi) << 16); }
__device__ __forceinline__ float bf2f(unsigned short b) { return __uint_as_float((unsigned)b << 16); }
using pg8::sigmoidf_;
__device__ __forceinline__ float dot4s(const f32x4 a) { return (a[0] * a[0] + a[1] * a[1]) + (a[2] * a[2] + a[3] * a[3]); }
__device__ __forceinline__ float wave_sum(float v) {
#pragma unroll
    for (int o = 1; o < 64; o <<= 1) v += __shfl_xor(v, o);
    return v;
}
#define XB_TMO      128
#define XB_XCNT(j)  (256  + 64 * (j))
#define XB_XSUB(j)  (1280 + 64 * (j))
#define XB_XGEN(j)  (2304 + 64 * (j))
#define XB_TOP      3328
#define XB_TOPGEN   3392
#define XCD_BAR_WORDS 3456
#define XB_SPIN_CAP (1u << 18)

__device__ __forceinline__ unsigned xb_ld(unsigned* p)              { return __hip_atomic_load(p, __ATOMIC_RELAXED, __HIP_MEMORY_SCOPE_AGENT); }
__device__ __forceinline__ unsigned xb_add(unsigned* p, unsigned v) { return __hip_atomic_fetch_add(p, v, __ATOMIC_RELAXED, __HIP_MEMORY_SCOPE_AGENT); }
__device__ __forceinline__ unsigned xb_xcc_id() { return (unsigned)__builtin_amdgcn_s_getreg((3 << 11) | 20) & 0xFu; }
#define XB_SPIN(cond, bar) do { unsigned _sp = 0; while (cond) { __builtin_amdgcn_s_sleep(1); \
    if ((++_sp & 255u) == 0u) { if (xb_ld(&(bar)[XB_TMO])) break; if (_sp > XB_SPIN_CAP) { atomicAdd(&(bar)[XB_TMO], 1u); break; } } } } while (0)

struct XcdBarrier {
    unsigned* bar; unsigned x;
    volatile LAS unsigned* st;
};

__device__ __forceinline__ XcdBarrier xcd_barrier_post(unsigned* bar, volatile LAS unsigned* st) {
    XcdBarrier b; b.bar = bar; b.x = xb_xcc_id(); b.st = st;
    if (threadIdx.x == 0) (void)xb_add(&bar[XB_XCNT(b.x)], 1u);
    return b;
}
__device__ __forceinline__ void xcd_barrier_complete(unsigned* bar, unsigned x, unsigned& nloc, unsigned& nx) {
    const unsigned G = gridDim.x * gridDim.y * gridDim.z;
    unsigned sum, cnt, mine, sp = 0u;
    for (;;) {
        sum = 0u; cnt = 0u; mine = 0u;
#pragma unroll
        for (unsigned j = 0; j < 16; ++j) { const unsigned c = xb_ld(&bar[XB_XCNT(j)]); sum += c; cnt += (c > 0u) ? 1u : 0u; mine = (j == x) ? c : mine; }
        if (sum == G) break;
        __builtin_amdgcn_s_sleep(1);
        if ((++sp & 255u) == 0u) { if (xb_ld(&bar[XB_TMO])) break; if (sp > XB_SPIN_CAP) { atomicAdd(&bar[XB_TMO], 1u); break; } }
    }
    nloc = mine > 0u ? mine : 1u; nx = cnt > 0u ? cnt : 1u;
}

__device__ __forceinline__ void xcd_barrier(const XcdBarrier& b) {
    asm volatile("s_waitcnt vmcnt(0)" ::: "memory");
    __syncthreads();
    if (threadIdx.x == 0) {
        unsigned* bar = b.bar;
        __builtin_amdgcn_s_waitcnt(0);
        unsigned nloc = b.st[0], nx = b.st[1];
        if (nloc == 0u) { xcd_barrier_complete(bar, b.x, nloc, nx); b.st[0] = nloc; b.st[1] = nx; }
        const unsigned old = xb_add(&bar[XB_XSUB(b.x)], 1u);
        const unsigned gen = old / nloc;
        if (old + 1u == (gen + 1u) * nloc) {
            __builtin_amdgcn_fence(__ATOMIC_RELEASE, "agent");
            asm volatile("s_waitcnt vmcnt(0)" ::: "memory");
            const unsigned og = xb_add(&bar[XB_TOP], 1u);
            const unsigned tg = og / nx;
            if (og + 1u == (tg + 1u) * nx) xb_add(&bar[XB_TOPGEN], 1u);
            else XB_SPIN(xb_ld(&bar[XB_TOPGEN]) == tg, bar);
            __builtin_amdgcn_fence(__ATOMIC_ACQUIRE, "agent");
            xb_add(&bar[XB_XGEN(b.x)], 1u);
            asm volatile("s_waitcnt vmcnt(0)" ::: "memory");
        } else {
            XB_SPIN(xb_ld(&bar[XB_XGEN(b.x)]) == gen, bar);
            __builtin_amdgcn_fence(__ATOMIC_ACQUIRE, "agent");
            asm volatile("s_waitcnt vmcnt(0)" ::: "memory");
        }
    }
    __syncthreads();
}
struct Args { const float* in[28]; float* out; unsigned char* ws; int ph_lo, ph_hi, li, pad; };
typedef const __attribute__((address_space(4))) Args* cargs_t;
__device__ __forceinline__ cargs_t argp() { cargs_t p = (cargs_t)__builtin_amdgcn_kernarg_segment_ptr(); asm volatile("" : "+s"(p)); return p; }
struct Frame {
    LAS unsigned char* lds;
    volatile LAS unsigned* MISC;
    gu32* ctl;
    int tid, lane, wave, vcu, G;
    const float* const* in;
};

__device__ __forceinline__ void p0_transpose_item(const float* W, int K, int N, const float* gain, bf16* WT, int drow0, LAS float* scr, int k0, int n0, int lane) {
#pragma unroll 8
    for (int i = 0; i < 32; ++i) { const int kk = 2 * i + (lane >> 5); float w = W[(size_t)(k0 + kk) * N + n0 + (lane & 31)]; if (gain) w *= gain[k0 + kk]; scr[kk * 33 + (lane & 31)] = w; }
    LDS_WAIT(); asm volatile("" ::: "memory");
    const int c = lane & 7;
#pragma unroll
    for (int j = 0; j < 4; ++j) { const int n = (lane >> 3) + 8 * j; const LAS float* s = scr + (8 * c) * 33 + n;
        v4u o; o.x = pk2(s[0 * 33], s[1 * 33]); o.y = pk2(s[2 * 33], s[3 * 33]); o.z = pk2(s[4 * 33], s[5 * 33]); o.w = pk2(s[6 * 33], s[7 * 33]);
        *(GAS v4u*)(WT + (size_t)(drow0 + n) * K + k0 + 8 * c) = o; }
    LDS_WAIT(); asm volatile("" ::: "memory");
}
struct WDesc { const float* W; const float* gain; bf16* WT; int K, N, Nuse, kind, roff; };
__device__ __forceinline__ void p0_weight(const WDesc& d, int item, LAS float* scr, int lane) {
    const int nblk = d.Nuse / 32, kb = item / nblk, nb = item % nblk, n0 = 32 * nb;
    int drow0;
    if (d.kind == 0) drow0 = d.roff + n0;
    else { const int up = n0 >= FFH, j = up ? n0 - FFH : n0; drow0 = (j >> 7) * 256 + (up ? 128 : 0) + (j & 127); }
    p0_transpose_item(d.W, d.K, d.N, d.gain, d.WT, drow0, scr, 64 * kb, n0, lane);
}
__device__ __forceinline__ void p0_prologue(Frame& F, cargs_t a) {
    unsigned char* ws = a->ws;
    LAS float* scr = (LAS float*)(F.lds + RING_OFF + F.wave * 16384);
    const int gw = F.vcu * NWAVES + F.wave, NGW = F.G * NWAVES;
    constexpr int NW = 13;
    int it0 = 0;
#pragma unroll 1
    for (int w = 0; w < NW; ++w) {
        WDesc d;
        switch (w) {
        case 0:  d = WDesc{a->in[9],  a->in[8],  (bf16*)(ws + WS_WIN),  1024, 4112, 4096, 0, 0}; break;
        case 1:  d = WDesc{a->in[14], nullptr,  (bf16*)(ws + WS_WOUT), 1024, 1024, 1024, 0, 0}; break;
        case 2:  d = WDesc{a->in[22], a->in[21], (bf16*)(ws + WS_WGU0), 1024, 5632, 5632, 1, 0}; break;
        case 3:  d = WDesc{a->in[22] + (size_t)1024 * 5632, a->in[21] + 1024, (bf16*)(ws + WS_WGU1), 1024, 5632, 5632, 1, 0}; break;
        case 4:  d = WDesc{a->in[23], nullptr,  (bf16*)(ws + WS_WDN0), 2816, 1024, 1024, 0, 0}; break;
        case 5:  d = WDesc{a->in[23] + (size_t)2816 * 1024, nullptr, (bf16*)(ws + WS_WDN1), 2816, 1024, 1024, 0, 0}; break;
        case 6:  d = WDesc{a->in[26], a->in[24], (bf16*)(ws + WS_WGT0), 1024, 1024, 1024, 0, 0}; break;
        case 7:  d = WDesc{a->in[26] + (size_t)1024 * 1024, a->in[24] + 1024, (bf16*)(ws + WS_WGT1), 1024, 1024, 1024, 0, 0}; break;
        case 8:  d = WDesc{a->in[25], nullptr,  (bf16*)(ws + WS_WPJ0), 256, 1024, 1024, 0, 0}; break;
        case 9:  d = WDesc{a->in[25] + (size_t)256 * 1024, nullptr, (bf16*)(ws + WS_WPJ1), 256, 1024, 1024, 0, 0}; break;
        case 10: d = WDesc{a->in[16], a->in[15], (bf16*)(ws + WS_WKVQ), 1024, 512, 512, 0, 0}; break;
        case 11: d = WDesc{a->in[18], a->in[17], (bf16*)(ws + WS_WKVQ), 1024, 1024, 1024, 0, 512}; break;
        default: d = WDesc{a->in[20], nullptr,  (bf16*)(ws + WS_WO),   1024, 1024, 1024, 0, 0}; break;
        }
        const int nitems = (d.K / 64) * (d.Nuse / 32);
        int first = (gw - (it0 % NGW) + NGW) % NGW;
        for (int item = first; item < nitems; item += NGW) p0_weight(d, item, scr, F.lane);
        it0 += nitems;
    }
    {
        bf16* WT = (bf16*)(ws + WS_WIN); const float* W = a->in[9]; const float* g = a->in[8];
        const int gt = (F.vcu * NWAVES + F.wave) * 64 + F.lane, NGT = F.G * NWAVES * 64;
        for (int e = gt; e < 256 * 1024; e += NGT) { const int n = 4096 + (e >> 10), k = e & 1023; WT[(size_t)n * 1024 + k] = (n < 4112) ? (bf16)f2bf(W[(size_t)k * 4112 + n] * g[k]) : (bf16)0; }
    }
    {
        bf16* XB = (bf16*)(ws + WS_XB); float* SSQ = (float*)(ws + WS_SSQX);
        for (int m = gw; m < MT; m += NGW) {
            const float* xrow = (m < MP) ? a->in[0] + (size_t)m * DM : a->in[1] + (size_t)(m - MP) * DM;
            const GAS f32x4* xr = (const GAS f32x4*)xrow + F.lane;
            f32x4 v[4]; float s = 0.f;
#pragma unroll
            for (int j = 0; j < 4; ++j) { v[j] = xr[64 * j]; s += (v[j].x * v[j].x + v[j].y * v[j].y) + (v[j].z * v[j].z + v[j].w * v[j].w); }
            s = wave_sum(s);
            GAS unsigned long long* o8 = (GAS unsigned long long*)(XB + (size_t)m * DM) + F.lane;
#pragma unroll
            for (int j = 0; j < 4; ++j) o8[64 * j] = (unsigned long long)pk2(v[j].x, v[j].y) | ((unsigned long long)pk2(v[j].z, v[j].w) << 32);
            if (F.lane < 16) SSQ[(size_t)m * 16 + F.lane] = (F.lane == 0) ? s : 0.f;
        }
    }
    {
        bf16* PEB = (bf16*)(ws + WS_PEB);
        const size_t gt = (size_t)(F.vcu * NWAVES + F.wave) * 64 + F.lane, NGT = (size_t)F.G * NWAVES * 64;
        const size_t nchunk = (size_t)2 * MT * 256 / 8;
        for (size_t c = gt; c < nchunk; c += NGT) {
            const size_t e = c * 8; const int l = (int)(e / ((size_t)MT * 256)); const size_t rem = e - (size_t)l * MT * 256; const size_t row = rem >> 8; const int col = (int)(rem & 255);
            const float* src = (row < (size_t)MP) ? a->in[6] + ((size_t)l * MP + row) * 256 + col : a->in[7] + ((size_t)l * MS + (row - MP)) * 256 + col;
            const f32x4 v0 = *(const GAS f32x4*)src, v1 = *(const GAS f32x4*)(src + 4);
            v4u o; o.x = pk2(v0.x, v0.y); o.y = pk2(v0.z, v0.w); o.z = pk2(v1.x, v1.y); o.w = pk2(v1.z, v1.w);
            *(GAS v4u*)(PEB + e) = o;
        }
    }
}

__device__ __forceinline__ void delta_seq_item(Frame& F, cargs_t a, int item) {
    unsigned char* ws = a->ws;
    const int tid = F.tid, kq = tid >> 7, v = tid & 127, wave = F.wave, lane = F.lane;
    const bool prompt = item < 128;
    int b, h, T; size_t rowbase;
    if (prompt) { b = item >> 3; h = item & 7; T = 2048; rowbase = (size_t)b * 2048; }
    else { const int it = item - 128; b = it >> 3; h = it & 7; T = 8; rowbase = (size_t)MP + (size_t)b * 8; }
    LAS float* L = (LAS float*)(F.lds + RING_OFF);
    LAS float* vec = L;
    LAS float* red = L + 384;
    LAS float* part = L + 512;
    LAS float* opart = L + 1024;
    LAS float* red2 = L + 1536;
    float S[32];
    if (prompt) {
#pragma unroll
        for (int i = 0; i < 32; ++i) S[i] = 0.f;
    } else {
        const float* sd = a->in[2] + ((size_t)(b * 8 + h) * 128 + 32 * kq) * 128 + v;
#pragma unroll
        for (int i = 0; i < 32; ++i) S[i] = sd[(size_t)i * 128];
    }
    const int ch = kq * 1024 + h * 128 + v;
    float cw0 = 0.f, cw1 = 0.f, cw2 = 0.f, cw3 = 0.f, xm3 = 0.f, xm2 = 0.f, xm1 = 0.f;
    if (kq < 3) {
        const float* cw = a->in[10];
        cw0 = cw[ch]; cw1 = cw[3072 + ch]; cw2 = cw[2 * 3072 + ch]; cw3 = cw[3 * 3072 + ch];
        if (!prompt) { const float* sc = a->in[3] + (size_t)b * 3 * 3072 + ch; xm3 = sc[0]; xm2 = sc[3072]; xm1 = sc[2 * 3072]; }
    }
    const float Aneg = -__expf(a->in[11][h]), dtb = a->in[12][h], outg = a->in[13][v];
    const bf16* xsrc = (kq < 3) ? (const bf16*)(ws + WS_QKV) + rowbase * 3072 + ch : (const bf16*)(ws + WS_Z) + rowbase * 1024 + h * 128 + v;
    const size_t xstride = (kq < 3) ? 3072 : 1024;
    const float* absrc = (const float*)(ws + WS_AB) + rowbase * 16 + h;
    bf16* og = (bf16*)(ws + WS_OG) + rowbase * 1024 + h * 128 + v;
    unsigned short xs[8]; float aa[8], bb[8];
#pragma unroll
    for (int j = 0; j < 8; ++j) { xs[j] = xsrc[(size_t)j * xstride]; aa[j] = absrc[(size_t)j * 16]; bb[j] = absrc[(size_t)j * 16 + 8]; }
    float o_prev = 0.f, z_prev = 0.f; bool have_prev = false;
    __syncthreads();
    for (int t0 = 0; t0 < T; t0 += 8) {
        unsigned short xc[8]; float ac[8], bc[8];
#pragma unroll
        for (int j = 0; j < 8; ++j) { xc[j] = xs[j]; ac[j] = aa[j]; bc[j] = bb[j]; }
        if (t0 + 8 < T) {
#pragma unroll
            for (int j = 0; j < 8; ++j) { xs[j] = xsrc[(size_t)(t0 + 8 + j) * xstride]; aa[j] = absrc[(size_t)(t0 + 8 + j) * 16]; bb[j] = absrc[(size_t)(t0 + 8 + j) * 16 + 8]; }
        }
#pragma unroll
        for (int tt = 0; tt < 8; ++tt) {
            const float x = bf2f(xc[tt]);
            float zcur = 0.f;
            if (kq < 3) {
                const float c = (xm3 * cw0 + xm2 * cw1) + (xm1 * cw2 + x * cw3);
                xm3 = xm2; xm2 = xm1; xm1 = x;
                const float s = c * sigmoidf_(c);
                vec[kq * 128 + v] = s;
                if (kq < 2) { const float q2 = wave_sum(s * s); if (lane == 0) red[wave] = q2; }
            } else zcur = x;
            __syncthreads();
            if (kq == 3 && have_prev) {
                const float tot = red2[0] + red2[1];
                const float ov = o_prev * rsqrtf(tot * (1.0f / 128.0f) + 1e-6f) * outg * (z_prev * sigmoidf_(z_prev));
                og[(size_t)(t0 + tt - 1) * 1024] = (bf16)f2bf(ov);
            }
            const float rq = rsqrtf(red[0] + red[1] + 1e-6f) * 0.08838834764831845f, rk = rsqrtf(red[2] + red[3] + 1e-6f);
            const float beta = sigmoidf_(bc[tt]);
            const float sp_in = ac[tt] + dtb; const float sp = (sp_in > 15.f) ? sp_in : log1pf(__expf(sp_in));
            const float adec = __expf(Aneg * sp);
            float kv[32];
            {
                float p = 0.f;
#pragma unroll
                for (int i = 0; i < 8; ++i) { const f32x4 k4 = *(const LAS f32x4*)(vec + 128 + 32 * kq + 4 * i); kv[4 * i] = k4[0]; kv[4 * i + 1] = k4[1]; kv[4 * i + 2] = k4[2]; kv[4 * i + 3] = k4[3];
                    p += (k4[0] * S[4 * i] + k4[1] * S[4 * i + 1]) + (k4[2] * S[4 * i + 2] + k4[3] * S[4 * i + 3]); }
                part[kq * 128 + v] = p;
            }
            __syncthreads();
            {
                const float kS = rk * ((part[v] + part[128 + v]) + (part[256 + v] + part[384 + v]));
                const float d = beta * (vec[256 + v] - adec * kS) * rk;
                float po = 0.f;
#pragma unroll
                for (int i = 0; i < 8; ++i) { const f32x4 q4 = *(const LAS f32x4*)(vec + 32 * kq + 4 * i);
#pragma unroll
                    for (int j = 0; j < 4; ++j) { S[4 * i + j] = adec * S[4 * i + j] + kv[4 * i + j] * d; po += q4[j] * S[4 * i + j]; } }
                opart[kq * 128 + v] = po * rq;
            }
            __syncthreads();
            if (kq == 3) {
                const float o = (opart[v] + opart[128 + v]) + (opart[256 + v] + opart[384 + v]);
                const float o2 = wave_sum(o * o); if (lane == 0) red2[wave - 6] = o2;
                o_prev = o; z_prev = zcur;
            }
            have_prev = true;
        }
    }
    __syncthreads();
    if (kq == 3) {
        const float tot = red2[0] + red2[1];
        const float ov = o_prev * rsqrtf(tot * (1.0f / 128.0f) + 1e-6f) * outg * (z_prev * sigmoidf_(z_prev));
        og[(size_t)(T - 1) * 1024] = (bf16)f2bf(ov);
    }
    {
        float* so = a->out + (prompt ? O_SDP : O_SDS) + ((size_t)(b * 8 + h) * 128 + 32 * kq) * 128 + v;
#pragma unroll
        for (int i = 0; i < 32; ++i) so[(size_t)i * 128] = S[i];
    }
}

__device__ __forceinline__ void attn_prompt_item(Frame& F, cargs_t a, int item) {
    unsigned char* ws = a->ws;
    const int qblk = item & 15, kvh = (item >> 4) & 3, b = item >> 6;
    const int tid = F.tid, wave = F.wave, lane = F.lane;
    LAS float* Kf = (LAS float*)(F.lds + RING_OFF);
    LAS float* Vf = Kf + 256 * 64;
    const bf16* KV = (const bf16*)(ws + WS_KV);
    __syncthreads();
    for (int idx = tid; idx < 256 * 16; idx += 512) {
        const int key = idx >> 4, c = idx & 15;
        const long srow = (long)qblk * 128 - 128 + key;
        f32x4 v0 = (f32x4){0.f, 0.f, 0.f, 0.f}, v1 = v0;
        if (srow >= 0) {
            const v4u w = *(const GAS v4u*)(KV + ((size_t)b * 2048 + (size_t)srow) * 512 + (c < 8 ? kvh * 64 + c * 8 : 256 + kvh * 64 + (c - 8) * 8));
            v0 = (f32x4){__uint_as_float(w.x << 16), __uint_as_float(w.x & 0xffff0000u), __uint_as_float(w.y << 16), __uint_as_float(w.y & 0xffff0000u)};
            v1 = (f32x4){__uint_as_float(w.z << 16), __uint_as_float(w.z & 0xffff0000u), __uint_as_float(w.w << 16), __uint_as_float(w.w & 0xffff0000u)};
        }
        LAS float* dst = (c < 8 ? Kf + key * 64 + c * 8 : Vf + key * 64 + (c - 8) * 8);
        *(LAS f32x4*)dst = v0; *(LAS f32x4*)(dst + 4) = v1;
    }
    __syncthreads();
    const int g = wave >> 1, qi = (wave & 1) * 64 + lane, head = kvh * 4 + g;
    const size_t row = (size_t)b * 2048 + (size_t)qblk * 128 + qi;
    float q[64];
    {
        const bf16* qp = (const bf16*)(ws + WS_Q) + row * 1024 + head * 64;
#pragma unroll
        for (int c = 0; c < 8; ++c) { const v4u w = *(const GAS v4u*)(qp + c * 8);
            q[c * 8 + 0] = __uint_as_float(w.x << 16); q[c * 8 + 1] = __uint_as_float(w.x & 0xffff0000u); q[c * 8 + 2] = __uint_as_float(w.y << 16); q[c * 8 + 3] = __uint_as_float(w.y & 0xffff0000u);
            q[c * 8 + 4] = __uint_as_float(w.z << 16); q[c * 8 + 5] = __uint_as_float(w.z & 0xffff0000u); q[c * 8 + 6] = __uint_as_float(w.w << 16); q[c * 8 + 7] = __uint_as_float(w.w & 0xffff0000u); }
    }
    float mrun = a->in[19][head], l = 1.0f;
    float acc[64];
#pragma unroll
    for (int d = 0; d < 64; ++d) acc[d] = 0.f;
    int jlo = (wave & 1) * 64; const int jhi = (wave & 1) * 64 + 192; if (qblk == 0 && jlo < 128) jlo = 128;
#pragma unroll 1
    for (int j = jlo; j < jhi; ++j) {
        const LAS float* kr = Kf + j * 64; float t = 0.f;
#pragma unroll
        for (int d = 0; d < 16; ++d) { const f32x4 k4 = *(const LAS f32x4*)(kr + 4 * d); t += (q[4 * d] * k4[0] + q[4 * d + 1] * k4[1]) + (q[4 * d + 2] * k4[2] + q[4 * d + 3] * k4[3]); }
        const bool ok = (j >= qi + 1) && (j <= qi + 128) && (qblk > 0 || j >= 128);
        t = ok ? t : -1e30f;
        if (t > mrun) {
            const float f = __expf(mrun - t); mrun = t; l *= f;
#pragma unroll
            for (int d = 0; d < 64; ++d) acc[d] *= f;
        }
        const float p = __expf(t - mrun); l += p;
        const LAS float* vr = Vf + j * 64;
#pragma unroll
        for (int d = 0; d < 16; ++d) { const f32x4 v4 = *(const LAS f32x4*)(vr + 4 * d); acc[4 * d] += p * v4[0]; acc[4 * d + 1] += p * v4[1]; acc[4 * d + 2] += p * v4[2]; acc[4 * d + 3] += p * v4[3]; }
    }
    const float inv = 1.0f / l;
    bf16* op = (bf16*)(ws + WS_OB) + row * 1024 + head * 64;
#pragma unroll
    for (int c = 0; c < 8; ++c) { v4u o; o.x = pk2(acc[c * 8] * inv, acc[c * 8 + 1] * inv); o.y = pk2(acc[c * 8 + 2] * inv, acc[c * 8 + 3] * inv); o.z = pk2(acc[c * 8 + 4] * inv, acc[c * 8 + 5] * inv); o.w = pk2(acc[c * 8 + 6] * inv, acc[c * 8 + 7] * inv); *(GAS v4u*)(op + c * 8) = o; }
}
__device__ __forceinline__ void attn_sample_item(Frame& F, cargs_t a, int item) {
    unsigned char* ws = a->ws;
    const int kvh = item & 3, b = item >> 2;
    const int tid = F.tid;
    LAS float* Kf = (LAS float*)(F.lds + RING_OFF);
    LAS float* Vf = Kf + 136 * 64;
    LAS float* Sc = Vf + 136 * 64;
    const bf16* KV = (const bf16*)(ws + WS_KV);
    __syncthreads();
    for (int idx = tid; idx < 128 * 32; idx += 512) {
        const int key = idx >> 5, c = idx & 31; const int isv = c >> 4, cc = c & 15;
        const float* src = a->in[isv ? 5 : 4] + ((size_t)(b * 128 + key) * 4 + kvh) * 64 + cc * 4;
        const f32x4 v = *(const GAS f32x4*)src;
        *(LAS f32x4*)((isv ? Vf : Kf) + key * 64 + cc * 4) = v;
        if (key >= 8) *(GAS f32x4*)(a->out + (isv ? O_VWS : O_KWS) + ((size_t)(b * 128 + key - 8) * 4 + kvh) * 64 + cc * 4) = v;
    }
    for (int idx = tid; idx < 8 * 16; idx += 512) {
        const int t = idx >> 4, c = idx & 15;
        const v4u w = *(const GAS v4u*)(KV + ((size_t)MP + (size_t)b * 8 + t) * 512 + (c < 8 ? kvh * 64 + c * 8 : 256 + kvh * 64 + (c - 8) * 8));
        LAS float* dst = (c < 8 ? Kf + (128 + t) * 64 + c * 8 : Vf + (128 + t) * 64 + (c - 8) * 8);
        *(LAS f32x4*)dst = (f32x4){__uint_as_float(w.x << 16), __uint_as_float(w.x & 0xffff0000u), __uint_as_float(w.y << 16), __uint_as_float(w.y & 0xffff0000u)};
        *(LAS f32x4*)(dst + 4) = (f32x4){__uint_as_float(w.z << 16), __uint_as_float(w.z & 0xffff0000u), __uint_as_float(w.w << 16), __uint_as_float(w.w & 0xffff0000u)};
    }
    __syncthreads();
    const int r = tid & 31, ks = tid >> 5;
    const int t = r >> 2, g = r & 3, head = kvh * 4 + g;
    const size_t row = (size_t)MP + (size_t)b * 8 + t;
    {
        float q[64];
        const bf16* qp = (const bf16*)(ws + WS_Q) + row * 1024 + head * 64;
#pragma unroll
        for (int c = 0; c < 8; ++c) { const v4u w = *(const GAS v4u*)(qp + c * 8);
            q[c * 8 + 0] = __uint_as_float(w.x << 16); q[c * 8 + 1] = __uint_as_float(w.x & 0xffff0000u); q[c * 8 + 2] = __uint_as_float(w.y << 16); q[c * 8 + 3] = __uint_as_float(w.y & 0xffff0000u);
            q[c * 8 + 4] = __uint_as_float(w.z << 16); q[c * 8 + 5] = __uint_as_float(w.z & 0xffff0000u); q[c * 8 + 6] = __uint_as_float(w.w << 16); q[c * 8 + 7] = __uint_as_float(w.w & 0xffff0000u); }
        for (int j = ks; j < 136; j += 16) {
            const LAS float* kr = Kf + j * 64; float s = 0.f;
#pragma unroll
            for (int d = 0; d < 16; ++d) { const f32x4 k4 = *(const LAS f32x4*)(kr + 4 * d); s += (q[4 * d] * k4[0] + q[4 * d + 1] * k4[1]) + (q[4 * d + 2] * k4[2] + q[4 * d + 3] * k4[3]); }
            const bool ok = (j < 128) ? (j >= t + 1) : (j - 128 <= t);
            Sc[r * 136 + j] = ok ? s : -1e30f;
        }
    }
    __syncthreads();
    {
        const float sink = a->in[19][head];
        float mx = sink;
        for (int j = 0; j < 136; ++j) mx = fmaxf(mx, Sc[r * 136 + j]);
        float l = __expf(sink - mx); f32x4 o = (f32x4){0.f, 0.f, 0.f, 0.f};
        for (int j = 0; j < 136; ++j) { const float p = __expf(Sc[r * 136 + j] - mx); l += p; const f32x4 v4 = *(const LAS f32x4*)(Vf + j * 64 + ks * 4); o += v4 * p; }
        const float inv = 1.0f / l;
        bf16* op = (bf16*)(ws + WS_OB) + row * 1024 + head * 64 + ks * 4;
        *(GAS unsigned long long*)op = (unsigned long long)pk2(o[0] * inv, o[1] * inv) | ((unsigned long long)pk2(o[2] * inv, o[3] * inv) << 32);
    }
}

__device__ __forceinline__ void final_norm(Frame& F, cargs_t a) {
    const int gw = F.vcu * NWAVES + F.wave, NGW = F.G * NWAVES;
    const GAS f32x4* gn = (const GAS f32x4*)a->in[27] + F.lane;
    f32x4 g[4];
#pragma unroll
    for (int j = 0; j < 4; ++j) g[j] = gn[64 * j];
    for (int m = gw; m < MT; m += NGW) {
        GAS f32x4* yr = (GAS f32x4*)(a->out + O_Y + (size_t)m * DM) + F.lane;
        f32x4 v[4]; float s = 0.f;
#pragma unroll
        for (int j = 0; j < 4; ++j) { v[j] = yr[64 * j]; s += (v[j].x * v[j].x + v[j].y * v[j].y) + (v[j].z * v[j].z + v[j].w * v[j].w); }
        const float rstd = rsqrtf(wave_sum(s) * (1.f / DM) + 1e-6f);
#pragma unroll
        for (int j = 0; j < 4; ++j) yr[64 * j] = v[j] * rstd * g[j];
    }
}
typedef short bf16x8 __attribute__((ext_vector_type(8)));
typedef short bf16x4 __attribute__((ext_vector_type(4)));
typedef LAS const unsigned char* lcp;
constexpr int PREP_HALF = 71680;
constexpr int PL_KB = 0, PL_QB = 17408, PL_VB = 34816, PL_AM = 52224, PL_TB = 69632;
__device__ __forceinline__ unsigned cvtpk(float lo, float hi) { unsigned r; asm volatile("v_cvt_pk_bf16_f32 %0, %1, %2" : "=v"(r) : "v"(lo), "v"(hi)); return r; }
__device__ __forceinline__ f32x4 bfx4lo(unsigned a, unsigned b) { return (f32x4){__uint_as_float(a << 16), __uint_as_float(a & 0xffff0000u), __uint_as_float(b << 16), __uint_as_float(b & 0xffff0000u)}; }

__device__ __forceinline__ void dprep_pair(Frame& F, cargs_t a, int pair) {
    unsigned char* ws = a->ws;
    const int tid = F.tid, half = tid >> 8, t8 = tid & 255, lane = F.lane, w4 = (tid >> 6) & 3;
    const int item = 2 * pair + half, c = item & 31, h = (item >> 5) & 7, b = item >> 8;
    const size_t t0 = (size_t)b * 2048 + (size_t)c * 64; const int chunkg = b * 32 + c;
    LAS unsigned char* L = F.lds + RING_OFF + half * PREP_HALF;
    LAS float* TB = (LAS float*)(L + PL_TB);
    LAS float* AM = (LAS float*)(L + PL_AM);
    const bf16* QKV = (const bf16*)(ws + WS_QKV); const bf16* HALO = (const bf16*)(ws + WS_HALO);
    __syncthreads();
    {
        const int tg = t8 >> 4, cg = t8 & 15;
#pragma unroll 1
        for (int p = 0; p < 3; ++p) {
            const int colbase = p * 1024 + h * 128 + 8 * cg;
            v4u raw[7];
#pragma unroll
            for (int i = 0; i < 7; ++i) {
                const int lr = 4 * tg - 3 + i;
                if (lr >= 0) raw[i] = *(const GAS v4u*)(QKV + (t0 + lr) * 3072 + colbase);
                else if (c > 0) raw[i] = *(const GAS v4u*)(HALO + ((size_t)(chunkg - 1) * 3 + (lr + 3)) * 3072 + colbase);
                else raw[i] = (v4u){0u, 0u, 0u, 0u};
            }
            const float* cw = a->in[10] + colbase;
            f32x4 w[4][2];
#pragma unroll
            for (int k = 0; k < 4; ++k) { w[k][0] = *(const GAS f32x4*)(cw + k * 3072); w[k][1] = *(const GAS f32x4*)(cw + k * 3072 + 4); }
            f32x4 o[4][2];
#pragma unroll
            for (int tok = 0; tok < 4; ++tok) { o[tok][0] = (f32x4){0.f, 0.f, 0.f, 0.f}; o[tok][1] = o[tok][0]; }
#pragma unroll
            for (int i = 0; i < 7; ++i) {
                const f32x4 x0 = bfx4lo(raw[i].x, raw[i].y), x1 = bfx4lo(raw[i].z, raw[i].w);
#pragma unroll
                for (int tok = 0; tok < 4; ++tok) { const int k = i - tok; if (k >= 0 && k < 4) { o[tok][0] += x0 * w[k][0]; o[tok][1] += x1 * w[k][1]; } }
            }
            LAS unsigned char* dst = L + (p == 0 ? PL_QB : (p == 1 ? PL_KB : PL_VB));
#pragma unroll
            for (int tok = 0; tok < 4; ++tok) {
                float ss = 0.f;
#pragma unroll
                for (int e = 0; e < 4; ++e) { float x = o[tok][0][e]; x = x * sigmoidf_(x); o[tok][0][e] = x; ss += x * x; float y = o[tok][1][e]; y = y * sigmoidf_(y); o[tok][1][e] = y; ss += y * y; }
                if (p < 2) {
                    ss += __shfl_xor(ss, 1); ss += __shfl_xor(ss, 2); ss += __shfl_xor(ss, 4); ss += __shfl_xor(ss, 8);
                    const float rn = rsqrtf(ss + 1e-6f) * (p == 0 ? 0.08838834764831845f : 1.0f);
                    o[tok][0] = o[tok][0] * rn; o[tok][1] = o[tok][1] * rn;
                }
                v4u pk; pk.x = cvtpk(o[tok][0][0], o[tok][0][1]); pk.y = cvtpk(o[tok][0][2], o[tok][0][3]); pk.z = cvtpk(o[tok][1][0], o[tok][1][1]); pk.w = cvtpk(o[tok][1][2], o[tok][1][3]);
                *(LAS v4u*)(dst + (4 * tg + tok) * 272 + cg * 16) = pk;
            }
        }
    }
    if (w4 == 0) {
        const float* ab = (const float*)(ws + WS_AB) + (t0 + lane) * 16 + h;
        const float av = ab[0], bv = ab[8];
        const float Aneg = -__expf(a->in[11][h]), dtb = a->in[12][h];
        const float beta = sigmoidf_(bv);
        const float spi = av + dtb; const float sp = (spi > 15.f) ? spi : log1pf(__expf(spi));
        float gc = Aneg * sp;
#pragma unroll
        for (int o = 1; o < 64; o <<= 1) { const float t = __shfl_up(gc, o); if (lane >= o) gc += t; }
        const float glast = __shfl(gc, 63);
        const float eg = __expf(gc), ek = __expf(glast - gc);
        TB[lane] = beta; TB[64 + lane] = gc; TB[128 + lane] = eg; TB[192 + lane] = ek; TB[256 + lane] = beta; TB[320 + lane] = beta * eg;
        float* scl = (float*)(ws + WS_SCL) + ((size_t)chunkg * 8 + h) * 128;
        scl[lane] = eg; scl[64 + lane] = ek;
    }
    __syncthreads();
    {
        const int fr = lane & 15, fq = lane >> 4;
        f32x4 kk[4], qq[4];
#pragma unroll
        for (int nt = 0; nt < 4; ++nt) { kk[nt] = (f32x4){0.f, 0.f, 0.f, 0.f}; qq[nt] = kk[nt]; }
#pragma unroll
        for (int ks = 0; ks < 4; ++ks) {
            const bf16x8 ak = *(const LAS bf16x8*)(L + PL_KB + (16 * w4 + fr) * 272 + ks * 64 + fq * 16);
            const bf16x8 aq = *(const LAS bf16x8*)(L + PL_QB + (16 * w4 + fr) * 272 + ks * 64 + fq * 16);
#pragma unroll
            for (int nt = 0; nt < 4; ++nt) {
                const bf16x8 bk = *(const LAS bf16x8*)(L + PL_KB + (16 * nt + fr) * 272 + ks * 64 + fq * 16);
                kk[nt] = __builtin_amdgcn_mfma_f32_16x16x32_bf16(ak, bk, kk[nt], 0, 0, 0);
                qq[nt] = __builtin_amdgcn_mfma_f32_16x16x32_bf16(aq, bk, qq[nt], 0, 0, 0);
            }
        }
        bf16* QKM = (bf16*)(ws + WS_QKM);
#pragma unroll
        for (int j = 0; j < 4; ++j) {
            const int i = 16 * w4 + 4 * fq + j; const float gi = TB[64 + i], bi = TB[i];
#pragma unroll
            for (int nt = 0; nt < 4; ++nt) {
                const int jj = 16 * nt + fr; const float d = __expf(fminf(gi - TB[64 + jj], 0.f));
                AM[i * 68 + jj] = (i > jj) ? bi * kk[nt][j] * d : 0.f;
                QKM[(t0 + i) * 512 + h * 64 + jj] = (bf16)f2bf((i >= jj) ? qq[nt][j] * d : 0.f);
            }
        }
    }
    __syncthreads();
    {
        const bool isv = t8 < 128; const int col = t8 & 127;
        LAS const bf16* src = (LAS const bf16*)(L + (isv ? PL_VB : PL_KB)) + col;
        LAS const float* coef = TB + (isv ? 256 : 320);
        float x[64];
#pragma unroll
        for (int i = 0; i < 64; ++i) x[i] = 0.f;
#pragma unroll
        for (int i = 0; i < 64; ++i) {
            float r = bf2f(src[i * 136]) * coef[i];
#pragma unroll
            for (int j4 = 0; j4 < (i + 3) / 4; ++j4) {
                const f32x4 a4 = *(LAS const f32x4*)(AM + i * 68 + 4 * j4);
                r -= a4[0] * x[4 * j4]; r -= a4[1] * x[4 * j4 + 1]; r -= a4[2] * x[4 * j4 + 2]; r -= a4[3] * x[4 * j4 + 3];
            }
            x[i] = r;
        }
        if (isv) {
            bf16* ut = (bf16*)(ws + WS_UTB) + (t0 + (col >> 1)) * 1024 + h * 128 + (col & 1) * 64;
#pragma unroll
            for (int g = 0; g < 8; ++g) { v4u pk; pk.x = cvtpk(x[8 * g], x[8 * g + 1]); pk.y = cvtpk(x[8 * g + 2], x[8 * g + 3]); pk.z = cvtpk(x[8 * g + 4], x[8 * g + 5]); pk.w = cvtpk(x[8 * g + 6], x[8 * g + 7]); *(GAS v4u*)(ut + 8 * g) = pk; }
        } else {
            bf16* nw = (bf16*)(ws + WS_QKV) + t0 * 3072 + 2048 + h * 128 + col;
#pragma unroll
            for (int i = 0; i < 64; ++i) nw[(size_t)i * 3072] = (bf16)f2bf(-x[i]);
        }
    }
    {
        bf16* qd = (bf16*)(ws + WS_QKV) + t0 * 3072 + h * 128;
#pragma unroll
        for (int i = 0; i < 4; ++i) { const int ch = t8 + 256 * i, row = ch >> 4, cc = ch & 15; *(GAS v4u*)(qd + (size_t)row * 3072 + cc * 8) = *(const LAS v4u*)(L + PL_QB + row * 272 + cc * 16); }
        bf16* kd = (bf16*)(ws + WS_QKV) + t0 * 3072 + 1024 + h * 128;
        LAS const bf16* kb = (LAS const bf16*)(L + PL_KB);
#pragma unroll
        for (int i = 0; i < 4; ++i) {
            const int ch = t8 + 256 * i, k = ch >> 3, cgp = ch & 7;
            unsigned short e[8];
#pragma unroll
            for (int j = 0; j < 8; ++j) e[j] = kb[(8 * cgp + j) * 136 + k];
            v4u pk; pk.x = e[0] | ((unsigned)e[1] << 16); pk.y = e[2] | ((unsigned)e[3] << 16); pk.z = e[4] | ((unsigned)e[5] << 16); pk.w = e[6] | ((unsigned)e[7] << 16);
            *(GAS v4u*)(kd + (size_t)(k >> 1) * 3072 + (k & 1) * 64 + cgp * 8) = pk;
        }
    }
}

constexpr int SL_Q = 0, SL_W = 17408, SL_KT = 34816, SL_QK = 53248, SL_SC = 62464, SL_OT = 62976;
__device__ __forceinline__ bf16x8 frag2(LAS const unsigned char* p) {
    const bf16x4 lo = *(LAS const bf16x4*)p, hi = *(LAS const bf16x4*)(p + 32);
    return (bf16x8){lo[0], lo[1], lo[2], lo[3], hi[0], hi[1], hi[2], hi[3]};
}
__device__ __forceinline__ bf16x8 packB(const f32x4 lo, const f32x4 hi) {
    const unsigned a = cvtpk(lo[0], lo[1]), b = cvtpk(lo[2], lo[3]), c = cvtpk(hi[0], hi[1]), d = cvtpk(hi[2], hi[3]);
    return __builtin_bit_cast(bf16x8, (v4u){a, b, c, d});
}
__device__ __forceinline__ void dscan_item(Frame& F, cargs_t a, int item) {
    unsigned char* ws = a->ws;
    const int tid = F.tid, lane = F.lane, w = F.wave, fr = lane & 15, fq = lane >> 4;
    const int b = item >> 3, h = item & 7;
    const size_t tb = (size_t)b * 2048;
    LAS unsigned char* L = F.lds + RING_OFF;
    const bf16* QKV = (const bf16*)(ws + WS_QKV); const bf16* QKM = (const bf16*)(ws + WS_QKM); const bf16* UTB = (const bf16*)(ws + WS_UTB);
    const bf16* Zb = (const bf16*)(ws + WS_Z); const float* SCL = (const float*)(ws + WS_SCL);
    bf16* OGp = (bf16*)(ws + WS_OG);
    f32x4 S[8];
#pragma unroll
    for (int st = 0; st < 8; ++st) S[st] = (f32x4){0.f, 0.f, 0.f, 0.f};
    const int r0 = tid >> 4, c0 = tid & 15;
    const int r1 = tid >> 3, c1 = tid & 7;
    const int grow = tid >> 3, gcg = tid & 7;
    v4u pq[2], pw[2], pk[2], pqk, psc, pz[2]; unsigned long long put[4];
    const float* og_gain = a->in[13] + 16 * gcg;
#define DS_LOAD(ci) do { const size_t t0_ = tb + (size_t)(ci) * 64; \
        _Pragma("unroll") for (int i_ = 0; i_ < 2; ++i_) { const bf16* rp = QKV + (t0_ + r0 + 32 * i_) * 3072 + h * 128 + c0 * 8; pq[i_] = *(const GAS v4u*)rp; pk[i_] = *(const GAS v4u*)(rp + 1024); pw[i_] = *(const GAS v4u*)(rp + 2048); } \
        pqk = *(const GAS v4u*)(QKM + (t0_ + r1) * 512 + h * 64 + c1 * 8); \
        if (tid < 32) psc = *(const GAS v4u*)(SCL + ((size_t)(b * 32 + (ci)) * 8 + h) * 128 + tid * 4); \
        _Pragma("unroll") for (int i_ = 0; i_ < 2; ++i_) pz[i_] = *(const GAS v4u*)(Zb + (t0_ + grow) * 1024 + h * 128 + gcg * 16 + i_ * 8); \
        { const int v_ = 16 * w + fr; const bf16* up = UTB + (t0_ + (v_ >> 1)) * 1024 + h * 128 + (v_ & 1) * 64 + 4 * fq; \
          _Pragma("unroll") for (int mt_ = 0; mt_ < 4; ++mt_) put[mt_] = *(const GAS unsigned long long*)(up + 16 * mt_); } } while (0)
    DS_LOAD(0);
    v4u zprev[2] = {pz[0], pz[1]};
#pragma unroll 1
    for (int ci = 0; ci <= 32; ++ci) {
        __syncthreads();
        f32x4 u[4];
        if (ci < 32) {
#pragma unroll
            for (int i = 0; i < 2; ++i) {
                *(LAS v4u*)(L + SL_Q + (r0 + 32 * i) * 272 + c0 * 16) = pq[i];
                *(LAS v4u*)(L + SL_W + (r0 + 32 * i) * 272 + c0 * 16) = pw[i];
                { const int kr = 2 * (r0 + 32 * i) + (c0 >> 3); *(LAS v4u*)(L + SL_KT + kr * 144 + (c0 & 7) * 16) = pk[i]; }
            }
            *(LAS v4u*)(L + SL_QK + r1 * 144 + c1 * 16) = pqk;
            if (tid < 32) *(LAS v4u*)(L + SL_SC + tid * 16) = psc;
#pragma unroll
            for (int mt = 0; mt < 4; ++mt) u[mt] = bfx4lo((unsigned)put[mt], (unsigned)(put[mt] >> 32));
        }
        if (ci > 0) {
            const v4u o0 = *(const LAS v4u*)(L + SL_OT + grow * 272 + gcg * 32), o1 = *(const LAS v4u*)(L + SL_OT + grow * 272 + gcg * 32 + 16);
            f32x4 ov[4] = {bfx4lo(o0.x, o0.y), bfx4lo(o0.z, o0.w), bfx4lo(o1.x, o1.y), bfx4lo(o1.z, o1.w)};
            float ss = (dot4s(ov[0]) + dot4s(ov[1])) + (dot4s(ov[2]) + dot4s(ov[3]));
            ss += __shfl_xor(ss, 1); ss += __shfl_xor(ss, 2); ss += __shfl_xor(ss, 4);
            const float rn = rsqrtf(ss * (1.0f / 128.0f) + 1e-6f);
            const f32x4 zv[4] = {bfx4lo(zprev[0].x, zprev[0].y), bfx4lo(zprev[0].z, zprev[0].w), bfx4lo(zprev[1].x, zprev[1].y), bfx4lo(zprev[1].z, zprev[1].w)};
            unsigned pkd[8];
#pragma unroll
            for (int q4 = 0; q4 < 4; ++q4) {
                const f32x4 gn = *(const GAS f32x4*)(og_gain + 4 * q4); f32x4 r;
#pragma unroll
                for (int e = 0; e < 4; ++e) { const float z = zv[q4][e]; r[e] = ov[q4][e] * rn * gn[e] * (z * sigmoidf_(z)); }
                pkd[2 * q4] = cvtpk(r[0], r[1]); pkd[2 * q4 + 1] = cvtpk(r[2], r[3]);
            }
            bf16* op = OGp + (tb + (size_t)(ci - 1) * 64 + grow) * 1024 + h * 128 + gcg * 16;
            *(GAS v4u*)op = (v4u){pkd[0], pkd[1], pkd[2], pkd[3]}; *(GAS v4u*)(op + 8) = (v4u){pkd[4], pkd[5], pkd[6], pkd[7]};
        }
        if (ci == 32) break;
        zprev[0] = pz[0]; zprev[1] = pz[1];
        if (ci + 1 < 32) DS_LOAD(ci + 1);
        __syncthreads();
        bf16x8 sb[4];
#pragma unroll
        for (int ks = 0; ks < 4; ++ks) sb[ks] = packB(S[2 * ks], S[2 * ks + 1]);
        f32x4 o[4];
        lcp wbase = (lcp)(L + SL_W + fr * 272 + fq * 8), qbase = (lcp)(L + SL_Q + fr * 272 + fq * 8);
#pragma unroll
        for (int mt = 0; mt < 4; ++mt) {
            o[mt] = (f32x4){0.f, 0.f, 0.f, 0.f};
#pragma unroll
            for (int ks = 0; ks < 4; ++ks) {
                u[mt] = __builtin_amdgcn_mfma_f32_16x16x32_bf16(frag2(wbase + mt * 16 * 272 + ks * 64), sb[ks], u[mt], 0, 0, 0);
                o[mt] = __builtin_amdgcn_mfma_f32_16x16x32_bf16(frag2(qbase + mt * 16 * 272 + ks * 64), sb[ks], o[mt], 0, 0, 0);
            }
        }
        LAS const float* sc = (LAS const float*)(L + SL_SC);
        const float gl = sc[63];
        bf16x8 ub[2], ub2[2];
        {
            f32x4 us[4];
#pragma unroll
            for (int mt = 0; mt < 4; ++mt) { const f32x4 eg = *(LAS const f32x4*)(sc + 16 * mt + 4 * fq), ek = *(LAS const f32x4*)(sc + 64 + 16 * mt + 4 * fq); o[mt] = o[mt] * eg; us[mt] = u[mt] * ek; }
            ub[0] = packB(u[0], u[1]); ub[1] = packB(u[2], u[3]); ub2[0] = packB(us[0], us[1]); ub2[1] = packB(us[2], us[3]);
        }
        lcp kbase = (lcp)(L + SL_QK + fr * 144 + fq * 8), tbase = (lcp)(L + SL_KT + fr * 144 + fq * 8);
#pragma unroll
        for (int mt = 0; mt < 4; ++mt)
#pragma unroll
            for (int ks = 0; ks < 2; ++ks) o[mt] = __builtin_amdgcn_mfma_f32_16x16x32_bf16(frag2(kbase + mt * 16 * 144 + ks * 64), ub[ks], o[mt], 0, 0, 0);
#pragma unroll
        for (int st = 0; st < 8; ++st) {
            S[st] = S[st] * gl;
#pragma unroll
            for (int ks = 0; ks < 2; ++ks) S[st] = __builtin_amdgcn_mfma_f32_16x16x32_bf16(frag2(tbase + st * 16 * 144 + ks * 64), ub2[ks], S[st], 0, 0, 0);
        }
        LAS bf16* ot = (LAS bf16*)(L + SL_OT) + 16 * w + fr;
#pragma unroll
        for (int mt = 0; mt < 4; ++mt)
#pragma unroll
            for (int j = 0; j < 4; ++j) ot[(16 * mt + 4 * fq + j) * 136] = (bf16)f2bf(o[mt][j]);
    }
#undef DS_LOAD
    float* so = a->out + O_SDP + ((size_t)(b * 8 + h) * 128) * 128 + 16 * w + fr;
#pragma unroll
    for (int st = 0; st < 8; ++st)
#pragma unroll
        for (int j = 0; j < 4; ++j) so[(size_t)(16 * st + 4 * fq + j) * 128] = S[st][j];
}
#ifndef MK_N_LAUNCHES
#define MK_N_LAUNCHES 1
#endif
constexpr int N_PHASES = 17;
constexpr int N_LAUNCHES = MK_N_LAUNCHES;

template <class Epi> __device__ __forceinline__ void run_gemm(Frame& F, const bf16* A, const bf16* Bt, int N, int K, const Epi& E) {
    pg8::Gemm g{A, Bt, MT, N, K}; pg8::StaticOrder S; S.init(MT, N, F.G, (int)blockIdx.x);
    pg8::gemm_phase<Epi, pg8::StaticOrder, true, true>(F.lds + RING_OFF, g, S, E);
}

__global__ void __launch_bounds__(NWAVES * 64, 2) yoco_fwd(Args args) {
    extern __shared__ __attribute__((aligned(16))) unsigned char lds[];
    Frame F;
    F.lds = (LAS unsigned char*)lds;
    F.MISC = (volatile LAS unsigned*)(F.lds + MISC_OFF);
    F.tid = threadIdx.x; F.lane = F.tid & 63; F.wave = __builtin_amdgcn_readfirstlane(F.tid >> 6);
    F.G = gridDim.x; { const int bx = blockIdx.x; F.vcu = (F.G % 8 == 0) ? (bx % 8) * (F.G / 8) + bx / 8 : bx; }
    F.ctl = (gu32*)(argp()->ws + WS_CTL);
    for (int u = F.tid; u < (LDS_BYTES - LDSCTL_OFF) / 4; u += NWAVES * 64) ((LAS unsigned*)(F.lds + LDSCTL_OFF))[u] = 0u;
    __syncthreads();
    XcdBarrier bar; bar.bar = (unsigned*)(F.ctl + CW_BAR); bar.x = 0; bar.st = nullptr;
    if (N_LAUNCHES == 1) bar = xcd_barrier_post((unsigned*)(F.ctl + CW_BAR) + argp()->li * XCD_BAR_WORDS, F.MISC + 8);
#define GRID_BAR() do { if (N_LAUNCHES == 1) xcd_barrier(bar); } while (0)
    const int lo = argp()->ph_lo, hi = argp()->ph_hi;
#ifndef PH_MASK
#define PH_MASK 0xffffffffu
#endif
#define IN(k) (((PH_MASK >> (k)) & 1) && lo <= (k) && (k) < hi)
#define REFRESH() do { int t_ = threadIdx.x; asm volatile("" : "+v"(t_)); F.tid = t_; F.lane = t_ & 63; } while (0)
#define SEAM(k) do { if (IN(k) && IN((k) + 1)) GRID_BAR(); } while (0)
#define XB ((bf16*)(argp()->ws + WS_XB))
#define HA ((bf16*)(argp()->ws + WS_HA))
#define HB ((bf16*)(argp()->ws + WS_HB))
#define OG ((bf16*)(argp()->ws + WS_OG))
#define PP ((bf16*)(argp()->ws + WS_PP))
#define ACT ((bf16*)(argp()->ws + WS_ACT))
#define KVb ((bf16*)(argp()->ws + WS_KV))
#define Qb ((bf16*)(argp()->ws + WS_Q))
#define OB ((bf16*)(argp()->ws + WS_OB))
#define PEB ((bf16*)(argp()->ws + WS_PEB))
#define SSQX ((float*)(argp()->ws + WS_SSQX))
#define SSQA ((float*)(argp()->ws + WS_SSQA))
#define SSQB ((float*)(argp()->ws + WS_SSQB))

    if (IN(0)) { REFRESH(); p0_prologue(F, argp()); } SEAM(0);
    if (IN(1)) { REFRESH(); pg8::EpiQKV E{(bf16*)(argp()->ws + WS_QKV), (bf16*)(argp()->ws + WS_Z), (float*)(argp()->ws + WS_AB), SSQX, argp()->out + O_SCP, argp()->out + O_SCS, (bf16*)(argp()->ws + WS_HALO)};
                 run_gemm(F, XB, (const bf16*)(argp()->ws + WS_WIN), NIN, 1024, E); } SEAM(1);
#ifndef CHUNKED
#define CHUNKED 1
#endif
    if (IN(2)) { REFRESH(); if (CHUNKED) for (int pair = blockIdx.x; pair < 2048; pair += F.G) dprep_pair(F, argp(), pair); } SEAM(2);
    if (IN(3)) { REFRESH(); for (int item = blockIdx.x; item < 128 + 1024; item += F.G) { if (CHUNKED && item < 128) dscan_item(F, argp(), item); else delta_seq_item(F, argp(), item); } } SEAM(3);
    if (IN(4)) { REFRESH(); pg8::EpiRes<true> E{argp()->in[0], argp()->in[1], nullptr, HA, SSQA}; run_gemm(F, OG, (const bf16*)(argp()->ws + WS_WOUT), 1024, 1024, E); } SEAM(4);
    if (IN(5)) { REFRESH(); pg8::EpiGU E{ACT, SSQA}; run_gemm(F, HA, (const bf16*)(argp()->ws + WS_WGU0), 5632, 1024, E); } SEAM(5);
    if (IN(6)) { REFRESH(); pg8::EpiRes<false> E{nullptr, nullptr, HA, HB, SSQB}; run_gemm(F, ACT, (const bf16*)(argp()->ws + WS_WDN0), 1024, FFH, E); } SEAM(6);
    if (IN(7)) { REFRESH(); pg8::EpiPP E{PP}; run_gemm(F, PEB, (const bf16*)(argp()->ws + WS_WPJ0), 1024, 256, E); } SEAM(7);
    if (IN(8)) { REFRESH(); pg8::EpiGate<false> E{SSQB, PP, HB, HA, SSQA, nullptr}; run_gemm(F, HB, (const bf16*)(argp()->ws + WS_WGT0), 1024, 1024, E); } SEAM(8);
    if (IN(9)) { REFRESH(); pg8::EpiKVQ E{KVb, Qb, SSQA, argp()->out + O_KWP, argp()->out + O_VWP, argp()->out + O_KWS, argp()->out + O_VWS};
                 run_gemm(F, HA, (const bf16*)(argp()->ws + WS_WKVQ), 1536, 1024, E); } SEAM(9);
    if (IN(10)) { REFRESH(); for (int item = blockIdx.x; item < 1024 + 512; item += F.G) { if (item < 1024) attn_prompt_item(F, argp(), item); else attn_sample_item(F, argp(), item - 1024); } } SEAM(10);
    if (IN(11)) { REFRESH(); pg8::EpiRes<false> E{nullptr, nullptr, HA, HB, SSQB}; run_gemm(F, OB, (const bf16*)(argp()->ws + WS_WO), 1024, 1024, E); } SEAM(11);
    if (IN(12)) { REFRESH(); pg8::EpiGU E{ACT, SSQB}; run_gemm(F, HB, (const bf16*)(argp()->ws + WS_WGU1), 5632, 1024, E); } SEAM(12);
    if (IN(13)) { REFRESH(); pg8::EpiRes<false> E{nullptr, nullptr, HB, HA, SSQA}; run_gemm(F, ACT, (const bf16*)(argp()->ws + WS_WDN1), 1024, FFH, E); } SEAM(13);
    if (IN(14)) { REFRESH(); pg8::EpiPP E{PP}; run_gemm(F, PEB + (size_t)MT * 256, (const bf16*)(argp()->ws + WS_WPJ1), 1024, 256, E); } SEAM(14);
    if (IN(15)) { REFRESH(); pg8::EpiGate<true> E{SSQA, PP, HA, nullptr, nullptr, argp()->out + O_Y}; run_gemm(F, HA, (const bf16*)(argp()->ws + WS_WGT1), 1024, 1024, E); } SEAM(15);
    if (IN(16)) { REFRESH(); final_norm(F, argp()); }
#undef IN
#undef SEAM
}

extern "C" void kernel_launch(void* const* d_in, const int* in_sizes, int n_in, void* d_out, int out_size, void* d_ws, size_t ws_size, hipStream_t stream) {
    static int grid = 0;
    if (grid == 0) {
        if (n_in != 28 || out_size != (int)O_END || ws_size < WS_END) { fprintf(stderr, "kernel_launch: unexpected shapes: n_in %d out %d ws %zu (need %zu)\n", n_in, out_size, ws_size, (size_t)WS_END); grid = -1; return; }
        int dev = 0, cus = 0;
        if (hipGetDevice(&dev) != hipSuccess || hipDeviceGetAttribute(&cus, hipDeviceAttributeMultiprocessorCount, dev) != hipSuccess) { grid = -1; return; }
        if (hipFuncSetAttribute((const void*)yoco_fwd, hipFuncAttributeMaxDynamicSharedMemorySize, LDS_BYTES) != hipSuccess) { fprintf(stderr, "kernel_launch: hipFuncSetAttribute failed\n"); grid = -1; return; }
        (void)hipGetLastError();
        grid = cus;
    }
    if (grid < 0) return;
    (void)hipMemsetAsync((char*)d_ws + WS_CTL, 0, CTL_ZERO_BYTES, stream);
    Args a{};
    for (int i = 0; i < 28; ++i) a.in[i] = (const float*)d_in[i];
    a.out = (float*)d_out; a.ws = (unsigned char*)d_ws;
#ifdef PROBE_PHASE
    if (N_LAUNCHES == 1) { const int cuts[4] = {0, PROBE_PHASE + 1, PROBE_PHASE, N_PHASES};
        a.ph_lo = 0; a.ph_hi = PROBE_PHASE + 1; a.li = 0; hipLaunchKernelGGL(yoco_fwd, dim3(grid), dim3(NWAVES * 64), LDS_BYTES, stream, a);
        a.ph_lo = PROBE_PHASE; a.ph_hi = PROBE_PHASE + 1; a.li = 1; hipLaunchKernelGGL(yoco_fwd, dim3(grid), dim3(NWAVES * 64), LDS_BYTES, stream, a);
        a.ph_lo = PROBE_PHASE + 1; a.ph_hi = N_PHASES; a.li = 2; hipLaunchKernelGGL(yoco_fwd, dim3(grid), dim3(NWAVES * 64), LDS_BYTES, stream, a); (void)cuts; }
#else
    if (N_LAUNCHES == 1) { a.ph_lo = 0; a.ph_hi = N_PHASES; a.li = 0; hipLaunchKernelGGL(yoco_fwd, dim3(grid), dim3(NWAVES * 64), LDS_BYTES, stream, a); }
#endif
    else for (int p = 0; p < N_PHASES; ++p) { a.ph_lo = p; a.ph_hi = p + 1; hipLaunchKernelGGL(yoco_fwd, dim3(grid), dim3(NWAVES * 64), LDS_BYTES, stream, a); }
}
```

```cpp
#include <hip/hip_runtime.h>
#include <cstdio>
#include <cstdint>
namespace pg8 {
#define PG8_LAS __attribute__((address_space(3)))
typedef unsigned short bf16_t;
typedef short bf16x8 __attribute__((ext_vector_type(8)));
typedef float f32x4 __attribute__((ext_vector_type(4)));
typedef unsigned u32x4 __attribute__((ext_vector_type(4)));
constexpr int BM = 256, BK = 64, HALF = 128, HTB = HALF * BK * 2  , STAGE_BYTES = 8 * HTB, NXCD = 8, WGM = 8;

__host__ __device__ __forceinline__ int lds_byte(int r, int c) { const int st = (r >> 4) * 2 + (c >> 5), rr = r & 15, cc = c & 31, ob = rr * 64 + cc * 2; return st * 1024 + (ob ^ (((ob >> 9) & 1) << 5)); }
__host__ __device__ __forceinline__ void stage_rc(int b, int& R, int& C) { const int st = b / 1024, sb = b % 1024, swz = sb ^ (((sb >> 9) & 1) << 5); R = (st >> 1) * 16 + swz / 64; C = (st & 1) * 32 + (swz % 64) / 2; }
__host__ __device__ __forceinline__ int perm32(int rho) { const int n = rho >> 4, i = rho & 15; return 8 * (i >> 2) + 4 * n + (i & 3); }

struct Unit { int pm, pn; };
struct Gemm { const bf16_t* A; const bf16_t* Bt; int M, N, K; };

struct StaticOrder {
    int nM, nN, nwg, G, c;
    __host__ __device__ void init(int M, int N, int G_, int c_) { nM = M / BM; nN = N / BM; nwg = nM * nN; G = G_; c = c_; }
    __host__ __device__ bool next(int i, Unit& u) const {
        const long L = (long)i * G + c; if (L >= nwg) return false;
        int wgid = (int)L; { const int q = nwg / NXCD, r = nwg % NXCD, xcd = wgid % NXCD, off = wgid / NXCD; wgid = (xcd < r ? xcd * (q + 1) : r * (q + 1) + (xcd - r) * q) + off; }
        const int nig = WGM * nN, gid = wgid / nig, fm = gid * WGM, gsz = (nM - fm) < WGM ? (nM - fm) : WGM;
        u.pm = fm + ((wgid % nig) % gsz); u.pn = (wgid % nig) / gsz; return true;
    }
    __device__ __forceinline__ void a_ready(const Unit&) const {}
    __device__ __forceinline__ void done(const Unit&) const {}
};

__device__ __forceinline__ unsigned cvt_pk_bf16(float lo, float hi) { unsigned r; asm volatile("v_cvt_pk_bf16_f32 %0, %1, %2" : "=v"(r) : "v"(lo), "v"(hi)); return r; }
__device__ __forceinline__ f32x4 bf_lo2(unsigned a, unsigned b) { return (f32x4){__uint_as_float(a << 16), __uint_as_float(a & 0xffff0000u), __uint_as_float(b << 16), __uint_as_float(b & 0xffff0000u)}; }
__device__ __forceinline__ u32x4 pack8(const f32x4 v0, const f32x4 v1) { u32x4 w; w.x = cvt_pk_bf16(v0[0], v0[1]); w.y = cvt_pk_bf16(v0[2], v0[3]); w.z = cvt_pk_bf16(v1[0], v1[1]); w.w = cvt_pk_bf16(v1[2], v1[3]); return w; }
__device__ __forceinline__ float dot4(const f32x4 a) { return (a[0] * a[0] + a[1] * a[1]) + (a[2] * a[2] + a[3] * a[3]); }
__device__ __forceinline__ float row_rstd(const float* ssq, int r, int fq) {
    const f32x4 p = *(const f32x4*)(ssq + (size_t)r * 16 + 4 * fq);
    float s = (p[0] + p[1]) + (p[2] + p[3]);
    s += __shfl_xor(s, 16); s += __shfl_xor(s, 32);
    return rsqrtf(s * (1.0f / 1024.0f) + 1e-6f);
}
__device__ __forceinline__ float sigmoidf_(float x) { return __builtin_amdgcn_rcpf(1.0f + __expf(-x)); }

constexpr int MP_ROWS = 32768;

struct EpiQKV {
    static constexpr bool PERM = true, AFTER_DRAIN = false;
    bf16_t* QKV; bf16_t* Z; float* AB; const float* ssq; float* sc_p; float* sc_s; bf16_t* halo;
    __device__ __forceinline__ void operator()(const f32x4 (&acc)[2][2][4][2], const Unit& u, int wr, int wc, int fr, int fq) const {
        const int row0 = u.pm * BM + wr * 64 + fr, colt = u.pn * BM + wc * 32 + 8 * fq;
#pragma unroll
        for (int ai = 0; ai < 2; ++ai)
#pragma unroll
            for (int m = 0; m < 4; ++m) {
                const int r = row0 + ai * HALF + m * 16; const float rs = row_rstd(ssq, r, fq);
#pragma unroll
                for (int bj = 0; bj < 2; ++bj) {
                    const int col = colt + bj * HALF; const f32x4 v0 = acc[ai][bj][m][0] * rs, v1 = acc[ai][bj][m][1] * rs;
                    if (u.pn < 12) {
                        const u32x4 pk = pack8(v0, v1);
                        *(u32x4*)(QKV + (size_t)r * 3072 + col) = pk;
                        if (r < MP_ROWS && (r & 63) >= 61) *(u32x4*)(halo + ((size_t)(r >> 6) * 3 + ((r & 63) - 61)) * 3072 + col) = pk;
                        if (r < MP_ROWS) { const int s = r & 2047; if (s >= 2045) { float* o = sc_p + ((size_t)((r >> 11) * 3 + (s - 2045))) * 3072 + col; *(f32x4*)o = v0; *(f32x4*)(o + 4) = v1; } }
                        else { const int rr = r - MP_ROWS, t = rr & 7; if (t >= 5) { float* o = sc_s + ((size_t)((rr >> 3) * 3 + (t - 5))) * 3072 + col; *(f32x4*)o = v0; *(f32x4*)(o + 4) = v1; } }
                    } else if (u.pn < 16) {
                        *(u32x4*)(Z + (size_t)r * 1024 + (col - 3072)) = pack8(v0, v1);
                    } else {
                        const int c = col - 4096; if (c < 16) { float* o = AB + (size_t)r * 16 + c; *(f32x4*)o = v0; *(f32x4*)(o + 4) = v1; }
                    }
                }
            }
    }
};
template <bool BASEF32> struct EpiRes {
    static constexpr bool PERM = true, AFTER_DRAIN = false;
    const float* xp; const float* xs; const bf16_t* hb; bf16_t* out; float* ssq_out;
    __device__ __forceinline__ void operator()(const f32x4 (&acc)[2][2][4][2], const Unit& u, int wr, int wc, int fr, int fq) const {
        const int row0 = u.pm * BM + wr * 64 + fr, colt = u.pn * BM + wc * 32 + 8 * fq;
#pragma unroll
        for (int ai = 0; ai < 2; ++ai)
#pragma unroll
            for (int m = 0; m < 4; ++m) {
                const int r = row0 + ai * HALF + m * 16; float q = 0.f;
#pragma unroll
                for (int bj = 0; bj < 2; ++bj) {
                    const int col = colt + bj * HALF; f32x4 b0, b1;
                    if (BASEF32) { const float* p = (r < MP_ROWS ? xp + (size_t)r * 1024 : xs + (size_t)(r - MP_ROWS) * 1024) + col; b0 = *(const f32x4*)p; b1 = *(const f32x4*)(p + 4); }
                    else { const u32x4 w = *(const u32x4*)(hb + (size_t)r * 1024 + col); b0 = bf_lo2(w.x, w.y); b1 = bf_lo2(w.z, w.w); }
                    const f32x4 v0 = acc[ai][bj][m][0] + b0, v1 = acc[ai][bj][m][1] + b1;
                    q += dot4(v0) + dot4(v1);
                    *(u32x4*)(out + (size_t)r * 1024 + col) = pack8(v0, v1);
                }
                q += __shfl_xor(q, 16); q += __shfl_xor(q, 32);
                if (fq == 0) ssq_out[(size_t)r * 16 + u.pn * 4 + wc] = q;
            }
    }
};
struct EpiGU {
    static constexpr bool PERM = true, AFTER_DRAIN = false;
    bf16_t* act; const float* ssq;
    __device__ __forceinline__ void operator()(const f32x4 (&acc)[2][2][4][2], const Unit& u, int wr, int wc, int fr, int fq) const {
        const int row0 = u.pm * BM + wr * 64 + fr, col = u.pn * HALF + wc * 32 + 8 * fq;
#pragma unroll
        for (int ai = 0; ai < 2; ++ai)
#pragma unroll
            for (int m = 0; m < 4; ++m) {
                const int r = row0 + ai * HALF + m * 16; const float rs = row_rstd(ssq, r, fq);
                f32x4 o[2];
#pragma unroll
                for (int n = 0; n < 2; ++n) {
                    const f32x4 g = acc[ai][0][m][n] * rs, up = acc[ai][1][m][n] * rs;
#pragma unroll
                    for (int j = 0; j < 4; ++j) o[n][j] = g[j] * sigmoidf_(g[j]) * up[j];
                }
                *(u32x4*)(act + (size_t)r * 2816 + col) = pack8(o[0], o[1]);
            }
    }
};
struct EpiPP {
    static constexpr bool PERM = true, AFTER_DRAIN = false;
    bf16_t* out;
    __device__ __forceinline__ void operator()(const f32x4 (&acc)[2][2][4][2], const Unit& u, int wr, int wc, int fr, int fq) const {
        const int row0 = u.pm * BM + wr * 64 + fr, colt = u.pn * BM + wc * 32 + 8 * fq;
#pragma unroll
        for (int ai = 0; ai < 2; ++ai)
#pragma unroll
            for (int m = 0; m < 4; ++m) {
                const int r = row0 + ai * HALF + m * 16;
#pragma unroll
                for (int bj = 0; bj < 2; ++bj) *(u32x4*)(out + (size_t)r * 1024 + colt + bj * HALF) = pack8(acc[ai][bj][m][0], acc[ai][bj][m][1]);
            }
    }
};
template <bool FINAL> struct EpiGate {
    static constexpr bool PERM = true, AFTER_DRAIN = false;
    const float* ssq_in; const bf16_t* pp; const bf16_t* hb; bf16_t* out; float* ssq_out; float* y;
    __device__ __forceinline__ void operator()(const f32x4 (&acc)[2][2][4][2], const Unit& u, int wr, int wc, int fr, int fq) const {
        const int row0 = u.pm * BM + wr * 64 + fr, colt = u.pn * BM + wc * 32 + 8 * fq;
#pragma unroll
        for (int ai = 0; ai < 2; ++ai)
#pragma unroll
            for (int m = 0; m < 4; ++m) {
                const int r = row0 + ai * HALF + m * 16; const float rs = row_rstd(ssq_in, r, fq); float q = 0.f;
#pragma unroll
                for (int bj = 0; bj < 2; ++bj) {
                    const int col = colt + bj * HALF;
                    const u32x4 wp = *(const u32x4*)(pp + (size_t)r * 1024 + col), wh = *(const u32x4*)(hb + (size_t)r * 1024 + col);
                    const f32x4 p0 = bf_lo2(wp.x, wp.y), p1 = bf_lo2(wp.z, wp.w), h0 = bf_lo2(wh.x, wh.y), h1 = bf_lo2(wh.z, wh.w);
                    f32x4 v0, v1;
#pragma unroll
                    for (int j = 0; j < 4; ++j) { v0[j] = h0[j] + p0[j] * sigmoidf_(acc[ai][bj][m][0][j] * rs); v1[j] = h1[j] + p1[j] * sigmoidf_(acc[ai][bj][m][1][j] * rs); }
                    if (FINAL) { float* o = y + (size_t)r * 1024 + col; *(f32x4*)o = v0; *(f32x4*)(o + 4) = v1; }
                    else { q += dot4(v0) + dot4(v1); *(u32x4*)(out + (size_t)r * 1024 + col) = pack8(v0, v1); }
                }
                if (!FINAL) { q += __shfl_xor(q, 16); q += __shfl_xor(q, 32); if (fq == 0) ssq_out[(size_t)r * 16 + u.pn * 4 + wc] = q; }
            }
    }
};
struct EpiKVQ {
    static constexpr bool PERM = true, AFTER_DRAIN = false;
    bf16_t* KV; bf16_t* Q; const float* ssq; float* kw_p; float* vw_p; float* kw_s; float* vw_s;
    __device__ __forceinline__ void operator()(const f32x4 (&acc)[2][2][4][2], const Unit& u, int wr, int wc, int fr, int fq) const {
        const int row0 = u.pm * BM + wr * 64 + fr, colt = u.pn * BM + wc * 32 + 8 * fq;
        const bool iskv = u.pn < 2;
        float* const cp = (u.pn == 0) ? kw_p : vw_p; float* const cs = (u.pn == 0) ? kw_s : vw_s;
        const int ccol = wc * 32 + 8 * fq;
#pragma unroll
        for (int ai = 0; ai < 2; ++ai)
#pragma unroll
            for (int m = 0; m < 4; ++m) {
                const int r = row0 + ai * HALF + m * 16; const float rs = row_rstd(ssq, r, fq);
                if (iskv) {
                    long crow = -1;
                    if (r < MP_ROWS) { const int s = r & 2047; if (s >= 1920) crow = (long)(r >> 11) * 128 + (s - 1920); }
                    else { const int rr = r - MP_ROWS; crow = (long)(rr >> 3) * 128 + 120 + (rr & 7); }
                    float* const cbase = (r < MP_ROWS) ? cp : cs;
#pragma unroll
                    for (int bj = 0; bj < 2; ++bj) {
                        const f32x4 v0 = acc[ai][bj][m][0] * rs, v1 = acc[ai][bj][m][1] * rs;
                        *(u32x4*)(KV + (size_t)r * 512 + colt + bj * HALF) = pack8(v0, v1);
                        if (crow >= 0) { float* o = cbase + (size_t)crow * 256 + ccol + bj * HALF; *(f32x4*)o = v0; *(f32x4*)(o + 4) = v1; }
                    }
                } else {
                    const float sc = rs * 0.125f;
#pragma unroll
                    for (int bj = 0; bj < 2; ++bj)
                        *(u32x4*)(Q + (size_t)r * 1024 + (colt - 512) + bj * HALF) = pack8(acc[ai][bj][m][0] * sc, acc[ai][bj][m][1] * sc);
                }
            }
    }
};
template <class Epi, class Sched, bool ALIGN_EPI = false, bool SP2 = false>
__device__ __forceinline__ void gemm_phase(PG8_LAS unsigned char* lds, const Gemm g, const Sched& S, const Epi& E) {
    int tid_ = threadIdx.x; asm volatile("" : "+v"(tid_));
    const int tid = tid_, wid = __builtin_amdgcn_readfirstlane(tid >> 6), lane = tid & 63, wr = wid >> 2, wc = wid & 3, fr = lane & 15, fq = lane >> 4;
    const int K = g.K, nt = K / BK;
    unsigned voffA[2], voffB[2];
#pragma unroll
    for (int i = 0; i < 2; ++i) { int R, C; stage_rc(tid * 16 + i * 8192, R, C); const int Rb = Epi::PERM ? ((R & ~31) + perm32(R & 31)) : R;
        voffA[i] = (unsigned)(R * K + C) * 2u; voffB[i] = (unsigned)(Rb * K + C) * 2u; }
    const size_t kstep = (size_t)(BK * 2);
    const size_t hstep = (size_t)HALF * K * 2;
    const size_t tstep = 2 * hstep;
    const unsigned ldsw = (unsigned)wid * 1024u;
    const int aoff = lds_byte(wr * 64 + fr, fq * 8), boff = lds_byte(wc * 32 + fr, fq * 8);
#define PG8_SA(b, h) (((b) * 2 + (h)) * HTB)
#define PG8_SB(b, h) ((4 + (b) * 2 + (h)) * HTB)
#define PG8_STAGE(bufoff, gbase, voff) do { _Pragma("unroll") for (int _i = 0; _i < 2; ++_i) \
        __builtin_amdgcn_global_load_lds((const unsigned*)((const char*)(gbase) + (voff)[_i]), (PG8_LAS unsigned*)(lds + (bufoff) + ldsw + _i * 8192), 16, 0, 0); } while (0)
#define PG8_LDA(dst, b, h) do { _Pragma("unroll") for (int m = 0; m < 4; ++m) _Pragma("unroll") for (int k = 0; k < 2; ++k) dst[m][k] = *(const PG8_LAS bf16x8*)(lds + PG8_SA(b, h) + aoff + m * 2048 + k * 1024); } while (0)
#define PG8_LDB(dst, b, h) do { _Pragma("unroll") for (int n = 0; n < 2; ++n) _Pragma("unroll") for (int k = 0; k < 2; ++k) dst[n][k] = *(const PG8_LAS bf16x8*)(lds + PG8_SB(b, h) + boff + n * 2048 + k * 1024); } while (0)
#define PG8_MMA(ai, bj, At, Bt) do { __builtin_amdgcn_s_setprio(1); _Pragma("unroll") for (int m = 0; m < 4; ++m) _Pragma("unroll") for (int n = 0; n < 2; ++n) _Pragma("unroll") for (int k = 0; k < 2; ++k) \
        acc[ai][bj][m][n] = __builtin_amdgcn_mfma_f32_16x16x32_bf16(Bt[n][k], At[m][k], acc[ai][bj][m][n], 0, 0, 0); __builtin_amdgcn_s_setprio(0); } while (0)
#define PG8_WAIT_V(n) asm volatile("s_waitcnt vmcnt(" #n ")" ::: "memory")
#define PG8_WAIT_L(n) asm volatile("s_waitcnt lgkmcnt(" #n ")" ::: "memory")
#define PG8_BAR __builtin_amdgcn_s_barrier()
#define PG8_SCHED __builtin_amdgcn_sched_barrier(0)
    Unit cur, nxt; int ui = 0;
    if (!S.next(0, cur)) return;
    f32x4 acc[2][2][4][2];
#pragma unroll
    for (int a = 0; a < 2; ++a)
#pragma unroll
        for (int b = 0; b < 2; ++b)
#pragma unroll
            for (int m = 0; m < 4; ++m)
#pragma unroll
                for (int n = 0; n < 2; ++n) acc[a][b][m][n] = (f32x4){0.f, 0.f, 0.f, 0.f};
    bf16x8 At[4][2], B0[2][2], B1[2][2];
    const char* cA = (const char*)g.A + (size_t)cur.pm * tstep; const char* cB = (const char*)g.Bt + (size_t)cur.pn * tstep;
    S.a_ready(cur);
    if constexpr (SP2) {
        PG8_STAGE(PG8_SB(0, 0), cB, voffB); PG8_STAGE(PG8_SB(0, 1), cB + hstep, voffB); PG8_STAGE(PG8_SA(0, 0), cA, voffA); PG8_STAGE(PG8_SA(0, 1), cA + hstep, voffA);
        if (wr == 1) PG8_BAR;
        PG8_WAIT_V(2); PG8_BAR;
        PG8_STAGE(PG8_SB(1, 0), cB + kstep, voffB); PG8_STAGE(PG8_SA(1, 0), cA + kstep, voffA); PG8_STAGE(PG8_SB(1, 1), cB + hstep + kstep, voffB);
        PG8_WAIT_V(6); PG8_BAR;
    } else {
        PG8_STAGE(PG8_SB(0, 0), cB, voffB); PG8_STAGE(PG8_SA(0, 0), cA, voffA); PG8_STAGE(PG8_SB(0, 1), cB + hstep, voffB); PG8_STAGE(PG8_SA(0, 1), cA + hstep, voffA);
        if (wr == 1) PG8_BAR;
        PG8_WAIT_V(4); PG8_BAR;
        PG8_STAGE(PG8_SB(1, 0), cB + kstep, voffB); PG8_STAGE(PG8_SA(1, 0), cA + kstep, voffA); PG8_STAGE(PG8_SB(1, 1), cB + hstep + kstep, voffB);
        PG8_WAIT_V(6); PG8_BAR;
    }
    for (;;) {
        const bool has_next = S.next(ui + 1, nxt);
        const char* nA = has_next ? (const char*)g.A + (size_t)nxt.pm * tstep : cA; const char* nB = has_next ? (const char*)g.Bt + (size_t)nxt.pn * tstep : cB;
        for (int t = 0; t < nt; t += 2) {
            const bool last = (t == nt - 2);
            const char* a1 = cA + (size_t)(t + 1) * kstep;
            const char* a2 = last ? nA : cA + (size_t)(t + 2) * kstep; const char* b2 = last ? nB : cB + (size_t)(t + 2) * kstep;
            const char* a3 = a2 + kstep; const char* b3 = b2 + kstep;
            if (last && has_next) S.a_ready(nxt);
            if constexpr (SP2) {
            PG8_LDB(B0, 0, 0); PG8_LDB(B1, 0, 1); PG8_SCHED; PG8_LDA(At, 0, 0); PG8_STAGE(PG8_SA(1, 1), a1 + hstep, voffA);
            PG8_WAIT_V(8); PG8_WAIT_L(0); PG8_BAR; PG8_MMA(0, 0, At, B0); PG8_MMA(0, 1, At, B1); PG8_BAR; PG8_SCHED;
            PG8_LDA(At, 0, 1); PG8_STAGE(PG8_SB(0, 0), b2, voffB); PG8_STAGE(PG8_SB(0, 1), b2 + hstep, voffB); PG8_STAGE(PG8_SA(0, 0), a2, voffA);
            PG8_WAIT_V(8); PG8_WAIT_L(0); PG8_BAR; PG8_MMA(1, 0, At, B0); PG8_MMA(1, 1, At, B1); PG8_BAR; PG8_SCHED;
            PG8_LDB(B0, 1, 0); PG8_LDB(B1, 1, 1); PG8_SCHED; PG8_LDA(At, 1, 0); PG8_STAGE(PG8_SA(0, 1), a2 + hstep, voffA);
            PG8_WAIT_V(8); PG8_WAIT_L(0); PG8_BAR; PG8_MMA(0, 0, At, B0); PG8_MMA(0, 1, At, B1); PG8_BAR; PG8_SCHED;
            PG8_LDA(At, 1, 1); PG8_STAGE(PG8_SB(1, 0), b3, voffB); PG8_STAGE(PG8_SB(1, 1), b3 + hstep, voffB); PG8_STAGE(PG8_SA(1, 0), a3, voffA);
            PG8_WAIT_V(8); PG8_WAIT_L(0); PG8_BAR; PG8_MMA(1, 0, At, B0); PG8_MMA(1, 1, At, B1); PG8_BAR; PG8_SCHED;
            } else {
            PG8_LDB(B0, 0, 0); PG8_SCHED; PG8_LDA(At, 0, 0); PG8_STAGE(PG8_SA(1, 1), a1 + hstep, voffA);
            PG8_WAIT_L(8); PG8_BAR; PG8_WAIT_L(0); PG8_MMA(0, 0, At, B0); PG8_BAR; PG8_SCHED;
            PG8_LDB(B1, 0, 1); PG8_STAGE(PG8_SB(0, 0), b2, voffB);
            PG8_BAR; PG8_WAIT_L(0); PG8_MMA(0, 1, At, B1); PG8_BAR;
            PG8_LDA(At, 0, 1); PG8_STAGE(PG8_SA(0, 0), a2, voffA);
            PG8_BAR; PG8_WAIT_L(0); PG8_MMA(1, 0, At, B0); PG8_BAR; PG8_SCHED;
            PG8_STAGE(PG8_SB(0, 1), b2 + hstep, voffB);
            PG8_WAIT_V(6); PG8_BAR; PG8_MMA(1, 1, At, B1); PG8_BAR;
            PG8_LDB(B0, 1, 0); PG8_SCHED; PG8_LDA(At, 1, 0); PG8_STAGE(PG8_SA(0, 1), a2 + hstep, voffA);
            PG8_WAIT_L(8); PG8_BAR; PG8_WAIT_L(0); PG8_MMA(0, 0, At, B0); PG8_BAR; PG8_SCHED;
            PG8_LDB(B1, 1, 1); PG8_STAGE(PG8_SB(1, 0), b3, voffB);
            PG8_BAR; PG8_WAIT_L(0); PG8_MMA(0, 1, At, B1); PG8_BAR;
            PG8_LDA(At, 1, 1); PG8_STAGE(PG8_SA(1, 0), a3, voffA);
            PG8_BAR; PG8_WAIT_L(0); PG8_MMA(1, 0, At, B0); PG8_BAR; PG8_SCHED;
            PG8_STAGE(PG8_SB(1, 1), b3 + hstep, voffB);
            PG8_WAIT_V(6); PG8_BAR; PG8_MMA(1, 1, At, B1); PG8_BAR;
            }
        }
        if constexpr (ALIGN_EPI) { if (wr == 0) PG8_BAR; }
        if constexpr (!Epi::AFTER_DRAIN) { E(acc, cur, wr, wc, fr, fq); S.done(cur); }
        if (!has_next) break;
#pragma unroll
        for (int a = 0; a < 2; ++a)
#pragma unroll
            for (int b = 0; b < 2; ++b)
#pragma unroll
                for (int m = 0; m < 4; ++m)
#pragma unroll
                    for (int n = 0; n < 2; ++n) acc[a][b][m][n] = (f32x4){0.f, 0.f, 0.f, 0.f};
        cur = nxt; cA = nA; cB = nB; ++ui;
        if constexpr (ALIGN_EPI) { if (wr == 1) PG8_BAR; }
    }
    PG8_WAIT_V(0);
    if constexpr (!ALIGN_EPI) { if (wr == 0) PG8_BAR; }
    PG8_BAR;
    if constexpr (Epi::AFTER_DRAIN) { E.fused(acc, cur, wr, wc, fr, fq, lds, wid, lane); S.done(cur); }
#undef PG8_SA
#undef PG8_SB
#undef PG8_STAGE
#undef PG8_LDA
#undef PG8_LDB
#undef PG8_MMA
#undef PG8_WAIT_V
#undef PG8_WAIT_L
#undef PG8_BAR
#undef PG8_SCHED
}
}
constexpr int NWAVES = 8;
constexpr int DM = 1024, MP = 32768, MS = 1024, MT = MP + MS;
constexpr int NIN = 4352;
constexpr int FFH = 2816;
constexpr size_t MiB = 1u << 20;
constexpr size_t WS_CTL = 0, CTL_ZERO_BYTES = 1 * MiB;
constexpr size_t WS_SSQX = 2 * MiB, WS_SSQA = 5 * MiB, WS_SSQB = 8 * MiB, WS_AB = 11 * MiB;
constexpr size_t WS_WIN = 16 * MiB, WS_WOUT = 25 * MiB, WS_WGU0 = 27 * MiB, WS_WGU1 = 38 * MiB, WS_WDN0 = 49 * MiB, WS_WDN1 = 55 * MiB,
                 WS_WGT0 = 61 * MiB, WS_WGT1 = 63 * MiB, WS_WPJ0 = 65 * MiB, WS_WPJ1 = 66 * MiB, WS_WKVQ = 67 * MiB, WS_WO = 70 * MiB;
constexpr size_t WS_PEB = 72 * MiB, WS_XB = 106 * MiB, WS_QKV = 172 * MiB, WS_Z = 370 * MiB, WS_END = 502 * MiB;
constexpr size_t WS_UTB = WS_XB, WS_OG = WS_UTB;
constexpr size_t WS_QKM = 436 * MiB, WS_SCL = 468 * MiB, WS_HALO = 471 * MiB;
constexpr size_t WS_HA = 436 * MiB, WS_HB = WS_Z, WS_PP = 106 * MiB, WS_ACT = WS_QKV, WS_KV = 172 * MiB, WS_Q = 205 * MiB, WS_OB = 271 * MiB;
constexpr int CW_BAR = 4096;
constexpr size_t O_Y = 0, O_SDP = (size_t)MT * DM, O_SDS = O_SDP + 2097152, O_SCP = O_SDS + 16777216, O_SCS = O_SCP + 147456,
                 O_KWP = O_SCS + 1179648, O_KWS = O_KWP + 524288, O_VWP = O_KWS + 4194304, O_VWS = O_VWP + 524288, O_END = O_VWS + 4194304;
constexpr int RING_OFF = 0, RING_BYTES = 131072, LDS_BYTES = 147456, LDSCTL_OFF = LDS_BYTES - 1024, MISC_OFF = LDSCTL_OFF + 320;

#define GAS __attribute__((address_space(1)))
#define LAS __attribute__((address_space(3)))
typedef unsigned short bf16;
typedef unsigned v4u __attribute__((ext_vector_type(4)));
typedef float f32x4 __attribute__((ext_vector_type(4)));
typedef GAS unsigned gu32;
#define RLX_AGENT __ATOMIC_RELAXED, __HIP_MEMORY_SCOPE_AGENT
#define LDS_WAIT() asm volatile("s_waitcnt lgkmcnt(0)" ::: "memory")
#define VM_WAIT() asm volatile("s_waitcnt vmcnt(0)" ::: "memory")
__device__ __forceinline__ unsigned f2bf(float f) { unsigned u = __builtin_bit_cast(unsigned, f); return (u + 0x7fffu + ((u >> 16) & 1u)) >> 16; }
__device__ __forceinline__ unsigned pk2(float lo, float hi) { return f2bf(lo) | (f2bf(hi) << 16); }
__device__ __forceinline__ float bf2f(unsigned short b) { return __uint_as_float((unsigned)b << 16); }
using pg8::sigmoidf_;
__device__ __forceinline__ float dot4s(const f32x4 a) { return (a[0] * a[0] + a[1] * a[1]) + (a[2] * a[2] + a[3] * a[3]); }
__device__ __forceinline__ float wave_sum(float v) {
#pragma unroll
    for (int o = 1; o < 64; o <<= 1) v += __shfl_xor(v, o);
    return v;
}
#define XB_TMO      128
#define XB_XCNT(j)  (256  + 64 * (j))
#define XB_XSUB(j)  (1280 + 64 * (j))
#define XB_XGEN(j)  (2304 + 64 * (j))
#define XB_TOP      3328
#define XB_TOPGEN   3392
#define XCD_BAR_WORDS 3456
#define XB_SPIN_CAP (1u << 18)

__device__ __forceinline__ unsigned xb_ld(unsigned* p)              { return __hip_atomic_load(p, __ATOMIC_RELAXED, __HIP_MEMORY_SCOPE_AGENT); }
__device__ __forceinline__ unsigned xb_add(unsigned* p, unsigned v) { return __hip_atomic_fetch_add(p, v, __ATOMIC_RELAXED, __HIP_MEMORY_SCOPE_AGENT); }
__device__ __forceinline__ unsigned xb_xcc_id() { return (unsigned)__builtin_amdgcn_s_getreg((3 << 11) | 20) & 0xFu; }
#define XB_SPIN(cond, bar) do { unsigned _sp = 0; while (cond) { __builtin_amdgcn_s_sleep(1); \
    if ((++_sp & 255u) == 0u) { if (xb_ld(&(bar)[XB_TMO])) break; if (_sp > XB_SPIN_CAP) { atomicAdd(&(bar)[XB_TMO], 1u); break; } } } } while (0)

struct XcdBarrier {
    unsigned* bar; unsigned x;
    volatile LAS unsigned* st;
};

__device__ __forceinline__ XcdBarrier xcd_barrier_post(unsigned* bar, volatile LAS unsigned* st) {
    XcdBarrier b; b.bar = bar; b.x = xb_xcc_id(); b.st = st;
    if (threadIdx.x == 0) (void)xb_add(&bar[XB_XCNT(b.x)], 1u);
    return b;
}
__device__ __forceinline__ void xcd_barrier_complete(unsigned* bar, unsigned x, unsigned& nloc, unsigned& nx) {
    const unsigned G = gridDim.x * gridDim.y * gridDim.z;
    unsigned sum, cnt, mine, sp = 0u;
    for (;;) {
        sum = 0u; cnt = 0u; mine = 0u;
#pragma unroll
        for (unsigned j = 0; j < 16; ++j) { const unsigned c = xb_ld(&bar[XB_XCNT(j)]); sum += c; cnt += (c > 0u) ? 1u : 0u; mine = (j == x) ? c : mine; }
        if (sum == G) break;
        __builtin_amdgcn_s_sleep(1);
        if ((++sp & 255u) == 0u) { if (xb_ld(&bar[XB_TMO])) break; if (sp > XB_SPIN_CAP) { atomicAdd(&bar[XB_TMO], 1u); break; } }
    }
    nloc = mine > 0u ? mine : 1u; nx = cnt > 0u ? cnt : 1u;
}

__device__ __forceinline__ void xcd_barrier(const XcdBarrier& b) {
    asm volatile("s_waitcnt vmcnt(0)" ::: "memory");
    __syncthreads();
    if (threadIdx.x == 0) {
        unsigned* bar = b.bar;
        __builtin_amdgcn_s_waitcnt(0);
        unsigned nloc = b.st[0], nx = b.st[1];
        if (nloc == 0u) { xcd_barrier_complete(bar, b.x, nloc, nx); b.st[0] = nloc; b.st[1] = nx; }
        const unsigned old = xb_add(&bar[XB_XSUB(b.x)], 1u);
        const unsigned gen = old / nloc;
        if (old + 1u == (gen + 1u) * nloc) {
            __builtin_amdgcn_fence(__ATOMIC_RELEASE, "agent");
            asm volatile("s_waitcnt vmcnt(0)" ::: "memory");
            const unsigned og = xb_add(&bar[XB_TOP], 1u);
            const unsigned tg = og / nx;
            if (og + 1u == (tg + 1u) * nx) xb_add(&bar[XB_TOPGEN], 1u);
            else XB_SPIN(xb_ld(&bar[XB_TOPGEN]) == tg, bar);
            __builtin_amdgcn_fence(__ATOMIC_ACQUIRE, "agent");
            xb_add(&bar[XB_XGEN(b.x)], 1u);
            asm volatile("s_waitcnt vmcnt(0)" ::: "memory");
        } else {
            XB_SPIN(xb_ld(&bar[XB_XGEN(b.x)]) == gen, bar);
            __builtin_amdgcn_fence(__ATOMIC_ACQUIRE, "agent");
            asm volatile("s_waitcnt vmcnt(0)" ::: "memory");
        }
    }
    __syncthreads();
}
struct Args { const float* in[28]; float* out; unsigned char* ws; int ph_lo, ph_hi, li, pad; };
typedef const __attribute__((address_space(4))) Args* cargs_t;
__device__ __forceinline__ cargs_t argp() { cargs_t p = (cargs_t)__builtin_amdgcn_kernarg_segment_ptr(); asm volatile("" : "+s"(p)); return p; }
struct Frame {
    LAS unsigned char* lds;
    volatile LAS unsigned* MISC;
    gu32* ctl;
    int tid, lane, wave, vcu, G;
    const float* const* in;
};

__device__ __forceinline__ void p0_transpose_item(const float* W, int K, int N, const float* gain, bf16* WT, int drow0, LAS float* scr, int k0, int n0, int lane) {
#pragma unroll 8
    for (int i = 0; i < 32; ++i) { const int kk = 2 * i + (lane >> 5); float w = W[(size_t)(k0 + kk) * N + n0 + (lane & 31)]; if (gain) w *= gain[k0 + kk]; scr[kk * 33 + (lane & 31)] = w; }
    LDS_WAIT(); asm volatile("" ::: "memory");
    const int c = lane & 7;
#pragma unroll
    for (int j = 0; j < 4; ++j) { const int n = (lane >> 3) + 8 * j; const LAS float* s = scr + (8 * c) * 33 + n;
        v4u o; o.x = pk2(s[0 * 33], s[1 * 33]); o.y = pk2(s[2 * 33], s[3 * 33]); o.z = pk2(s[4 * 33], s[5 * 33]); o.w = pk2(s[6 * 33], s[7 * 33]);
        *(GAS v4u*)(WT + (size_t)(drow0 + n) * K + k0 + 8 * c) = o; }
    LDS_WAIT(); asm volatile("" ::: "memory");
}
struct WDesc { const float* W; const float* gain; bf16* WT; int K, N, Nuse, kind, roff; };
__device__ __forceinline__ void p0_weight(const WDesc& d, int item, LAS float* scr, int lane) {
    const int nblk = d.Nuse / 32, kb = item / nblk, nb = item % nblk, n0 = 32 * nb;
    int drow0;
    if (d.kind == 0) drow0 = d.roff + n0;
    else { const int up = n0 >= FFH, j = up ? n0 - FFH : n0; drow0 = (j >> 7) * 256 + (up ? 128 : 0) + (j & 127); }
    p0_transpose_item(d.W, d.K, d.N, d.gain, d.WT, drow0, scr, 64 * kb, n0, lane);
}
__device__ __forceinline__ void p0_prologue(Frame& F, cargs_t a) {
    unsigned char* ws = a->ws;
    LAS float* scr = (LAS float*)(F.lds + RING_OFF + F.wave * 16384);
    const int gw = F.vcu * NWAVES + F.wave, NGW = F.G * NWAVES;
    constexpr int NW = 13;
    int it0 = 0;
#pragma unroll 1
    for (int w = 0; w < NW; ++w) {
        WDesc d;
        switch (w) {
        case 0:  d = WDesc{a->in[9],  a->in[8],  (bf16*)(ws + WS_WIN),  1024, 4112, 4096, 0, 0}; break;
        case 1:  d = WDesc{a->in[14], nullptr,  (bf16*)(ws + WS_WOUT), 1024, 1024, 1024, 0, 0}; break;
        case 2:  d = WDesc{a->in[22], a->in[21], (bf16*)(ws + WS_WGU0), 1024, 5632, 5632, 1, 0}; break;
        case 3:  d = WDesc{a->in[22] + (size_t)1024 * 5632, a->in[21] + 1024, (bf16*)(ws + WS_WGU1), 1024, 5632, 5632, 1, 0}; break;
        case 4:  d = WDesc{a->in[23], nullptr,  (bf16*)(ws + WS_WDN0), 2816, 1024, 1024, 0, 0}; break;
        case 5:  d = WDesc{a->in[23] + (size_t)2816 * 1024, nullptr, (bf16*)(ws + WS_WDN1), 2816, 1024, 1024, 0, 0}; break;
        case 6:  d = WDesc{a->in[26], a->in[24], (bf16*)(ws + WS_WGT0), 1024, 1024, 1024, 0, 0}; break;
        case 7:  d = WDesc{a->in[26] + (size_t)1024 * 1024, a->in[24] + 1024, (bf16*)(ws + WS_WGT1), 1024, 1024, 1024, 0, 0}; break;
        case 8:  d = WDesc{a->in[25], nullptr,  (bf16*)(ws + WS_WPJ0), 256, 1024, 1024, 0, 0}; break;
        case 9:  d = WDesc{a->in[25] + (size_t)256 * 1024, nullptr, (bf16*)(ws + WS_WPJ1), 256, 1024, 1024, 0, 0}; break;
        case 10: d = WDesc{a->in[16], a->in[15], (bf16*)(ws + WS_WKVQ), 1024, 512, 512, 0, 0}; break;
        case 11: d = WDesc{a->in[18], a->in[17], (bf16*)(ws + WS_WKVQ), 1024, 1024, 1024, 0, 512}; break;
        default: d = WDesc{a->in[20], nullptr,  (bf16*)(ws + WS_WO),   1024, 1024, 1024, 0, 0}; break;
        }
        const int nitems = (d.K / 64) * (d.Nuse / 32);
        int first = (gw - (it0 % NGW) + NGW) % NGW;
        for (int item = first; item < nitems; item += NGW) p0_weight(d, item, scr, F.lane);
        it0 += nitems;
    }
    {
        bf16* WT = (bf16*)(ws + WS_WIN); const float* W = a->in[9]; const float* g = a->in[8];
        const int gt = (F.vcu * NWAVES + F.wave) * 64 + F.lane, NGT = F.G * NWAVES * 64;
        for (int e = gt; e < 256 * 1024; e += NGT) { const int n = 4096 + (e >> 10), k = e & 1023; WT[(size_t)n * 1024 + k] = (n < 4112) ? (bf16)f2bf(W[(size_t)k * 4112 + n] * g[k]) : (bf16)0; }
    }
    {
        bf16* XB = (bf16*)(ws + WS_XB); float* SSQ = (float*)(ws + WS_SSQX);
        for (int m = gw; m < MT; m += NGW) {
            const float* xrow = (m < MP) ? a->in[0] + (size_t)m * DM : a->in[1] + (size_t)(m - MP) * DM;
            const GAS f32x4* xr = (const GAS f32x4*)xrow + F.lane;
            f32x4 v[4]; float s = 0.f;
#pragma unroll
            for (int j = 0; j < 4; ++j) { v[j] = xr[64 * j]; s += (v[j].x * v[j].x + v[j].y * v[j].y) + (v[j].z * v[j].z + v[j].w * v[j].w); }
            s = wave_sum(s);
            GAS unsigned long long* o8 = (GAS unsigned long long*)(XB + (size_t)m * DM) + F.lane;
#pragma unroll
            for (int j = 0; j < 4; ++j) o8[64 * j] = (unsigned long long)pk2(v[j].x, v[j].y) | ((unsigned long long)pk2(v[j].z, v[j].w) << 32);
            if (F.lane < 16) SSQ[(size_t)m * 16 + F.lane] = (F.lane == 0) ? s : 0.f;
        }
    }
    {
        bf16* PEB = (bf16*)(ws + WS_PEB);
        const size_t gt = (size_t)(F.vcu * NWAVES + F.wave) * 64 + F.lane, NGT = (size_t)F.G * NWAVES * 64;
        const size_t nchunk = (size_t)2 * MT * 256 / 8;
        for (size_t c = gt; c < nchunk; c += NGT) {
            const size_t e = c * 8; const int l = (int)(e / ((size_t)MT * 256)); const size_t rem = e - (size_t)l * MT * 256; const size_t row = rem >> 8; const int col = (int)(rem & 255);
            const float* src = (row < (size_t)MP) ? a->in[6] + ((size_t)l * MP + row) * 256 + col : a->in[7] + ((size_t)l * MS + (row - MP)) * 256 + col;
            const f32x4 v0 = *(const GAS f32x4*)src, v1 = *(const GAS f32x4*)(src + 4);
            v4u o; o.x = pk2(v0.x, v0.y); o.y = pk2(v0.z, v0.w); o.z = pk2(v1.x, v1.y); o.w = pk2(v1.z, v1.w);
            *(GAS v4u*)(PEB + e) = o;
        }
    }
}

__device__ __forceinline__ void delta_seq_item(Frame& F, cargs_t a, int item) {
    unsigned char* ws = a->ws;
    const int tid = F.tid, kq = tid >> 7, v = tid & 127, wave = F.wave, lane = F.lane;
    const bool prompt = item < 128;
    int b, h, T; size_t rowbase;
    if (prompt) { b = item >> 3; h = item & 7; T = 2048; rowbase = (size_t)b * 2048; }
    else { const int it = item - 128; b = it >> 3; h = it & 7; T = 8; rowbase = (size_t)MP + (size_t)b * 8; }
    LAS float* L = (LAS float*)(F.lds + RING_OFF);
    LAS float* vec = L;
    LAS float* red = L + 384;
    LAS float* part = L + 512;
    LAS float* opart = L + 1024;
    LAS float* red2 = L + 1536;
    float S[32];
    if (prompt) {
#pragma unroll
        for (int i = 0; i < 32; ++i) S[i] = 0.f;
    } else {
        const float* sd = a->in[2] + ((size_t)(b * 8 + h) * 128 + 32 * kq) * 128 + v;
#pragma unroll
        for (int i = 0; i < 32; ++i) S[i] = sd[(size_t)i * 128];
    }
    const int ch = kq * 1024 + h * 128 + v;
    float cw0 = 0.f, cw1 = 0.f, cw2 = 0.f, cw3 = 0.f, xm3 = 0.f, xm2 = 0.f, xm1 = 0.f;
    if (kq < 3) {
        const float* cw = a->in[10];
        cw0 = cw[ch]; cw1 = cw[3072 + ch]; cw2 = cw[2 * 3072 + ch]; cw3 = cw[3 * 3072 + ch];
        if (!prompt) { const float* sc = a->in[3] + (size_t)b * 3 * 3072 + ch; xm3 = sc[0]; xm2 = sc[3072]; xm1 = sc[2 * 3072]; }
    }
    const float Aneg = -__expf(a->in[11][h]), dtb = a->in[12][h], outg = a->in[13][v];
    const bf16* xsrc = (kq < 3) ? (const bf16*)(ws + WS_QKV) + rowbase * 3072 + ch : (const bf16*)(ws + WS_Z) + rowbase * 1024 + h * 128 + v;
    const size_t xstride = (kq < 3) ? 3072 : 1024;
    const float* absrc = (const float*)(ws + WS_AB) + rowbase * 16 + h;
    bf16* og = (bf16*)(ws + WS_OG) + rowbase * 1024 + h * 128 + v;
    unsigned short xs[8]; float aa[8], bb[8];
#pragma unroll
    for (int j = 0; j < 8; ++j) { xs[j] = xsrc[(size_t)j * xstride]; aa[j] = absrc[(size_t)j * 16]; bb[j] = absrc[(size_t)j * 16 + 8]; }
    float o_prev = 0.f, z_prev = 0.f; bool have_prev = false;
    __syncthreads();
    for (int t0 = 0; t0 < T; t0 += 8) {
        unsigned short xc[8]; float ac[8], bc[8];
#pragma unroll
        for (int j = 0; j < 8; ++j) { xc[j] = xs[j]; ac[j] = aa[j]; bc[j] = bb[j]; }
        if (t0 + 8 < T) {
#pragma unroll
            for (int j = 0; j < 8; ++j) { xs[j] = xsrc[(size_t)(t0 + 8 + j) * xstride]; aa[j] = absrc[(size_t)(t0 + 8 + j) * 16]; bb[j] = absrc[(size_t)(t0 + 8 + j) * 16 + 8]; }
        }
#pragma unroll
        for (int tt = 0; tt < 8; ++tt) {
            const float x = bf2f(xc[tt]);
            float zcur = 0.f;
            if (kq < 3) {
                const float c = (xm3 * cw0 + xm2 * cw1) + (xm1 * cw2 + x * cw3);
                xm3 = xm2; xm2 = xm1; xm1 = x;
                const float s = c * sigmoidf_(c);
                vec[kq * 128 + v] = s;
                if (kq < 2) { const float q2 = wave_sum(s * s); if (lane == 0) red[wave] = q2; }
            } else zcur = x;
            __syncthreads();
            if (kq == 3 && have_prev) {
                const float tot = red2[0] + red2[1];
                const float ov = o_prev * rsqrtf(tot * (1.0f / 128.0f) + 1e-6f) * outg * (z_prev * sigmoidf_(z_prev));
                og[(size_t)(t0 + tt - 1) * 1024] = (bf16)f2bf(ov);
            }
            const float rq = rsqrtf(red[0] + red[1] + 1e-6f) * 0.08838834764831845f, rk = rsqrtf(red[2] + red[3] + 1e-6f);
            const float beta = sigmoidf_(bc[tt]);
            const float sp_in = ac[tt] + dtb; const float sp = (sp_in > 15.f) ? sp_in : log1pf(__expf(sp_in));
            const float adec = __expf(Aneg * sp);
            float kv[32];
            {
                float p = 0.f;
#pragma unroll
                for (int i = 0; i < 8; ++i) { const f32x4 k4 = *(const LAS f32x4*)(vec + 128 + 32 * kq + 4 * i); kv[4 * i] = k4[0]; kv[4 * i + 1] = k4[1]; kv[4 * i + 2] = k4[2]; kv[4 * i + 3] = k4[3];
                    p += (k4[0] * S[4 * i] + k4[1] * S[4 * i + 1]) + (k4[2] * S[4 * i + 2] + k4[3] * S[4 * i + 3]); }
                part[kq * 128 + v] = p;
            }
            __syncthreads();
            {
                const float kS = rk * ((part[v] + part[128 + v]) + (part[256 + v] + part[384 + v]));
                const float d = beta * (vec[256 + v] - adec * kS) * rk;
                float po = 0.f;
#pragma unroll
                for (int i = 0; i < 8; ++i) { const f32x4 q4 = *(const LAS f32x4*)(vec + 32 * kq + 4 * i);
#pragma unroll
                    for (int j = 0; j < 4; ++j) { S[4 * i + j] = adec * S[4 * i + j] + kv[4 * i + j] * d; po += q4[j] * S[4 * i + j]; } }
                opart[kq * 128 + v] = po * rq;
            }
            __syncthreads();
            if (kq == 3) {
                const float o = (opart[v] + opart[128 + v]) + (opart[256 + v] + opart[384 + v]);
                const float o2 = wave_sum(o * o); if (lane == 0) red2[wave - 6] = o2;
                o_prev = o; z_prev = zcur;
            }
            have_prev = true;
        }
    }
    __syncthreads();
    if (kq == 3) {
        const float tot = red2[0] + red2[1];
        const float ov = o_prev * rsqrtf(tot * (1.0f / 128.0f) + 1e-6f) * outg * (z_prev * sigmoidf_(z_prev));
        og[(size_t)(T - 1) * 1024] = (bf16)f2bf(ov);
    }
    {
        float* so = a->out + (prompt ? O_SDP : O_SDS) + ((size_t)(b * 8 + h) * 128 + 32 * kq) * 128 + v;
#pragma unroll
        for (int i = 0; i < 32; ++i) so[(size_t)i * 128] = S[i];
    }
}

__device__ __forceinline__ void attn_prompt_item(Frame& F, cargs_t a, int item) {
    unsigned char* ws = a->ws;
    const int qblk = item & 15, kvh = (item >> 4) & 3, b = item >> 6;
    const int tid = F.tid, wave = F.wave, lane = F.lane;
    LAS float* Kf = (LAS float*)(F.lds + RING_OFF);
    LAS float* Vf = Kf + 256 * 64;
    const bf16* KV = (const bf16*)(ws + WS_KV);
    __syncthreads();
    for (int idx = tid; idx < 256 * 16; idx += 512) {
        const int key = idx >> 4, c = idx & 15;
        const long srow = (long)qblk * 128 - 128 + key;
        f32x4 v0 = (f32x4){0.f, 0.f, 0.f, 0.f}, v1 = v0;
        if (srow >= 0) {
            const v4u w = *(const GAS v4u*)(KV + ((size_t)b * 2048 + (size_t)srow) * 512 + (c < 8 ? kvh * 64 + c * 8 : 256 + kvh * 64 + (c - 8) * 8));
            v0 = (f32x4){__uint_as_float(w.x << 16), __uint_as_float(w.x & 0xffff0000u), __uint_as_float(w.y << 16), __uint_as_float(w.y & 0xffff0000u)};
            v1 = (f32x4){__uint_as_float(w.z << 16), __uint_as_float(w.z & 0xffff0000u), __uint_as_float(w.w << 16), __uint_as_float(w.w & 0xffff0000u)};
        }
        LAS float* dst = (c < 8 ? Kf + key * 64 + c * 8 : Vf + key * 64 + (c - 8) * 8);
        *(LAS f32x4*)dst = v0; *(LAS f32x4*)(dst + 4) = v1;
    }
    __syncthreads();
    const int g = wave >> 1, qi = (wave & 1) * 64 + lane, head = kvh * 4 + g;
    const size_t row = (size_t)b * 2048 + (size_t)qblk * 128 + qi;
    float q[64];
    {
        const bf16* qp = (const bf16*)(ws + WS_Q) + row * 1024 + head * 64;
#pragma unroll
        for (int c = 0; c < 8; ++c) { const v4u w = *(const GAS v4u*)(qp + c * 8);
            q[c * 8 + 0] = __uint_as_float(w.x << 16); q[c * 8 + 1] = __uint_as_float(w.x & 0xffff0000u); q[c * 8 + 2] = __uint_as_float(w.y << 16); q[c * 8 + 3] = __uint_as_float(w.y & 0xffff0000u);
            q[c * 8 + 4] = __uint_as_float(w.z << 16); q[c * 8 + 5] = __uint_as_float(w.z & 0xffff0000u); q[c * 8 + 6] = __uint_as_float(w.w << 16); q[c * 8 + 7] = __uint_as_float(w.w & 0xffff0000u); }
    }
    float mrun = a->in[19][head], l = 1.0f;
    float acc[64];
#pragma unroll
    for (int d = 0; d < 64; ++d) acc[d] = 0.f;
    int jlo = (wave & 1) * 64; const int jhi = (wave & 1) * 64 + 192; if (qblk == 0 && jlo < 128) jlo = 128;
#pragma unroll 1
    for (int j = jlo; j < jhi; ++j) {
        const LAS float* kr = Kf + j * 64; float t = 0.f;
#pragma unroll
        for (int d = 0; d < 16; ++d) { const f32x4 k4 = *(const LAS f32x4*)(kr + 4 * d); t += (q[4 * d] * k4[0] + q[4 * d + 1] * k4[1]) + (q[4 * d + 2] * k4[2] + q[4 * d + 3] * k4[3]); }
        const bool ok = (j >= qi + 1) && (j <= qi + 128) && (qblk > 0 || j >= 128);
        t = ok ? t : -1e30f;
        if (t > mrun) {
            const float f = __expf(mrun - t); mrun = t; l *= f;
#pragma unroll
            for (int d = 0; d < 64; ++d) acc[d] *= f;
        }
        const float p = __expf(t - mrun); l += p;
        const LAS float* vr = Vf + j * 64;
#pragma unroll
        for (int d = 0; d < 16; ++d) { const f32x4 v4 = *(const LAS f32x4*)(vr + 4 * d); acc[4 * d] += p * v4[0]; acc[4 * d + 1] += p * v4[1]; acc[4 * d + 2] += p * v4[2]; acc[4 * d + 3] += p * v4[3]; }
    }
    const float inv = 1.0f / l;
    bf16* op = (bf16*)(ws + WS_OB) + row * 1024 + head * 64;
#pragma unroll
    for (int c = 0; c < 8; ++c) { v4u o; o.x = pk2(acc[c * 8] * inv, acc[c * 8 + 1] * inv); o.y = pk2(acc[c * 8 + 2] * inv, acc[c * 8 + 3] * inv); o.z = pk2(acc[c * 8 + 4] * inv, acc[c * 8 + 5] * inv); o.w = pk2(acc[c * 8 + 6] * inv, acc[c * 8 + 7] * inv); *(GAS v4u*)(op + c * 8) = o; }
}
__device__ __forceinline__ void attn_sample_item(Frame& F, cargs_t a, int item) {
    unsigned char* ws = a->ws;
    const int kvh = item & 3, b = item >> 2;
    const int tid = F.tid;
    LAS float* Kf = (LAS float*)(F.lds + RING_OFF);
    LAS float* Vf = Kf + 136 * 64;
    LAS float* Sc = Vf + 136 * 64;
    const bf16* KV = (const bf16*)(ws + WS_KV);
    __syncthreads();
    for (int idx = tid; idx < 128 * 32; idx += 512) {
        const int key = idx >> 5, c = idx & 31; const int isv = c >> 4, cc = c & 15;
        const float* src = a->in[isv ? 5 : 4] + ((size_t)(b * 128 + key) * 4 + kvh) * 64 + cc * 4;
        const f32x4 v = *(const GAS f32x4*)src;
        *(LAS f32x4*)((isv ? Vf : Kf) + key * 64 + cc * 4) = v;
        if (key >= 8) *(GAS f32x4*)(a->out + (isv ? O_VWS : O_KWS) + ((size_t)(b * 128 + key - 8) * 4 + kvh) * 64 + cc * 4) = v;
    }
    for (int idx = tid; idx < 8 * 16; idx += 512) {
        const int t = idx >> 4, c = idx & 15;
        const v4u w = *(const GAS v4u*)(KV + ((size_t)MP + (size_t)b * 8 + t) * 512 + (c < 8 ? kvh * 64 + c * 8 : 256 + kvh * 64 + (c - 8) * 8));
        LAS float* dst = (c < 8 ? Kf + (128 + t) * 64 + c * 8 : Vf + (128 + t) * 64 + (c - 8) * 8);
        *(LAS f32x4*)dst = (f32x4){__uint_as_float(w.x << 16), __uint_as_float(w.x & 0xffff0000u), __uint_as_float(w.y << 16), __uint_as_float(w.y & 0xffff0000u)};
        *(LAS f32x4*)(dst + 4) = (f32x4){__uint_as_float(w.z << 16), __uint_as_float(w.z & 0xffff0000u), __uint_as_float(w.w << 16), __uint_as_float(w.w & 0xffff0000u)};
    }
    __syncthreads();
    const int r = tid & 31, ks = tid >> 5;
    const int t = r >> 2, g = r & 3, head = kvh * 4 + g;
    const size_t row = (size_t)MP + (size_t)b * 8 + t;
    {
        float q[64];
        const bf16* qp = (const bf16*)(ws + WS_Q) + row * 1024 + head * 64;
#pragma unroll
        for (int c = 0; c < 8; ++c) { const v4u w = *(const GAS v4u*)(qp + c * 8);
            q[c * 8 + 0] = __uint_as_float(w.x << 16); q[c * 8 + 1] = __uint_as_float(w.x & 0xffff0000u); q[c * 8 + 2] = __uint_as_float(w.y << 16); q[c * 8 + 3] = __uint_as_float(w.y & 0xffff0000u);
            q[c * 8 + 4] = __uint_as_float(w.z << 16); q[c * 8 + 5] = __uint_as_float(w.z & 0xffff0000u); q[c * 8 + 6] = __uint_as_float(w.w << 16); q[c * 8 + 7] = __uint_as_float(w.w & 0xffff0000u); }
        for (int j = ks; j < 136; j += 16) {
            const LAS float* kr = Kf + j * 64; float s = 0.f;
#pragma unroll
            for (int d = 0; d < 16; ++d) { const f32x4 k4 = *(const LAS f32x4*)(kr + 4 * d); s += (q[4 * d] * k4[0] + q[4 * d + 1] * k4[1]) + (q[4 * d + 2] * k4[2] + q[4 * d + 3] * k4[3]); }
            const bool ok = (j < 128) ? (j >= t + 1) : (j - 128 <= t);
            Sc[r * 136 + j] = ok ? s : -1e30f;
        }
    }
    __syncthreads();
    {
        const float sink = a->in[19][head];
        float mx = sink;
        for (int j = 0; j < 136; ++j) mx = fmaxf(mx, Sc[r * 136 + j]);
        float l = __expf(sink - mx); f32x4 o = (f32x4){0.f, 0.f, 0.f, 0.f};
        for (int j = 0; j < 136; ++j) { const float p = __expf(Sc[r * 136 + j] - mx); l += p; const f32x4 v4 = *(const LAS f32x4*)(Vf + j * 64 + ks * 4); o += v4 * p; }
        const float inv = 1.0f / l;
        bf16* op = (bf16*)(ws + WS_OB) + row * 1024 + head * 64 + ks * 4;
        *(GAS unsigned long long*)op = (unsigned long long)pk2(o[0] * inv, o[1] * inv) | ((unsigned long long)pk2(o[2] * inv, o[3] * inv) << 32);
    }
}

__device__ __forceinline__ void final_norm(Frame& F, cargs_t a) {
    const int gw = F.vcu * NWAVES + F.wave, NGW = F.G * NWAVES;
    const GAS f32x4* gn = (const GAS f32x4*)a->in[27] + F.lane;
    f32x4 g[4];
#pragma unroll
    for (int j = 0; j < 4; ++j) g[j] = gn[64 * j];
    for (int m = gw; m < MT; m += NGW) {
        GAS f32x4* yr = (GAS f32x4*)(a->out + O_Y + (size_t)m * DM) + F.lane;
        f32x4 v[4]; float s = 0.f;
#pragma unroll
        for (int j = 0; j < 4; ++j) { v[j] = yr[64 * j]; s += (v[j].x * v[j].x + v[j].y * v[j].y) + (v[j].z * v[j].z + v[j].w * v[j].w); }
        const float rstd = rsqrtf(wave_sum(s) * (1.f / DM) + 1e-6f);
#pragma unroll
        for (int j = 0; j < 4; ++j) yr[64 * j] = v[j] * rstd * g[j];
    }
}
typedef short bf16x8 __attribute__((ext_vector_type(8)));
typedef short bf16x4 __attribute__((ext_vector_type(4)));
typedef LAS const unsigned char* lcp;
constexpr int PREP_HALF = 71680;
constexpr int PL_KB = 0, PL_QB = 17408, PL_VB = 34816, PL_AM = 52224, PL_TB = 69632;
__device__ __forceinline__ unsigned cvtpk(float lo, float hi) { unsigned r; asm volatile("v_cvt_pk_bf16_f32 %0, %1, %2" : "=v"(r) : "v"(lo), "v"(hi)); return r; }
__device__ __forceinline__ f32x4 bfx4lo(unsigned a, unsigned b) { return (f32x4){__uint_as_float(a << 16), __uint_as_float(a & 0xffff0000u), __uint_as_float(b << 16), __uint_as_float(b & 0xffff0000u)}; }

__device__ __forceinline__ void dprep_pair(Frame& F, cargs_t a, int pair) {
    unsigned char* ws = a->ws;
    const int tid = F.tid, half = tid >> 8, t8 = tid & 255, lane = F.lane, w4 = (tid >> 6) & 3;
    const int item = 2 * pair + half, c = item & 31, h = (item >> 5) & 7, b = item >> 8;
    const size_t t0 = (size_t)b * 2048 + (size_t)c * 64; const int chunkg = b * 32 + c;
    LAS unsigned char* L = F.lds + RING_OFF + half * PREP_HALF;
    LAS float* TB = (LAS float*)(L + PL_TB);
    LAS float* AM = (LAS float*)(L + PL_AM);
    const bf16* QKV = (const bf16*)(ws + WS_QKV); const bf16* HALO = (const bf16*)(ws + WS_HALO);
    __syncthreads();
    {
        const int tg = t8 >> 4, cg = t8 & 15;
#pragma unroll 1
        for (int p = 0; p < 3; ++p) {
            const int colbase = p * 1024 + h * 128 + 8 * cg;
            v4u raw[7];
#pragma unroll
            for (int i = 0; i < 7; ++i) {
                const int lr = 4 * tg - 3 + i;
                if (lr >= 0) raw[i] = *(const GAS v4u*)(QKV + (t0 + lr) * 3072 + colbase);
                else if (c > 0) raw[i] = *(const GAS v4u*)(HALO + ((size_t)(chunkg - 1) * 3 + (lr + 3)) * 3072 + colbase);
                else raw[i] = (v4u){0u, 0u, 0u, 0u};
            }
            const float* cw = a->in[10] + colbase;
            f32x4 w[4][2];
#pragma unroll
            for (int k = 0; k < 4; ++k) { w[k][0] = *(const GAS f32x4*)(cw + k * 3072); w[k][1] = *(const GAS f32x4*)(cw + k * 3072 + 4); }
            f32x4 o[4][2];
#pragma unroll
            for (int tok = 0; tok < 4; ++tok) { o[tok][0] = (f32x4){0.f, 0.f, 0.f, 0.f}; o[tok][1] = o[tok][0]; }
#pragma unroll
            for (int i = 0; i < 7; ++i) {
                const f32x4 x0 = bfx4lo(raw[i].x, raw[i].y), x1 = bfx4lo(raw[i].z, raw[i].w);
#pragma unroll
                for (int tok = 0; tok < 4; ++tok) { const int k = i - tok; if (k >= 0 && k < 4) { o[tok][0] += x0 * w[k][0]; o[tok][1] += x1 * w[k][1]; } }
            }
            LAS unsigned char* dst = L + (p == 0 ? PL_QB : (p == 1 ? PL_KB : PL_VB));
#pragma unroll
            for (int tok = 0; tok < 4; ++tok) {
                float ss = 0.f;
#pragma unroll
                for (int e = 0; e < 4; ++e) { float x = o[tok][0][e]; x = x * sigmoidf_(x); o[tok][0][e] = x; ss += x * x; float y = o[tok][1][e]; y = y * sigmoidf_(y); o[tok][1][e] = y; ss += y * y; }
                if (p < 2) {
                    ss += __shfl_xor(ss, 1); ss += __shfl_xor(ss, 2); ss += __shfl_xor(ss, 4); ss += __shfl_xor(ss, 8);
                    const float rn = rsqrtf(ss + 1e-6f) * (p == 0 ? 0.08838834764831845f : 1.0f);
                    o[tok][0] = o[tok][0] * rn; o[tok][1] = o[tok][1] * rn;
                }
                v4u pk; pk.x = cvtpk(o[tok][0][0], o[tok][0][1]); pk.y = cvtpk(o[tok][0][2], o[tok][0][3]); pk.z = cvtpk(o[tok][1][0], o[tok][1][1]); pk.w = cvtpk(o[tok][1][2], o[tok][1][3]);
                *(LAS v4u*)(dst + (4 * tg + tok) * 272 + cg * 16) = pk;
            }
        }
    }
    if (w4 == 0) {
        const float* ab = (const float*)(ws + WS_AB) + (t0 + lane) * 16 + h;
        const float av = ab[0], bv = ab[8];
        const float Aneg = -__expf(a->in[11][h]), dtb = a->in[12][h];
        const float beta = sigmoidf_(bv);
        const float spi = av + dtb; const float sp = (spi > 15.f) ? spi : log1pf(__expf(spi));
        float gc = Aneg * sp;
#pragma unroll
        for (int o = 1; o < 64; o <<= 1) { const float t = __shfl_up(gc, o); if (lane >= o) gc += t; }
        const float glast = __shfl(gc, 63);
        const float eg = __expf(gc), ek = __expf(glast - gc);
        TB[lane] = beta; TB[64 + lane] = gc; TB[128 + lane] = eg; TB[192 + lane] = ek; TB[256 + lane] = beta; TB[320 + lane] = beta * eg;
        float* scl = (float*)(ws + WS_SCL) + ((size_t)chunkg * 8 + h) * 128;
        scl[lane] = eg; scl[64 + lane] = ek;
    }
    __syncthreads();
    {
        const int fr = lane & 15, fq = lane >> 4;
        f32x4 kk[4], qq[4];
#pragma unroll
        for (int nt = 0; nt < 4; ++nt) { kk[nt] = (f32x4){0.f, 0.f, 0.f, 0.f}; qq[nt] = kk[nt]; }
#pragma unroll
        for (int ks = 0; ks < 4; ++ks) {
            const bf16x8 ak = *(const LAS bf16x8*)(L + PL_KB + (16 * w4 + fr) * 272 + ks * 64 + fq * 16);
            const bf16x8 aq = *(const LAS bf16x8*)(L + PL_QB + (16 * w4 + fr) * 272 + ks * 64 + fq * 16);
#pragma unroll
            for (int nt = 0; nt < 4; ++nt) {
                const bf16x8 bk = *(const LAS bf16x8*)(L + PL_KB + (16 * nt + fr) * 272 + ks * 64 + fq * 16);
                kk[nt] = __builtin_amdgcn_mfma_f32_16x16x32_bf16(ak, bk, kk[nt], 0, 0, 0);
                qq[nt] = __builtin_amdgcn_mfma_f32_16x16x32_bf16(aq, bk, qq[nt], 0, 0, 0);
            }
        }
        bf16* QKM = (bf16*)(ws + WS_QKM);
#pragma unroll
        for (int j = 0; j < 4; ++j) {
            const int i = 16 * w4 + 4 * fq + j; const float gi = TB[64 + i], bi = TB[i];
#pragma unroll
            for (int nt = 0; nt < 4; ++nt) {
                const int jj = 16 * nt + fr; const float d = __expf(fminf(gi - TB[64 + jj], 0.f));
                AM[i * 68 + jj] = (i > jj) ? bi * kk[nt][j] * d : 0.f;
                QKM[(t0 + i) * 512 + h * 64 + jj] = (bf16)f2bf((i >= jj) ? qq[nt][j] * d : 0.f);
            }
        }
    }
    __syncthreads();
    {
        const bool isv = t8 < 128; const int col = t8 & 127;
        LAS const bf16* src = (LAS const bf16*)(L + (isv ? PL_VB : PL_KB)) + col;
        LAS const float* coef = TB + (isv ? 256 : 320);
        float x[64];
#pragma unroll
        for (int i = 0; i < 64; ++i) x[i] = 0.f;
#pragma unroll
        for (int i = 0; i < 64; ++i) {
            float r = bf2f(src[i * 136]) * coef[i];
#pragma unroll
            for (int j4 = 0; j4 < (i + 3) / 4; ++j4) {
                const f32x4 a4 = *(LAS const f32x4*)(AM + i * 68 + 4 * j4);
                r -= a4[0] * x[4 * j4]; r -= a4[1] * x[4 * j4 + 1]; r -= a4[2] * x[4 * j4 + 2]; r -= a4[3] * x[4 * j4 + 3];
            }
            x[i] = r;
        }
        if (isv) {
            bf16* ut = (bf16*)(ws + WS_UTB) + (t0 + (col >> 1)) * 1024 + h * 128 + (col & 1) * 64;
#pragma unroll
            for (int g = 0; g < 8; ++g) { v4u pk; pk.x = cvtpk(x[8 * g], x[8 * g + 1]); pk.y = cvtpk(x[8 * g + 2], x[8 * g + 3]); pk.z = cvtpk(x[8 * g + 4], x[8 * g + 5]); pk.w = cvtpk(x[8 * g + 6], x[8 * g + 7]); *(GAS v4u*)(ut + 8 * g) = pk; }
        } else {
            bf16* nw = (bf16*)(ws + WS_QKV) + t0 * 3072 + 2048 + h * 128 + col;
#pragma unroll
            for (int i = 0; i < 64; ++i) nw[(size_t)i * 3072] = (bf16)f2bf(-x[i]);
        }
    }
    {
        bf16* qd = (bf16*)(ws + WS_QKV) + t0 * 3072 + h * 128;
#pragma unroll
        for (int i = 0; i < 4; ++i) { const int ch = t8 + 256 * i, row = ch >> 4, cc = ch & 15; *(GAS v4u*)(qd + (size_t)row * 3072 + cc * 8) = *(const LAS v4u*)(L + PL_QB + row * 272 + cc * 16); }
        bf16* kd = (bf16*)(ws + WS_QKV) + t0 * 3072 + 1024 + h * 128;
        LAS const bf16* kb = (LAS const bf16*)(L + PL_KB);
#pragma unroll
        for (int i = 0; i < 4; ++i) {
            const int ch = t8 + 256 * i, k = ch >> 3, cgp = ch & 7;
            unsigned short e[8];
#pragma unroll
            for (int j = 0; j < 8; ++j) e[j] = kb[(8 * cgp + j) * 136 + k];
            v4u pk; pk.x = e[0] | ((unsigned)e[1] << 16); pk.y = e[2] | ((unsigned)e[3] << 16); pk.z = e[4] | ((unsigned)e[5] << 16); pk.w = e[6] | ((unsigned)e[7] << 16);
            *(GAS v4u*)(kd + (size_t)(k >> 1) * 3072 + (k & 1) * 64 + cgp * 8) = pk;
        }
    }
}

constexpr int SL_Q = 0, SL_W = 17408, SL_KT = 34816, SL_QK = 53248, SL_SC = 62464, SL_OT = 62976;
__device__ __forceinline__ bf16x8 frag2(LAS const unsigned char* p) {
    const bf16x4 lo = *(LAS const bf16x4*)p, hi = *(LAS const bf16x4*)(p + 32);
    return (bf16x8){lo[0], lo[1], lo[2], lo[3], hi[0], hi[1], hi[2], hi[3]};
}
__device__ __forceinline__ bf16x8 packB(const f32x4 lo, const f32x4 hi) {
    const unsigned a = cvtpk(lo[0], lo[1]), b = cvtpk(lo[2], lo[3]), c = cvtpk(hi[0], hi[1]), d = cvtpk(hi[2], hi[3]);
    return __builtin_bit_cast(bf16x8, (v4u){a, b, c, d});
}
__device__ __forceinline__ void dscan_item(Frame& F, cargs_t a, int item) {
    unsigned char* ws = a->ws;
    const int tid = F.tid, lane = F.lane, w = F.wave, fr = lane & 15, fq = lane >> 4;
    const int b = item >> 3, h = item & 7;
    const size_t tb = (size_t)b * 2048;
    LAS unsigned char* L = F.lds + RING_OFF;
    const bf16* QKV = (const bf16*)(ws + WS_QKV); const bf16* QKM = (const bf16*)(ws + WS_QKM); const bf16* UTB = (const bf16*)(ws + WS_UTB);
    const bf16* Zb = (const bf16*)(ws + WS_Z); const float* SCL = (const float*)(ws + WS_SCL);
    bf16* OGp = (bf16*)(ws + WS_OG);
    f32x4 S[8];
#pragma unroll
    for (int st = 0; st < 8; ++st) S[st] = (f32x4){0.f, 0.f, 0.f, 0.f};
    const int r0 = tid >> 4, c0 = tid & 15;
    const int r1 = tid >> 3, c1 = tid & 7;
    const int grow = tid >> 3, gcg = tid & 7;
    v4u pq[2], pw[2], pk[2], pqk, psc, pz[2]; unsigned long long put[4];
    const float* og_gain = a->in[13] + 16 * gcg;
#define DS_LOAD(ci) do { const size_t t0_ = tb + (size_t)(ci) * 64; \
        _Pragma("unroll") for (int i_ = 0; i_ < 2; ++i_) { const bf16* rp = QKV + (t0_ + r0 + 32 * i_) * 3072 + h * 128 + c0 * 8; pq[i_] = *(const GAS v4u*)rp; pk[i_] = *(const GAS v4u*)(rp + 1024); pw[i_] = *(const GAS v4u*)(rp + 2048); } \
        pqk = *(const GAS v4u*)(QKM + (t0_ + r1) * 512 + h * 64 + c1 * 8); \
        if (tid < 32) psc = *(const GAS v4u*)(SCL + ((size_t)(b * 32 + (ci)) * 8 + h) * 128 + tid * 4); \
        _Pragma("unroll") for (int i_ = 0; i_ < 2; ++i_) pz[i_] = *(const GAS v4u*)(Zb + (t0_ + grow) * 1024 + h * 128 + gcg * 16 + i_ * 8); \
        { const int v_ = 16 * w + fr; const bf16* up = UTB + (t0_ + (v_ >> 1)) * 1024 + h * 128 + (v_ & 1) * 64 + 4 * fq; \
          _Pragma("unroll") for (int mt_ = 0; mt_ < 4; ++mt_) put[mt_] = *(const GAS unsigned long long*)(up + 16 * mt_); } } while (0)
    DS_LOAD(0);
    v4u zprev[2] = {pz[0], pz[1]};
#pragma unroll 1
    for (int ci = 0; ci <= 32; ++ci) {
        __syncthreads();
        f32x4 u[4];
        if (ci < 32) {
#pragma unroll
            for (int i = 0; i < 2; ++i) {
                *(LAS v4u*)(L + SL_Q + (r0 + 32 * i) * 272 + c0 * 16) = pq[i];
                *(LAS v4u*)(L + SL_W + (r0 + 32 * i) * 272 + c0 * 16) = pw[i];
                { const int kr = 2 * (r0 + 32 * i) + (c0 >> 3); *(LAS v4u*)(L + SL_KT + kr * 144 + (c0 & 7) * 16) = pk[i]; }
            }
            *(LAS v4u*)(L + SL_QK + r1 * 144 + c1 * 16) = pqk;
            if (tid < 32) *(LAS v4u*)(L + SL_SC + tid * 16) = psc;
#pragma unroll
            for (int mt = 0; mt < 4; ++mt) u[mt] = bfx4lo((unsigned)put[mt], (unsigned)(put[mt] >> 32));
        }
        if (ci > 0) {
            const v4u o0 = *(const LAS v4u*)(L + SL_OT + grow * 272 + gcg * 32), o1 = *(const LAS v4u*)(L + SL_OT + grow * 272 + gcg * 32 + 16);
            f32x4 ov[4] = {bfx4lo(o0.x, o0.y), bfx4lo(o0.z, o0.w), bfx4lo(o1.x, o1.y), bfx4lo(o1.z, o1.w)};
            float ss = (dot4s(ov[0]) + dot4s(ov[1])) + (dot4s(ov[2]) + dot4s(ov[3]));
            ss += __shfl_xor(ss, 1); ss += __shfl_xor(ss, 2); ss += __shfl_xor(ss, 4);
            const float rn = rsqrtf(ss * (1.0f / 128.0f) + 1e-6f);
            const f32x4 zv[4] = {bfx4lo(zprev[0].x, zprev[0].y), bfx4lo(zprev[0].z, zprev[0].w), bfx4lo(zprev[1].x, zprev[1].y), bfx4lo(zprev[1].z, zprev[1].w)};
            unsigned pkd[8];
#pragma unroll
            for (int q4 = 0; q4 < 4; ++q4) {
                const f32x4 gn = *(const GAS f32x4*)(og_gain + 4 * q4); f32x4 r;
#pragma unroll
                for (int e = 0; e < 4; ++e) { const float z = zv[q4][e]; r[e] = ov[q4][e] * rn * gn[e] * (z * sigmoidf_(z)); }
                pkd[2 * q4] = cvtpk(r[0], r[1]); pkd[2 * q4 + 1] = cvtpk(r[2], r[3]);
            }
            bf16* op = OGp + (tb + (size_t)(ci - 1) * 64 + grow) * 1024 + h * 128 + gcg * 16;
            *(GAS v4u*)op = (v4u){pkd[0], pkd[1], pkd[2], pkd[3]}; *(GAS v4u*)(op + 8) = (v4u){pkd[4], pkd[5], pkd[6], pkd[7]};
        }
        if (ci == 32) break;
        zprev[0] = pz[0]; zprev[1] = pz[1];
        if (ci + 1 < 32) DS_LOAD(ci + 1);
        __syncthreads();
        bf16x8 sb[4];
#pragma unroll
        for (int ks = 0; ks < 4; ++ks) sb[ks] = packB(S[2 * ks], S[2 * ks + 1]);
        f32x4 o[4];
        lcp wbase = (lcp)(L + SL_W + fr * 272 + fq * 8), qbase = (lcp)(L + SL_Q + fr * 272 + fq * 8);
#pragma unroll
        for (int mt = 0; mt < 4; ++mt) {
            o[mt] = (f32x4){0.f, 0.f, 0.f, 0.f};
#pragma unroll
            for (int ks = 0; ks < 4; ++ks) {
                u[mt] = __builtin_amdgcn_mfma_f32_16x16x32_bf16(frag2(wbase + mt * 16 * 272 + ks * 64), sb[ks], u[mt], 0, 0, 0);
                o[mt] = __builtin_amdgcn_mfma_f32_16x16x32_bf16(frag2(qbase + mt * 16 * 272 + ks * 64), sb[ks], o[mt], 0, 0, 0);
            }
        }
        LAS const float* sc = (LAS const float*)(L + SL_SC);
        const float gl = sc[63];
        bf16x8 ub[2], ub2[2];
        {
            f32x4 us[4];
#pragma unroll
            for (int mt = 0; mt < 4; ++mt) { const f32x4 eg = *(LAS const f32x4*)(sc + 16 * mt + 4 * fq), ek = *(LAS const f32x4*)(sc + 64 + 16 * mt + 4 * fq); o[mt] = o[mt] * eg; us[mt] = u[mt] * ek; }
            ub[0] = packB(u[0], u[1]); ub[1] = packB(u[2], u[3]); ub2[0] = packB(us[0], us[1]); ub2[1] = packB(us[2], us[3]);
        }
        lcp kbase = (lcp)(L + SL_QK + fr * 144 + fq * 8), tbase = (lcp)(L + SL_KT + fr * 144 + fq * 8);
#pragma unroll
        for (int mt = 0; mt < 4; ++mt)
#pragma unroll
            for (int ks = 0; ks < 2; ++ks) o[mt] = __builtin_amdgcn_mfma_f32_16x16x32_bf16(frag2(kbase + mt * 16 * 144 + ks * 64), ub[ks], o[mt], 0, 0, 0);
#pragma unroll
        for (int st = 0; st < 8; ++st) {
            S[st] = S[st] * gl;
#pragma unroll
            for (int ks = 0; ks < 2; ++ks) S[st] = __builtin_amdgcn_mfma_f32_16x16x32_bf16(frag2(tbase + st * 16 * 144 + ks * 64), ub2[ks], S[st], 0, 0, 0);
        }
        LAS bf16* ot = (LAS bf16*)(L + SL_OT) + 16 * w + fr;
#pragma unroll
        for (int mt = 0; mt < 4; ++mt)
#pragma unroll
            for (int j = 0; j < 4; ++j) ot[(16 * mt + 4 * fq + j) * 136] = (bf16)f2bf(o[mt][j]);
    }
#undef DS_LOAD
    float* so = a->out + O_SDP + ((size_t)(b * 8 + h) * 128) * 128 + 16 * w + fr;
#pragma unroll
    for (int st = 0; st < 8; ++st)
#pragma unroll
        for (int j = 0; j < 4; ++j) so[(size_t)(16 * st + 4 * fq + j) * 128] = S[st][j];
}
constexpr int AL_K = 0, AL_VT = 36864, AVT_STRIDE = 592;
__device__ __forceinline__ void attn_prompt_mfma(Frame& F, cargs_t a, int item) {
    unsigned char* ws = a->ws;
    const int qblk = item & 15, kvh = (item >> 4) & 3, b = item >> 6;
    const int tid = F.tid, w = F.wave, lane = F.lane, fr = lane & 15, fq = lane >> 4;
    LAS unsigned char* L = F.lds + RING_OFF;
    const bf16* KV = (const bf16*)(ws + WS_KV);
    __syncthreads();
    for (int idx = tid; idx < 256 * 16; idx += 512) {
        const int key = idx >> 4, c = idx & 15;
        const long srow = (long)qblk * 128 - 128 + key;
        v4u wv = (v4u){0u, 0u, 0u, 0u};
        if (srow >= 0) wv = *(const GAS v4u*)(KV + ((size_t)b * 2048 + (size_t)srow) * 512 + (c < 8 ? kvh * 64 + c * 8 : 256 + kvh * 64 + (c - 8) * 8));
        if (c < 8) *(LAS v4u*)(L + AL_K + key * 144 + c * 16) = wv;
        else {
            LAS unsigned short* vt = (LAS unsigned short*)(L + AL_VT) + (size_t)((c - 8) * 8) * (AVT_STRIDE / 2) + key;
            vt[0 * (AVT_STRIDE / 2)] = (unsigned short)(wv.x & 0xffffu); vt[1 * (AVT_STRIDE / 2)] = (unsigned short)(wv.x >> 16);
            vt[2 * (AVT_STRIDE / 2)] = (unsigned short)(wv.y & 0xffffu); vt[3 * (AVT_STRIDE / 2)] = (unsigned short)(wv.y >> 16);
            vt[4 * (AVT_STRIDE / 2)] = (unsigned short)(wv.z & 0xffffu); vt[5 * (AVT_STRIDE / 2)] = (unsigned short)(wv.z >> 16);
            vt[6 * (AVT_STRIDE / 2)] = (unsigned short)(wv.w & 0xffffu); vt[7 * (AVT_STRIDE / 2)] = (unsigned short)(wv.w >> 16);
        }
    }
    if (tid < 256) { const int d = tid >> 2, pc = tid & 3; *(LAS v4u*)(L + AL_VT + d * AVT_STRIDE + 512 + pc * 16) = (v4u){0u, 0u, 0u, 0u}; }
    __syncthreads();
    const int g = w >> 1, head = kvh * 4 + g;
    const float sink = a->in[19][head];
    const bf16* Qb_ = (const bf16*)(ws + WS_Q); bf16* OBp = (bf16*)(ws + WS_OB);
#pragma unroll 1
    for (int qt = 0; qt < 4; ++qt) {
        const int q0 = (w & 1) * 64 + 16 * qt, mt0 = q0 >> 4, qi = q0 + fr;
        const size_t row = (size_t)b * 2048 + (size_t)qblk * 128 + qi;
        bf16x8 qb[2];
#pragma unroll
        for (int ks = 0; ks < 2; ++ks) qb[ks] = *(const GAS bf16x8*)(Qb_ + row * 1024 + head * 64 + ks * 32 + fq * 8);
        f32x4 s[10];
#pragma unroll
        for (int kt = 0; kt < 9; ++kt) {
            s[kt] = (f32x4){0.f, 0.f, 0.f, 0.f};
#pragma unroll
            for (int ks = 0; ks < 2; ++ks) {
                const bf16x8 ka = *(const LAS bf16x8*)(L + AL_K + (16 * (mt0 + kt) + fr) * 144 + ks * 64 + fq * 16);
                s[kt] = __builtin_amdgcn_mfma_f32_16x16x32_bf16(ka, qb[ks], s[kt], 0, 0, 0);
            }
        }
        float m = sink;
#pragma unroll
        for (int kt = 0; kt < 9; ++kt)
#pragma unroll
            for (int jj = 0; jj < 4; ++jj) {
                const int j = 16 * (mt0 + kt) + 4 * fq + jj;
                const bool ok = (j >= qi + 1) && (j <= qi + 128) && (qblk > 0 || j >= 128);
                const float sv = ok ? s[kt][jj] : -1e30f; s[kt][jj] = sv; m = fmaxf(m, sv);
            }
        m = fmaxf(m, __shfl_xor(m, 16)); m = fmaxf(m, __shfl_xor(m, 32));
        float l = 0.f;
#pragma unroll
        for (int kt = 0; kt < 9; ++kt)
#pragma unroll
            for (int jj = 0; jj < 4; ++jj) { const float p = __expf(s[kt][jj] - m); s[kt][jj] = p; l += p; }
        s[9] = (f32x4){0.f, 0.f, 0.f, 0.f};
        l += __shfl_xor(l, 16); l += __shfl_xor(l, 32);
        l += __expf(sink - m);
        f32x4 o[4];
#pragma unroll
        for (int dt = 0; dt < 4; ++dt) o[dt] = (f32x4){0.f, 0.f, 0.f, 0.f};
#pragma unroll
        for (int k5 = 0; k5 < 5; ++k5) {
            const bf16x8 pb = packB(s[2 * k5], s[2 * k5 + 1]);
#pragma unroll
            for (int dt = 0; dt < 4; ++dt)
                o[dt] = __builtin_amdgcn_mfma_f32_16x16x32_bf16(frag2((lcp)(L + AL_VT + (16 * dt + fr) * AVT_STRIDE + (16 * (mt0 + 2 * k5) + 4 * fq) * 2)), pb, o[dt], 0, 0, 0);
        }
        const float inv = 1.0f / l;
        bf16* op = OBp + row * 1024 + head * 64 + 4 * fq;
#pragma unroll
        for (int dt = 0; dt < 4; ++dt) { const f32x4 r = o[dt] * inv; *(GAS unsigned long long*)(op + 16 * dt) = (unsigned long long)cvtpk(r[0], r[1]) | ((unsigned long long)cvtpk(r[2], r[3]) << 32); }
    }
}
#ifndef MK_N_LAUNCHES
#define MK_N_LAUNCHES 1
#endif
constexpr int N_PHASES = 17;
constexpr int N_LAUNCHES = MK_N_LAUNCHES;

template <class Epi> __device__ __forceinline__ void run_gemm(Frame& F, const bf16* A, const bf16* Bt, int N, int K, const Epi& E) {
    pg8::Gemm g{A, Bt, MT, N, K}; pg8::StaticOrder S; S.init(MT, N, F.G, (int)blockIdx.x);
    pg8::gemm_phase<Epi, pg8::StaticOrder, true, true>(F.lds + RING_OFF, g, S, E);
}

__global__ void __launch_bounds__(NWAVES * 64, 2) yoco_fwd(Args args) {
    extern __shared__ __attribute__((aligned(16))) unsigned char lds[];
    Frame F;
    F.lds = (LAS unsigned char*)lds;
    F.MISC = (volatile LAS unsigned*)(F.lds + MISC_OFF);
    F.tid = threadIdx.x; F.lane = F.tid & 63; F.wave = __builtin_amdgcn_readfirstlane(F.tid >> 6);
    F.G = gridDim.x; { const int bx = blockIdx.x; F.vcu = (F.G % 8 == 0) ? (bx % 8) * (F.G / 8) + bx / 8 : bx; }
    F.ctl = (gu32*)(argp()->ws + WS_CTL);
    for (int u = F.tid; u < (LDS_BYTES - LDSCTL_OFF) / 4; u += NWAVES * 64) ((LAS unsigned*)(F.lds + LDSCTL_OFF))[u] = 0u;
    __syncthreads();
    XcdBarrier bar; bar.bar = (unsigned*)(F.ctl + CW_BAR); bar.x = 0; bar.st = nullptr;
    if (N_LAUNCHES == 1) bar = xcd_barrier_post((unsigned*)(F.ctl + CW_BAR) + argp()->li * XCD_BAR_WORDS, F.MISC + 8);
#define GRID_BAR() do { if (N_LAUNCHES == 1) xcd_barrier(bar); } while (0)
    const int lo = argp()->ph_lo, hi = argp()->ph_hi;
#ifndef PH_MASK
#define PH_MASK 0xffffffffu
#endif
#define IN(k) (((PH_MASK >> (k)) & 1) && lo <= (k) && (k) < hi)
#define REFRESH() do { int t_ = threadIdx.x; asm volatile("" : "+v"(t_)); F.tid = t_; F.lane = t_ & 63; } while (0)
#define SEAM(k) do { if (IN(k) && IN((k) + 1)) GRID_BAR(); } while (0)
#define XB ((bf16*)(argp()->ws + WS_XB))
#define HA ((bf16*)(argp()->ws + WS_HA))
#define HB ((bf16*)(argp()->ws + WS_HB))
#define OG ((bf16*)(argp()->ws + WS_OG))
#define PP ((bf16*)(argp()->ws + WS_PP))
#define ACT ((bf16*)(argp()->ws + WS_ACT))
#define KVb ((bf16*)(argp()->ws + WS_KV))
#define Qb ((bf16*)(argp()->ws + WS_Q))
#define OB ((bf16*)(argp()->ws + WS_OB))
#define PEB ((bf16*)(argp()->ws + WS_PEB))
#define SSQX ((float*)(argp()->ws + WS_SSQX))
#define SSQA ((float*)(argp()->ws + WS_SSQA))
#define SSQB ((float*)(argp()->ws + WS_SSQB))

    if (IN(0)) { REFRESH(); p0_prologue(F, argp()); } SEAM(0);
    if (IN(1)) { REFRESH(); pg8::EpiQKV E{(bf16*)(argp()->ws + WS_QKV), (bf16*)(argp()->ws + WS_Z), (float*)(argp()->ws + WS_AB), SSQX, argp()->out + O_SCP, argp()->out + O_SCS, (bf16*)(argp()->ws + WS_HALO)};
                 run_gemm(F, XB, (const bf16*)(argp()->ws + WS_WIN), NIN, 1024, E); } SEAM(1);
#ifndef CHUNKED
#define CHUNKED 1
#endif
    if (IN(2)) { REFRESH(); if (CHUNKED) for (int pair = blockIdx.x; pair < 2048; pair += F.G) dprep_pair(F, argp(), pair); } SEAM(2);
    if (IN(3)) { REFRESH(); for (int item = blockIdx.x; item < 128 + 1024; item += F.G) { if (CHUNKED && item < 128) dscan_item(F, argp(), item); else delta_seq_item(F, argp(), item); } } SEAM(3);
    if (IN(4)) { REFRESH(); pg8::EpiRes<true> E{argp()->in[0], argp()->in[1], nullptr, HA, SSQA}; run_gemm(F, OG, (const bf16*)(argp()->ws + WS_WOUT), 1024, 1024, E); } SEAM(4);
    if (IN(5)) { REFRESH(); pg8::EpiGU E{ACT, SSQA}; run_gemm(F, HA, (const bf16*)(argp()->ws + WS_WGU0), 5632, 1024, E); } SEAM(5);
    if (IN(6)) { REFRESH(); pg8::EpiRes<false> E{nullptr, nullptr, HA, HB, SSQB}; run_gemm(F, ACT, (const bf16*)(argp()->ws + WS_WDN0), 1024, FFH, E); } SEAM(6);
    if (IN(7)) { REFRESH(); pg8::EpiPP E{PP}; run_gemm(F, PEB, (const bf16*)(argp()->ws + WS_WPJ0), 1024, 256, E); } SEAM(7);
    if (IN(8)) { REFRESH(); pg8::EpiGate<false> E{SSQB, PP, HB, HA, SSQA, nullptr}; run_gemm(F, HB, (const bf16*)(argp()->ws + WS_WGT0), 1024, 1024, E); } SEAM(8);
    if (IN(9)) { REFRESH(); pg8::EpiKVQ E{KVb, Qb, SSQA, argp()->out + O_KWP, argp()->out + O_VWP, argp()->out + O_KWS, argp()->out + O_VWS};
                 run_gemm(F, HA, (const bf16*)(argp()->ws + WS_WKVQ), 1536, 1024, E); } SEAM(9);
    if (IN(10)) { REFRESH(); for (int item = blockIdx.x; item < 1024 + 512; item += F.G) { if (item < 1024) attn_prompt_mfma(F, argp(), item); else attn_sample_item(F, argp(), item - 1024); } } SEAM(10);
    if (IN(11)) { REFRESH(); pg8::EpiRes<false> E{nullptr, nullptr, HA, HB, SSQB}; run_gemm(F, OB, (const bf16*)(argp()->ws + WS_WO), 1024, 1024, E); } SEAM(11);
    if (IN(12)) { REFRESH(); pg8::EpiGU E{ACT, SSQB}; run_gemm(F, HB, (const bf16*)(argp()->ws + WS_WGU1), 5632, 1024, E); } SEAM(12);
    if (IN(13)) { REFRESH(); pg8::EpiRes<false> E{nullptr, nullptr, HB, HA, SSQA}; run_gemm(F, ACT, (const bf16*)(argp()->ws + WS_WDN1), 1024, FFH, E); } SEAM(13);
    if (IN(14)) { REFRESH(); pg8::EpiPP E{PP}; run_gemm(F, PEB + (size_t)MT * 256, (const bf16*)(argp()->ws + WS_WPJ1), 1024, 256, E); } SEAM(14);
    if (IN(15)) { REFRESH(); pg8::EpiGate<true> E{SSQA, PP, HA, nullptr, nullptr, argp()->out + O_Y}; run_gemm(F, HA, (const bf16*)(argp()->ws + WS_WGT1), 1024, 1024, E); } SEAM(15);
    if (IN(16)) { REFRESH(); final_norm(F, argp()); }
#undef IN
#undef SEAM
}

extern "C" void kernel_launch(void* const* d_in, const int* in_sizes, int n_in, void* d_out, int out_size, void* d_ws, size_t ws_size, hipStream_t stream) {
    static int grid = 0;
    if (grid == 0) {
        if (n_in != 28 || out_size != (int)O_END || ws_size < WS_END) { fprintf(stderr, "kernel_launch: unexpected shapes: n_in %d out %d ws %zu (need %zu)\n", n_in, out_size, ws_size, (size_t)WS_END); grid = -1; return; }
        int dev = 0, cus = 0;
        if (hipGetDevice(&dev) != hipSuccess || hipDeviceGetAttribute(&cus, hipDeviceAttributeMultiprocessorCount, dev) != hipSuccess) { grid = -1; return; }
        if (hipFuncSetAttribute((const void*)yoco_fwd, hipFuncAttributeMaxDynamicSharedMemorySize, LDS_BYTES) != hipSuccess) { fprintf(stderr, "kernel_launch: hipFuncSetAttribute failed\n"); grid = -1; return; }
        (void)hipGetLastError();
        grid = cus;
    }
    if (grid < 0) return;
    (void)hipMemsetAsync((char*)d_ws + WS_CTL, 0, CTL_ZERO_BYTES, stream);
    Args a{};
    for (int i = 0; i < 28; ++i) a.in[i] = (const float*)d_in[i];
    a.out = (float*)d_out; a.ws = (unsigned char*)d_ws;
#ifdef PROBE_PHASE
    if (N_LAUNCHES == 1) { const int cuts[4] = {0, PROBE_PHASE + 1, PROBE_PHASE, N_PHASES};
        a.ph_lo = 0; a.ph_hi = PROBE_PHASE + 1; a.li = 0; hipLaunchKernelGGL(yoco_fwd, dim3(grid), dim3(NWAVES * 64), LDS_BYTES, stream, a);
        a.ph_lo = PROBE_PHASE; a.ph_hi = PROBE_PHASE + 1; a.li = 1; hipLaunchKernelGGL(yoco_fwd, dim3(grid), dim3(NWAVES * 64), LDS_BYTES, stream, a);
        a.ph_lo = PROBE_PHASE + 1; a.ph_hi = N_PHASES; a.li = 2; hipLaunchKernelGGL(yoco_fwd, dim3(grid), dim3(NWAVES * 64), LDS_BYTES, stream, a); (void)cuts; }
#else
    if (N_LAUNCHES == 1) { a.ph_lo = 0; a.ph_hi = N_PHASES; a.li = 0; hipLaunchKernelGGL(yoco_fwd, dim3(grid), dim3(NWAVES * 64), LDS_BYTES, stream, a); }
#endif
    else for (int p = 0; p < N_PHASES; ++p) { a.ph_lo = p; a.ph_hi = p + 1; hipLaunchKernelGGL(yoco_fwd, dim3(grid), dim3(NWAVES * 64), LDS_BYTES, stream, a); }
}
```

```cpp
#include <hip/hip_runtime.h>
#include <cstdio>
#include <cstdint>
namespace pg8 {
#define PG8_LAS __attribute__((address_space(3)))
typedef unsigned short bf16_t;
typedef short bf16x8 __attribute__((ext_vector_type(8)));
typedef float f32x4 __attribute__((ext_vector_type(4)));
typedef unsigned u32x4 __attribute__((ext_vector_type(4)));
constexpr int BM = 256, BK = 64, HALF = 128, HTB = HALF * BK * 2  , STAGE_BYTES = 8 * HTB, NXCD = 8, WGM = 8;

__host__ __device__ __forceinline__ int lds_byte(int r, int c) { const int st = (r >> 4) * 2 + (c >> 5), rr = r & 15, cc = c & 31, ob = rr * 64 + cc * 2; return st * 1024 + (ob ^ (((ob >> 9) & 1) << 5)); }
__host__ __device__ __forceinline__ void stage_rc(int b, int& R, int& C) { const int st = b / 1024, sb = b % 1024, swz = sb ^ (((sb >> 9) & 1) << 5); R = (st >> 1) * 16 + swz / 64; C = (st & 1) * 32 + (swz % 64) / 2; }
__host__ __device__ __forceinline__ int perm32(int rho) { const int n = rho >> 4, i = rho & 15; return 8 * (i >> 2) + 4 * n + (i & 3); }

struct Unit { int pm, pn; };
struct Gemm { const bf16_t* A; const bf16_t* Bt; int M, N, K; };

struct StaticOrder {
    int nM, nN, nwg, G, c;
    __host__ __device__ void init(int M, int N, int G_, int c_) { nM = M / BM; nN = N / BM; nwg = nM * nN; G = G_; c = c_; }
    __host__ __device__ bool next(int i, Unit& u) const {
        const long L = (long)i * G + c; if (L >= nwg) return false;
        int wgid = (int)L; { const int q = nwg / NXCD, r = nwg % NXCD, xcd = wgid % NXCD, off = wgid / NXCD; wgid = (xcd < r ? xcd * (q + 1) : r * (q + 1) + (xcd - r) * q) + off; }
        const int nig = WGM * nN, gid = wgid / nig, fm = gid * WGM, gsz = (nM - fm) < WGM ? (nM - fm) : WGM;
        u.pm = fm + ((wgid % nig) % gsz); u.pn = (wgid % nig) / gsz; return true;
    }
    __device__ __forceinline__ void a_ready(const Unit&) const {}
    __device__ __forceinline__ void done(const Unit&) const {}
};

__device__ __forceinline__ unsigned cvt_pk_bf16(float lo, float hi) { unsigned r; asm volatile("v_cvt_pk_bf16_f32 %0, %1, %2" : "=v"(r) : "v"(lo), "v"(hi)); return r; }
__device__ __forceinline__ f32x4 bf_lo2(unsigned a, unsigned b) { return (f32x4){__uint_as_float(a << 16), __uint_as_float(a & 0xffff0000u), __uint_as_float(b << 16), __uint_as_float(b & 0xffff0000u)}; }
__device__ __forceinline__ u32x4 pack8(const f32x4 v0, const f32x4 v1) { u32x4 w; w.x = cvt_pk_bf16(v0[0], v0[1]); w.y = cvt_pk_bf16(v0[2], v0[3]); w.z = cvt_pk_bf16(v1[0], v1[1]); w.w = cvt_pk_bf16(v1[2], v1[3]); return w; }
__device__ __forceinline__ float dot4(const f32x4 a) { return (a[0] * a[0] + a[1] * a[1]) + (a[2] * a[2] + a[3] * a[3]); }
__device__ __forceinline__ float row_rstd(const float* ssq, int r, int fq) {
    const f32x4 p = *(const f32x4*)(ssq + (size_t)r * 16 + 4 * fq);
    float s = (p[0] + p[1]) + (p[2] + p[3]);
    s += __shfl_xor(s, 16); s += __shfl_xor(s, 32);
    return rsqrtf(s * (1.0f / 1024.0f) + 1e-6f);
}
__device__ __forceinline__ f32x4 rstd_load(const float* ssq, int r, int fq) { return *(const f32x4*)(ssq + (size_t)r * 16 + 4 * fq); }
__device__ __forceinline__ float rstd_finish(const f32x4 p) {
    float s = (p[0] + p[1]) + (p[2] + p[3]);
    s += __shfl_xor(s, 16); s += __shfl_xor(s, 32);
    return rsqrtf(s * (1.0f / 1024.0f) + 1e-6f);
}
__device__ __forceinline__ float row_rstd8(const float* ssq, int r, int sub) {
    const float2 p = *(const float2*)(ssq + (size_t)r * 16 + 2 * sub);
    float s = p.x + p.y;
    s += __shfl_xor(s, 1); s += __shfl_xor(s, 2); s += __shfl_xor(s, 4);
    return rsqrtf(s * (1.0f / 1024.0f) + 1e-6f);
}
__device__ __forceinline__ float sum8(float q) { q += __shfl_xor(q, 1); q += __shfl_xor(q, 2); q += __shfl_xor(q, 4); return q; }
__device__ __forceinline__ float sigmoidf_(float x) { return __builtin_amdgcn_rcpf(1.0f + __expf(-x)); }

constexpr int MP_ROWS = 32768;

struct EpiQKV {
    static constexpr bool PERM = true, AFTER_DRAIN = false;
    bf16_t* QKV; bf16_t* Z; float* AB; const float* ssq; float* sc_p; float* sc_s; bf16_t* halo;
    __device__ __forceinline__ void operator()(const f32x4 (&acc)[2][2][4][2], const Unit& u, int wr, int wc, int fr, int fq) const {
        const int row0 = u.pm * BM + wr * 64 + fr, colt = u.pn * BM + wc * 32 + 8 * fq;
#pragma unroll
        for (int ai = 0; ai < 2; ++ai) {
            f32x4 pr[4];
#pragma unroll
            for (int m = 0; m < 4; ++m) pr[m] = rstd_load(ssq, row0 + ai * HALF + m * 16, fq);
#pragma unroll
            for (int m = 0; m < 4; ++m) {
                const int r = row0 + ai * HALF + m * 16; const float rs = rstd_finish(pr[m]);
#pragma unroll
                for (int bj = 0; bj < 2; ++bj) {
                    const int col = colt + bj * HALF; const f32x4 v0 = acc[ai][bj][m][0] * rs, v1 = acc[ai][bj][m][1] * rs;
                    if (u.pn < 12) {
                        const u32x4 pk = pack8(v0, v1);
                        *(u32x4*)(QKV + (size_t)r * 3072 + col) = pk;
                        if (r < MP_ROWS && (r & 63) >= 61) *(u32x4*)(halo + ((size_t)(r >> 6) * 3 + ((r & 63) - 61)) * 3072 + col) = pk;
                        if (r < MP_ROWS) { const int s = r & 2047; if (s >= 2045) { float* o = sc_p + ((size_t)((r >> 11) * 3 + (s - 2045))) * 3072 + col; *(f32x4*)o = v0; *(f32x4*)(o + 4) = v1; } }
                        else { const int rr = r - MP_ROWS, t = rr & 7; if (t >= 5) { float* o = sc_s + ((size_t)((rr >> 3) * 3 + (t - 5))) * 3072 + col; *(f32x4*)o = v0; *(f32x4*)(o + 4) = v1; } }
                    } else if (u.pn < 16) {
                        *(u32x4*)(Z + (size_t)r * 1024 + (col - 3072)) = pack8(v0, v1);
                    } else {
                        const int c = col - 4096; if (c < 16) { float* o = AB + (size_t)r * 16 + c; *(f32x4*)o = v0; *(f32x4*)(o + 4) = v1; }
                    }
                }
            }
        }
    }
};
template <bool BASEF32> struct EpiRes {
    static constexpr bool PERM = true, AFTER_DRAIN = false;
    const float* xp; const float* xs; const bf16_t* hb; bf16_t* out; float* ssq_out;
    __device__ __forceinline__ void operator()(const f32x4 (&acc)[2][2][4][2], const Unit& u, int wr, int wc, int fr, int fq) const {
        const int row0 = u.pm * BM + wr * 64 + fr, colt = u.pn * BM + wc * 32 + 8 * fq;
#pragma unroll
        for (int ai = 0; ai < 2; ++ai) {
            u32x4 bw[4][2];
            if (!BASEF32) {
#pragma unroll
                for (int m = 0; m < 4; ++m)
#pragma unroll
                    for (int bj = 0; bj < 2; ++bj) bw[m][bj] = *(const u32x4*)(hb + (size_t)(row0 + ai * HALF + m * 16) * 1024 + colt + bj * HALF);
            }
#pragma unroll
            for (int m = 0; m < 4; ++m) {
                const int r = row0 + ai * HALF + m * 16; float q = 0.f;
#pragma unroll
                for (int bj = 0; bj < 2; ++bj) {
                    const int col = colt + bj * HALF; f32x4 b0, b1;
                    if (BASEF32) { const float* p = (r < MP_ROWS ? xp + (size_t)r * 1024 : xs + (size_t)(r - MP_ROWS) * 1024) + col; b0 = *(const f32x4*)p; b1 = *(const f32x4*)(p + 4); }
                    else { const u32x4 w = bw[m][bj]; b0 = bf_lo2(w.x, w.y); b1 = bf_lo2(w.z, w.w); }
                    const f32x4 v0 = acc[ai][bj][m][0] + b0, v1 = acc[ai][bj][m][1] + b1;
                    q += dot4(v0) + dot4(v1);
                    *(u32x4*)(out + (size_t)r * 1024 + col) = pack8(v0, v1);
                }
                q += __shfl_xor(q, 16); q += __shfl_xor(q, 32);
                if (fq == 0) ssq_out[(size_t)r * 16 + u.pn * 4 + wc] = q;
            }
        }
    }
    __device__ __forceinline__ void small(int r, int col, f32x4 v0, f32x4 v1, int slot, int sub) const {
        f32x4 b0, b1;
        if (BASEF32) { const float* p = xs + (size_t)(r - MP_ROWS) * 1024 + col; b0 = *(const f32x4*)p; b1 = *(const f32x4*)(p + 4); }
        else { const u32x4 w = *(const u32x4*)(hb + (size_t)r * 1024 + col); b0 = bf_lo2(w.x, w.y); b1 = bf_lo2(w.z, w.w); }
        v0 += b0; v1 += b1;
        const float q = sum8(dot4(v0) + dot4(v1));
        *(u32x4*)(out + (size_t)r * 1024 + col) = pack8(v0, v1);
        if (sub == 0) ssq_out[(size_t)r * 16 + slot] = q;
    }
};
struct EpiGU {
    static constexpr bool PERM = true, AFTER_DRAIN = false;
    bf16_t* act; const float* ssq;
    __device__ __forceinline__ void operator()(const f32x4 (&acc)[2][2][4][2], const Unit& u, int wr, int wc, int fr, int fq) const {
        const int row0 = u.pm * BM + wr * 64 + fr, col = u.pn * HALF + wc * 32 + 8 * fq;
#pragma unroll
        for (int ai = 0; ai < 2; ++ai) {
            f32x4 pr[4];
#pragma unroll
            for (int m = 0; m < 4; ++m) pr[m] = rstd_load(ssq, row0 + ai * HALF + m * 16, fq);
#pragma unroll
            for (int m = 0; m < 4; ++m) {
                const int r = row0 + ai * HALF + m * 16; const float rs = rstd_finish(pr[m]);
                f32x4 o[2];
#pragma unroll
                for (int n = 0; n < 2; ++n) {
                    const f32x4 g = acc[ai][0][m][n] * rs, up = acc[ai][1][m][n] * rs;
#pragma unroll
                    for (int j = 0; j < 4; ++j) o[n][j] = g[j] * sigmoidf_(g[j]) * up[j];
                }
                *(u32x4*)(act + (size_t)r * 2816 + col) = pack8(o[0], o[1]);
            }
        }
    }
};
struct EpiPP {
    static constexpr bool PERM = true, AFTER_DRAIN = false;
    bf16_t* out;
    __device__ __forceinline__ void operator()(const f32x4 (&acc)[2][2][4][2], const Unit& u, int wr, int wc, int fr, int fq) const {
        const int row0 = u.pm * BM + wr * 64 + fr, colt = u.pn * BM + wc * 32 + 8 * fq;
#pragma unroll
        for (int ai = 0; ai < 2; ++ai)
#pragma unroll
            for (int m = 0; m < 4; ++m) {
                const int r = row0 + ai * HALF + m * 16;
#pragma unroll
                for (int bj = 0; bj < 2; ++bj) *(u32x4*)(out + (size_t)r * 1024 + colt + bj * HALF) = pack8(acc[ai][bj][m][0], acc[ai][bj][m][1]);
            }
    }
    __device__ __forceinline__ void small(int r, int col, f32x4 v0, f32x4 v1, int slot, int sub) const { *(u32x4*)(out + (size_t)r * 1024 + col) = pack8(v0, v1); }
};
template <bool FINAL> struct EpiGate {
    static constexpr bool PERM = true, AFTER_DRAIN = false;
    const float* ssq_in; const bf16_t* pp; const bf16_t* hb; bf16_t* out; float* ssq_out; float* y;
    __device__ __forceinline__ void operator()(const f32x4 (&acc)[2][2][4][2], const Unit& u, int wr, int wc, int fr, int fq) const {
        const int row0 = u.pm * BM + wr * 64 + fr, colt = u.pn * BM + wc * 32 + 8 * fq;
#pragma unroll
        for (int ai = 0; ai < 2; ++ai) {
            f32x4 pr[4];
#pragma unroll
            for (int m = 0; m < 4; ++m) pr[m] = rstd_load(ssq_in, row0 + ai * HALF + m * 16, fq);
#pragma unroll
            for (int m2 = 0; m2 < 4; m2 += 2) {
            u32x4 pw_[2][2], hw_[2][2];
#pragma unroll
            for (int m = 0; m < 2; ++m)
#pragma unroll
                for (int bj = 0; bj < 2; ++bj) { const size_t o_ = (size_t)(row0 + ai * HALF + (m2 + m) * 16) * 1024 + colt + bj * HALF; pw_[m][bj] = *(const u32x4*)(pp + o_); hw_[m][bj] = *(const u32x4*)(hb + o_); }
#pragma unroll
            for (int mm = 0; mm < 2; ++mm) {
                const int m = m2 + mm;
                const int r = row0 + ai * HALF + m * 16; const float rs = rstd_finish(pr[m]); float q = 0.f;
#pragma unroll
                for (int bj = 0; bj < 2; ++bj) {
                    const int col = colt + bj * HALF;
                    const u32x4 wp = pw_[mm][bj], wh = hw_[mm][bj];
                    const f32x4 p0 = bf_lo2(wp.x, wp.y), p1 = bf_lo2(wp.z, wp.w), h0 = bf_lo2(wh.x, wh.y), h1 = bf_lo2(wh.z, wh.w);
                    f32x4 v0, v1;
#pragma unroll
                    for (int j = 0; j < 4; ++j) { v0[j] = h0[j] + p0[j] * sigmoidf_(acc[ai][bj][m][0][j] * rs); v1[j] = h1[j] + p1[j] * sigmoidf_(acc[ai][bj][m][1][j] * rs); }
                    if (FINAL) { float* o = y + (size_t)r * 1024 + col; *(f32x4*)o = v0; *(f32x4*)(o + 4) = v1; }
                    else { q += dot4(v0) + dot4(v1); *(u32x4*)(out + (size_t)r * 1024 + col) = pack8(v0, v1); }
                }
                if (!FINAL) { q += __shfl_xor(q, 16); q += __shfl_xor(q, 32); if (fq == 0) ssq_out[(size_t)r * 16 + u.pn * 4 + wc] = q; }
            }
            }
        }
    }
    __device__ __forceinline__ void small(int r, int col, f32x4 a0, f32x4 a1, int slot, int sub) const {
        const float rs = row_rstd8(ssq_in, r, sub);
        const u32x4 wp = *(const u32x4*)(pp + (size_t)r * 1024 + col), wh = *(const u32x4*)(hb + (size_t)r * 1024 + col);
        const f32x4 p0 = bf_lo2(wp.x, wp.y), p1 = bf_lo2(wp.z, wp.w), h0 = bf_lo2(wh.x, wh.y), h1 = bf_lo2(wh.z, wh.w);
        f32x4 v0, v1;
#pragma unroll
        for (int j = 0; j < 4; ++j) { v0[j] = h0[j] + p0[j] * sigmoidf_(a0[j] * rs); v1[j] = h1[j] + p1[j] * sigmoidf_(a1[j] * rs); }
        if (FINAL) { float* o = y + (size_t)r * 1024 + col; *(f32x4*)o = v0; *(f32x4*)(o + 4) = v1; }
        else { const float q = sum8(dot4(v0) + dot4(v1)); *(u32x4*)(out + (size_t)r * 1024 + col) = pack8(v0, v1); if (sub == 0) ssq_out[(size_t)r * 16 + slot] = q; }
    }
};
struct EpiKVQ {
    static constexpr bool PERM = true, AFTER_DRAIN = false;
    bf16_t* KV; bf16_t* Q; const float* ssq; float* kw_p; float* vw_p; float* kw_s; float* vw_s;
    __device__ __forceinline__ void operator()(const f32x4 (&acc)[2][2][4][2], const Unit& u, int wr, int wc, int fr, int fq) const {
        const int row0 = u.pm * BM + wr * 64 + fr, colt = u.pn * BM + wc * 32 + 8 * fq;
        const bool iskv = u.pn < 2;
        float* const cp = (u.pn == 0) ? kw_p : vw_p; float* const cs = (u.pn == 0) ? kw_s : vw_s;
        const int ccol = wc * 32 + 8 * fq;
#pragma unroll
        for (int ai = 0; ai < 2; ++ai) {
            f32x4 pr[4];
#pragma unroll
            for (int m = 0; m < 4; ++m) pr[m] = rstd_load(ssq, row0 + ai * HALF + m * 16, fq);
#pragma unroll
            for (int m = 0; m < 4; ++m) {
                const int r = row0 + ai * HALF + m * 16; const float rs = rstd_finish(pr[m]);
                if (iskv) {
                    long crow = -1;
                    if (r < MP_ROWS) { const int s = r & 2047; if (s >= 1920) crow = (long)(r >> 11) * 128 + (s - 1920); }
                    else { const int rr = r - MP_ROWS; crow = (long)(rr >> 3) * 128 + 120 + (rr & 7); }
                    float* const cbase = (r < MP_ROWS) ? cp : cs;
#pragma unroll
                    for (int bj = 0; bj < 2; ++bj) {
                        const f32x4 v0 = acc[ai][bj][m][0] * rs, v1 = acc[ai][bj][m][1] * rs;
                        *(u32x4*)(KV + (size_t)r * 512 + colt + bj * HALF) = pack8(v0, v1);
                        if (crow >= 0) { float* o = cbase + (size_t)crow * 256 + ccol + bj * HALF; *(f32x4*)o = v0; *(f32x4*)(o + 4) = v1; }
                    }
                } else {
                    const float sc = rs * 0.125f;
#pragma unroll
                    for (int bj = 0; bj < 2; ++bj)
                        *(u32x4*)(Q + (size_t)r * 1024 + (colt - 512) + bj * HALF) = pack8(acc[ai][bj][m][0] * sc, acc[ai][bj][m][1] * sc);
                }
            }
        }
    }
    __device__ __forceinline__ void small(int r, int col, f32x4 a0, f32x4 a1, int slot, int sub) const {
        const float rs = row_rstd8(ssq, r, sub);
        if (col < 512) {
            const f32x4 v0 = a0 * rs, v1 = a1 * rs;
            *(u32x4*)(KV + (size_t)r * 512 + col) = pack8(v0, v1);
            const int rr = r - MP_ROWS; float* o = (col < 256 ? kw_s : vw_s) + ((size_t)(rr >> 3) * 128 + 120 + (rr & 7)) * 256 + (col & 255);
            *(f32x4*)o = v0; *(f32x4*)(o + 4) = v1;
        } else {
            const float sc = rs * 0.125f;
            *(u32x4*)(Q + (size_t)r * 1024 + (col - 512)) = pack8(a0 * sc, a1 * sc);
        }
    }
};

template <class Epi, class Sched, bool ALIGN_EPI = false, bool SP2 = false>
__device__ __forceinline__ void gemm_phase(PG8_LAS unsigned char* lds, const Gemm g, const Sched& S, const Epi& E) {
    int tid_ = threadIdx.x; asm volatile("" : "+v"(tid_));
    const int tid = tid_, wid = __builtin_amdgcn_readfirstlane(tid >> 6), lane = tid & 63, wr = wid >> 2, wc = wid & 3, fr = lane & 15, fq = lane >> 4;
    const int K = g.K, nt = K / BK;
    unsigned voffA[2], voffB[2];
#pragma unroll
    for (int i = 0; i < 2; ++i) { int R, C; stage_rc(tid * 16 + i * 8192, R, C); const int Rb = Epi::PERM ? ((R & ~31) + perm32(R & 31)) : R;
        voffA[i] = (unsigned)(R * K + C) * 2u; voffB[i] = (unsigned)(Rb * K + C) * 2u; }
    const size_t kstep = (size_t)(BK * 2);
    const size_t hstep = (size_t)HALF * K * 2;
    const size_t tstep = 2 * hstep;
    const unsigned ldsw = (unsigned)wid * 1024u;
    const int aoff = lds_byte(wr * 64 + fr, fq * 8), boff = lds_byte(wc * 32 + fr, fq * 8);
#define PG8_SA(b, h) (((b) * 2 + (h)) * HTB)
#define PG8_SB(b, h) ((4 + (b) * 2 + (h)) * HTB)
#define PG8_STAGE(bufoff, gbase, voff) do { _Pragma("unroll") for (int _i = 0; _i < 2; ++_i) \
        __builtin_amdgcn_global_load_lds((const unsigned*)((const char*)(gbase) + (voff)[_i]), (PG8_LAS unsigned*)(lds + (bufoff) + ldsw + _i * 8192), 16, 0, 0); } while (0)
#define PG8_LDA(dst, b, h) do { _Pragma("unroll") for (int m = 0; m < 4; ++m) _Pragma("unroll") for (int k = 0; k < 2; ++k) dst[m][k] = *(const PG8_LAS bf16x8*)(lds + PG8_SA(b, h) + aoff + m * 2048 + k * 1024); } while (0)
#define PG8_LDB(dst, b, h) do { _Pragma("unroll") for (int n = 0; n < 2; ++n) _Pragma("unroll") for (int k = 0; k < 2; ++k) dst[n][k] = *(const PG8_LAS bf16x8*)(lds + PG8_SB(b, h) + boff + n * 2048 + k * 1024); } while (0)
#define PG8_MMA(ai, bj, At, Bt) do { __builtin_amdgcn_s_setprio(1); _Pragma("unroll") for (int m = 0; m < 4; ++m) _Pragma("unroll") for (int n = 0; n < 2; ++n) _Pragma("unroll") for (int k = 0; k < 2; ++k) \
        acc[ai][bj][m][n] = __builtin_amdgcn_mfma_f32_16x16x32_bf16(Bt[n][k], At[m][k], acc[ai][bj][m][n], 0, 0, 0); __builtin_amdgcn_s_setprio(0); } while (0)
#define PG8_WAIT_V(n) asm volatile("s_waitcnt vmcnt(" #n ")" ::: "memory")
#define PG8_WAIT_L(n) asm volatile("s_waitcnt lgkmcnt(" #n ")" ::: "memory")
#define PG8_BAR __builtin_amdgcn_s_barrier()
#define PG8_SCHED __builtin_amdgcn_sched_barrier(0)
    Unit cur, nxt; int ui = 0;
    if (!S.next(0, cur)) return;
    f32x4 acc[2][2][4][2];
#pragma unroll
    for (int a = 0; a < 2; ++a)
#pragma unroll
        for (int b = 0; b < 2; ++b)
#pragma unroll
            for (int m = 0; m < 4; ++m)
#pragma unroll
                for (int n = 0; n < 2; ++n) acc[a][b][m][n] = (f32x4){0.f, 0.f, 0.f, 0.f};
    bf16x8 At[4][2], B0[2][2], B1[2][2];
    const char* cA = (const char*)g.A + (size_t)cur.pm * tstep; const char* cB = (const char*)g.Bt + (size_t)cur.pn * tstep;
    S.a_ready(cur);
    if constexpr (SP2) {
        PG8_STAGE(PG8_SB(0, 0), cB, voffB); PG8_STAGE(PG8_SB(0, 1), cB + hstep, voffB); PG8_STAGE(PG8_SA(0, 0), cA, voffA); PG8_STAGE(PG8_SA(0, 1), cA + hstep, voffA);
        if (wr == 1) PG8_BAR;
        PG8_WAIT_V(2); PG8_BAR;
        PG8_STAGE(PG8_SB(1, 0), cB + kstep, voffB); PG8_STAGE(PG8_SA(1, 0), cA + kstep, voffA); PG8_STAGE(PG8_SB(1, 1), cB + hstep + kstep, voffB);
        PG8_WAIT_V(6); PG8_BAR;
    } else {
        PG8_STAGE(PG8_SB(0, 0), cB, voffB); PG8_STAGE(PG8_SA(0, 0), cA, voffA); PG8_STAGE(PG8_SB(0, 1), cB + hstep, voffB); PG8_STAGE(PG8_SA(0, 1), cA + hstep, voffA);
        if (wr == 1) PG8_BAR;
        PG8_WAIT_V(4); PG8_BAR;
        PG8_STAGE(PG8_SB(1, 0), cB + kstep, voffB); PG8_STAGE(PG8_SA(1, 0), cA + kstep, voffA); PG8_STAGE(PG8_SB(1, 1), cB + hstep + kstep, voffB);
        PG8_WAIT_V(6); PG8_BAR;
    }
    for (;;) {
        const bool has_next = S.next(ui + 1, nxt);
        const char* nA = has_next ? (const char*)g.A + (size_t)nxt.pm * tstep : cA; const char* nB = has_next ? (const char*)g.Bt + (size_t)nxt.pn * tstep : cB;
        for (int t = 0; t < nt; t += 2) {
            const bool last = (t == nt - 2);
            const char* a1 = cA + (size_t)(t + 1) * kstep;
            const char* a2 = last ? nA : cA + (size_t)(t + 2) * kstep; const char* b2 = last ? nB : cB + (size_t)(t + 2) * kstep;
            const char* a3 = a2 + kstep; const char* b3 = b2 + kstep;
            if (last && has_next) S.a_ready(nxt);
            if constexpr (SP2) {
            PG8_LDB(B0, 0, 0); PG8_LDB(B1, 0, 1); PG8_SCHED; PG8_LDA(At, 0, 0); PG8_STAGE(PG8_SA(1, 1), a1 + hstep, voffA);
            PG8_WAIT_V(8); PG8_WAIT_L(0); PG8_BAR; PG8_MMA(0, 0, At, B0); PG8_MMA(0, 1, At, B1); PG8_BAR; PG8_SCHED;
            PG8_LDA(At, 0, 1); PG8_STAGE(PG8_SB(0, 0), b2, voffB); PG8_STAGE(PG8_SB(0, 1), b2 + hstep, voffB); PG8_STAGE(PG8_SA(0, 0), a2, voffA);
            PG8_WAIT_V(8); PG8_WAIT_L(0); PG8_BAR; PG8_MMA(1, 0, At, B0); PG8_MMA(1, 1, At, B1); PG8_BAR; PG8_SCHED;
            PG8_LDB(B0, 1, 0); PG8_LDB(B1, 1, 1); PG8_SCHED; PG8_LDA(At, 1, 0); PG8_STAGE(PG8_SA(0, 1), a2 + hstep, voffA);
            PG8_WAIT_V(8); PG8_WAIT_L(0); PG8_BAR; PG8_MMA(0, 0, At, B0); PG8_MMA(0, 1, At, B1); PG8_BAR; PG8_SCHED;
            PG8_LDA(At, 1, 1); PG8_STAGE(PG8_SB(1, 0), b3, voffB); PG8_STAGE(PG8_SB(1, 1), b3 + hstep, voffB); PG8_STAGE(PG8_SA(1, 0), a3, voffA);
            PG8_WAIT_V(8); PG8_WAIT_L(0); PG8_BAR; PG8_MMA(1, 0, At, B0); PG8_MMA(1, 1, At, B1); PG8_BAR; PG8_SCHED;
            } else {
            PG8_LDB(B0, 0, 0); PG8_SCHED; PG8_LDA(At, 0, 0); PG8_STAGE(PG8_SA(1, 1), a1 + hstep, voffA);
            PG8_WAIT_L(8); PG8_BAR; PG8_WAIT_L(0); PG8_MMA(0, 0, At, B0); PG8_BAR; PG8_SCHED;
            PG8_LDB(B1, 0, 1); PG8_STAGE(PG8_SB(0, 0), b2, voffB);
            PG8_BAR; PG8_WAIT_L(0); PG8_MMA(0, 1, At, B1); PG8_BAR;
            PG8_LDA(At, 0, 1); PG8_STAGE(PG8_SA(0, 0), a2, voffA);
            PG8_BAR; PG8_WAIT_L(0); PG8_MMA(1, 0, At, B0); PG8_BAR; PG8_SCHED;
            PG8_STAGE(PG8_SB(0, 1), b2 + hstep, voffB);
            PG8_WAIT_V(6); PG8_BAR; PG8_MMA(1, 1, At, B1); PG8_BAR;
            PG8_LDB(B0, 1, 0); PG8_SCHED; PG8_LDA(At, 1, 0); PG8_STAGE(PG8_SA(0, 1), a2 + hstep, voffA);
            PG8_WAIT_L(8); PG8_BAR; PG8_WAIT_L(0); PG8_MMA(0, 0, At, B0); PG8_BAR; PG8_SCHED;
            PG8_LDB(B1, 1, 1); PG8_STAGE(PG8_SB(1, 0), b3, voffB);
            PG8_BAR; PG8_WAIT_L(0); PG8_MMA(0, 1, At, B1); PG8_BAR;
            PG8_LDA(At, 1, 1); PG8_STAGE(PG8_SA(1, 0), a3, voffA);
            PG8_BAR; PG8_WAIT_L(0); PG8_MMA(1, 0, At, B0); PG8_BAR; PG8_SCHED;
            PG8_STAGE(PG8_SB(1, 1), b3 + hstep, voffB);
            PG8_WAIT_V(6); PG8_BAR; PG8_MMA(1, 1, At, B1); PG8_BAR;
            }
        }
        if constexpr (ALIGN_EPI) { if (wr == 0) PG8_BAR; }
        if constexpr (!Epi::AFTER_DRAIN) { E(acc, cur, wr, wc, fr, fq); S.done(cur); }
        if (!has_next) break;
#pragma unroll
        for (int a = 0; a < 2; ++a)
#pragma unroll
            for (int b = 0; b < 2; ++b)
#pragma unroll
                for (int m = 0; m < 4; ++m)
#pragma unroll
                    for (int n = 0; n < 2; ++n) acc[a][b][m][n] = (f32x4){0.f, 0.f, 0.f, 0.f};
        cur = nxt; cA = nA; cB = nB; ++ui;
        if constexpr (ALIGN_EPI) { if (wr == 1) PG8_BAR; }
    }
    PG8_WAIT_V(0);
    if constexpr (!ALIGN_EPI) { if (wr == 0) PG8_BAR; }
    PG8_BAR;
    if constexpr (Epi::AFTER_DRAIN) { E.fused(acc, cur, wr, wc, fr, fq, lds, wid, lane); S.done(cur); }
#undef PG8_SA
#undef PG8_SB
#undef PG8_STAGE
#undef PG8_LDA
#undef PG8_LDB
#undef PG8_MMA
#undef PG8_WAIT_V
#undef PG8_WAIT_L
#undef PG8_BAR
#undef PG8_SCHED
}
}
constexpr int NWAVES = 8;
constexpr int DM = 1024, MP = 32768, MS = 1024, MT = MP + MS;
constexpr int NIN = 4352;
constexpr int FFH = 2816;
constexpr size_t MiB = 1u << 20;
constexpr size_t WS_CTL = 0, CTL_ZERO_BYTES = 1 * MiB;
constexpr size_t WS_SSQX = 1 * MiB, WS_SSQA = 13 * MiB / 4, WS_SSQB = 11 * MiB / 2, WS_AB = 31 * MiB / 4;
constexpr size_t WS_WIN = 16 * MiB, WS_WOUT = 25 * MiB, WS_WGU0 = 27 * MiB, WS_WGU1 = 38 * MiB, WS_WDN0 = 49 * MiB, WS_WDN1 = 55 * MiB,
                 WS_WGT0 = 61 * MiB, WS_WGT1 = 63 * MiB, WS_WPJ0 = 65 * MiB, WS_WPJ1 = 66 * MiB, WS_WKVQ = 67 * MiB, WS_WO = 70 * MiB;
constexpr size_t WS_PEB = 72 * MiB, WS_XB = 436 * MiB, WS_QKV = 172 * MiB, WS_Z = 370 * MiB, WS_END = 511 * MiB;
constexpr size_t WS_UTB = 106 * MiB, WS_OG = WS_UTB;
constexpr size_t WS_QKM = 436 * MiB, WS_SCL = 10 * MiB, WS_HALO = 502 * MiB;
constexpr size_t WS_HA = 436 * MiB, WS_HB = WS_Z, WS_PP = 106 * MiB, WS_ACT = WS_QKV, WS_KV = 172 * MiB, WS_Q = 205 * MiB, WS_OB = 271 * MiB;
constexpr int CW_BAR = 4096;
constexpr size_t O_Y = 0, O_SDP = (size_t)MT * DM, O_SDS = O_SDP + 2097152, O_SCP = O_SDS + 16777216, O_SCS = O_SCP + 147456,
                 O_KWP = O_SCS + 1179648, O_KWS = O_KWP + 524288, O_VWP = O_KWS + 4194304, O_VWS = O_VWP + 524288, O_END = O_VWS + 4194304;
constexpr int RING_OFF = 0, RING_BYTES = 131072, LDS_BYTES = 163840, LDSCTL_OFF = LDS_BYTES - 1024, MISC_OFF = LDSCTL_OFF + 320;

#define GAS __attribute__((address_space(1)))
#define LAS __attribute__((address_space(3)))
typedef unsigned short bf16;
typedef unsigned v4u __attribute__((ext_vector_type(4)));
typedef float f32x4 __attribute__((ext_vector_type(4)));
typedef GAS unsigned gu32;
#define RLX_AGENT __ATOMIC_RELAXED, __HIP_MEMORY_SCOPE_AGENT
#define LDS_WAIT() asm volatile("s_waitcnt lgkmcnt(0)" ::: "memory")
#define VM_WAIT() asm volatile("s_waitcnt vmcnt(0)" ::: "memory")
__device__ __forceinline__ unsigned f2bf(float f) { unsigned u = __builtin_bit_cast(unsigned, f); return (u + 0x7fffu + ((u >> 16) & 1u)) >> 16; }
__device__ __forceinline__ unsigned pk2(float lo, float hi) { return f2bf(lo) | (f2bf(hi) << 16); }
__device__ __forceinline__ float bf2f(unsigned short b) { return __uint_as_float((unsigned)b << 16); }
using pg8::sigmoidf_;
__device__ __forceinline__ float dot4s(const f32x4 a) { return (a[0] * a[0] + a[1] * a[1]) + (a[2] * a[2] + a[3] * a[3]); }
__device__ __forceinline__ float wave_sum(float v) {
#pragma unroll
    for (int o = 1; o < 64; o <<= 1) v += __shfl_xor(v, o);
    return v;
}
#define XB_TMO      128
#define XB_XCNT(j)  (256  + 64 * (j))
#define XB_XSUB(j)  (1280 + 64 * (j))
#define XB_XGEN(j)  (2304 + 64 * (j))
#define XB_TOP      3328
#define XB_TOPGEN   3392
#define XCD_BAR_WORDS 3456
#define XB_SPIN_CAP (1u << 18)

__device__ __forceinline__ unsigned xb_ld(unsigned* p)              { return __hip_atomic_load(p, __ATOMIC_RELAXED, __HIP_MEMORY_SCOPE_AGENT); }
__device__ __forceinline__ unsigned xb_add(unsigned* p, unsigned v) { return __hip_atomic_fetch_add(p, v, __ATOMIC_RELAXED, __HIP_MEMORY_SCOPE_AGENT); }
__device__ __forceinline__ unsigned xb_xcc_id() { return (unsigned)__builtin_amdgcn_s_getreg((3 << 11) | 20) & 0xFu; }
#define XB_SPIN(cond, bar) do { unsigned _sp = 0; while (cond) { __builtin_amdgcn_s_sleep(1); \
    if ((++_sp & 255u) == 0u) { if (xb_ld(&(bar)[XB_TMO])) break; if (_sp > XB_SPIN_CAP) { atomicAdd(&(bar)[XB_TMO], 1u); break; } } } } while (0)

struct XcdBarrier {
    unsigned* bar; unsigned x;
    volatile LAS unsigned* st;
};

__device__ __forceinline__ XcdBarrier xcd_barrier_post(unsigned* bar, volatile LAS unsigned* st) {
    XcdBarrier b; b.bar = bar; b.x = xb_xcc_id(); b.st = st;
    if (threadIdx.x == 0) (void)xb_add(&bar[XB_XCNT(b.x)], 1u);
    return b;
}
__device__ __forceinline__ void xcd_barrier_complete(unsigned* bar, unsigned x, unsigned& nloc, unsigned& nx) {
    const unsigned G = gridDim.x * gridDim.y * gridDim.z;
    unsigned sum, cnt, mine, sp = 0u;
    for (;;) {
        sum = 0u; cnt = 0u; mine = 0u;
#pragma unroll
        for (unsigned j = 0; j < 16; ++j) { const unsigned c = xb_ld(&bar[XB_XCNT(j)]); sum += c; cnt += (c > 0u) ? 1u : 0u; mine = (j == x) ? c : mine; }
        if (sum == G) break;
        __builtin_amdgcn_s_sleep(1);
        if ((++sp & 255u) == 0u) { if (xb_ld(&bar[XB_TMO])) break; if (sp > XB_SPIN_CAP) { atomicAdd(&bar[XB_TMO], 1u); break; } }
    }
    nloc = mine > 0u ? mine : 1u; nx = cnt > 0u ? cnt : 1u;
}

__device__ __forceinline__ void xcd_barrier(const XcdBarrier& b) {
    asm volatile("s_waitcnt vmcnt(0)" ::: "memory");
    __syncthreads();
    if (threadIdx.x == 0) {
        unsigned* bar = b.bar;
        __builtin_amdgcn_s_waitcnt(0);
        unsigned nloc = b.st[0], nx = b.st[1];
        if (nloc == 0u) { xcd_barrier_complete(bar, b.x, nloc, nx); b.st[0] = nloc; b.st[1] = nx; }
        const unsigned old = xb_add(&bar[XB_XSUB(b.x)], 1u);
        const unsigned gen = old / nloc;
        if (old + 1u == (gen + 1u) * nloc) {
            __builtin_amdgcn_fence(__ATOMIC_RELEASE, "agent");
            asm volatile("s_waitcnt vmcnt(0)" ::: "memory");
            const unsigned og = xb_add(&bar[XB_TOP], 1u);
            const unsigned tg = og / nx;
            if (og + 1u == (tg + 1u) * nx) xb_add(&bar[XB_TOPGEN], 1u);
            else XB_SPIN(xb_ld(&bar[XB_TOPGEN]) == tg, bar);
            __builtin_amdgcn_fence(__ATOMIC_ACQUIRE, "agent");
            xb_add(&bar[XB_XGEN(b.x)], 1u);
            asm volatile("s_waitcnt vmcnt(0)" ::: "memory");
        } else {
            XB_SPIN(xb_ld(&bar[XB_XGEN(b.x)]) == gen, bar);
            __builtin_amdgcn_fence(__ATOMIC_ACQUIRE, "agent");
            asm volatile("s_waitcnt vmcnt(0)" ::: "memory");
        }
    }
    __syncthreads();
}
struct Args { const float* in[28]; float* out; unsigned char* ws; int ph_lo, ph_hi, li, pad; };
typedef const __attribute__((address_space(4))) Args* cargs_t;
__device__ __forceinline__ cargs_t argp() { cargs_t p = (cargs_t)__builtin_amdgcn_kernarg_segment_ptr(); asm volatile("" : "+s"(p)); return p; }
struct Frame {
    LAS unsigned char* lds;
    volatile LAS unsigned* MISC;
    gu32* ctl;
    int tid, lane, wave, vcu, G;
    const float* const* in;
};

__device__ __forceinline__ void p0_transpose_item(const float* W, int K, int N, const float* gain, bf16* WT, int drow0, LAS float* scr, int k0, int n0, int lane) {
    const int lr = lane >> 4, lc = (lane & 15) * 4;
#pragma unroll 4
    for (int i = 0; i < 16; ++i) { const int kk = 4 * i + lr; f32x4 w = *(const GAS f32x4*)(W + (size_t)(k0 + kk) * N + n0 + lc); if (gain) w = w * gain[k0 + kk];
        LAS float* d = scr + kk * 65 + lc; d[0] = w.x; d[1] = w.y; d[2] = w.z; d[3] = w.w; }
    LDS_WAIT(); asm volatile("" ::: "memory");
    const int c = lane & 7;
#pragma unroll
    for (int j = 0; j < 8; ++j) { const int n = (lane >> 3) + 8 * j; const LAS float* s = scr + (8 * c) * 65 + n;
        v4u o; o.x = pk2(s[0 * 65], s[1 * 65]); o.y = pk2(s[2 * 65], s[3 * 65]); o.z = pk2(s[4 * 65], s[5 * 65]); o.w = pk2(s[6 * 65], s[7 * 65]);
        *(GAS v4u*)(WT + (size_t)(drow0 + n) * K + k0 + 8 * c) = o; }
    LDS_WAIT(); asm volatile("" ::: "memory");
}
struct WDesc { const float* W; const float* gain; bf16* WT; int K, N, Nuse, kind, roff; };
__device__ __forceinline__ void p0_weight(const WDesc& d, int item, LAS float* scr, int lane) {
    const int nblk = d.Nuse / 64, kb = item / nblk, nb = item % nblk, n0 = 64 * nb;
    int drow0;
    if (d.kind == 0) drow0 = d.roff + n0;
    else { const int up = n0 >= FFH, j = up ? n0 - FFH : n0; drow0 = (j >> 7) * 256 + (up ? 128 : 0) + (j & 127); }
    p0_transpose_item(d.W, d.K, d.N, d.gain, d.WT, drow0, scr, 64 * kb, n0, lane);
}
__device__ __forceinline__ void p0_prologue(Frame& F, cargs_t a, int part, int gw, int NGW) {
    unsigned char* ws = a->ws;
    LAS float* scr = (LAS float*)(F.lds + RING_OFF + F.wave * 17408);
    const unsigned wmask = (part == 0) ? 0x0001u : (part == 1) ? 0x1FFEu : (part == 2) ? 0x1FFFu : (part == 3) ? 0x0156u : (part == 4) ? 0x1C08u : (part == 5) ? 0x02A0u : 0u;
    const bool do_x = part == 0 || part == 2; const int pe_lo = (part == 1 || part == 2 || part == 3) ? 0 : 2, pe_hi = (part == 1 || part == 2 || part == 3) ? 2 : 0;
    constexpr int NW = 13;
    int it0 = 0;
#pragma unroll 1
    for (int w = 0; w < 13; ++w) {
        if (!((wmask >> w) & 1u)) continue;
        WDesc d;
        switch (w) {
        case 0:  d = WDesc{a->in[9],  a->in[8],  (bf16*)(ws + WS_WIN),  1024, 4112, 4096, 0, 0}; break;
        case 1:  d = WDesc{a->in[14], nullptr,  (bf16*)(ws + WS_WOUT), 1024, 1024, 1024, 0, 0}; break;
        case 2:  d = WDesc{a->in[22], a->in[21], (bf16*)(ws + WS_WGU0), 1024, 5632, 5632, 1, 0}; break;
        case 3:  d = WDesc{a->in[22] + (size_t)1024 * 5632, a->in[21] + 1024, (bf16*)(ws + WS_WGU1), 1024, 5632, 5632, 1, 0}; break;
        case 4:  d = WDesc{a->in[23], nullptr,  (bf16*)(ws + WS_WDN0), 2816, 1024, 1024, 0, 0}; break;
        case 5:  d = WDesc{a->in[23] + (size_t)2816 * 1024, nullptr, (bf16*)(ws + WS_WDN1), 2816, 1024, 1024, 0, 0}; break;
        case 6:  d = WDesc{a->in[26], a->in[24], (bf16*)(ws + WS_WGT0), 1024, 1024, 1024, 0, 0}; break;
        case 7:  d = WDesc{a->in[26] + (size_t)1024 * 1024, a->in[24] + 1024, (bf16*)(ws + WS_WGT1), 1024, 1024, 1024, 0, 0}; break;
        case 8:  d = WDesc{a->in[25], nullptr,  (bf16*)(ws + WS_WPJ0), 256, 1024, 1024, 0, 0}; break;
        case 9:  d = WDesc{a->in[25] + (size_t)256 * 1024, nullptr, (bf16*)(ws + WS_WPJ1), 256, 1024, 1024, 0, 0}; break;
        case 10: d = WDesc{a->in[16], a->in[15], (bf16*)(ws + WS_WKVQ), 1024, 512, 512, 0, 0}; break;
        case 11: d = WDesc{a->in[18], a->in[17], (bf16*)(ws + WS_WKVQ), 1024, 1024, 1024, 0, 512}; break;
        default: d = WDesc{a->in[20], nullptr,  (bf16*)(ws + WS_WO),   1024, 1024, 1024, 0, 0}; break;
        }
        const int nitems = (d.K / 64) * (d.Nuse / 64);
        int first = (gw - (it0 % NGW) + NGW) % NGW;
        for (int item = first; item < nitems; item += NGW) p0_weight(d, item, scr, F.lane);
        it0 += nitems;
    }
    if (do_x) {
        bf16* WT = (bf16*)(ws + WS_WIN); const float* W = a->in[9]; const float* g = a->in[8];
        const int gt = gw * 64 + F.lane, NGT = NGW * 64;
        for (int e = gt; e < 256 * 1024; e += NGT) { const int n = 4096 + (e >> 10), k = e & 1023; WT[(size_t)n * 1024 + k] = (n < 4112) ? (bf16)f2bf(W[(size_t)k * 4112 + n] * g[k]) : (bf16)0; }
    }
    if (do_x) {
        bf16* XB = (bf16*)(ws + WS_XB); float* SSQ = (float*)(ws + WS_SSQX);
        for (int m = gw; m < MT; m += NGW) {
            const float* xrow = (m < MP) ? a->in[0] + (size_t)m * DM : a->in[1] + (size_t)(m - MP) * DM;
            const GAS f32x4* xr = (const GAS f32x4*)xrow + F.lane;
            f32x4 v[4]; float s = 0.f;
#pragma unroll
            for (int j = 0; j < 4; ++j) { v[j] = xr[64 * j]; s += (v[j].x * v[j].x + v[j].y * v[j].y) + (v[j].z * v[j].z + v[j].w * v[j].w); }
            s = wave_sum(s);
            GAS unsigned long long* o8 = (GAS unsigned long long*)(XB + (size_t)m * DM) + F.lane;
#pragma unroll
            for (int j = 0; j < 4; ++j) o8[64 * j] = (unsigned long long)pk2(v[j].x, v[j].y) | ((unsigned long long)pk2(v[j].z, v[j].w) << 32);
            if (F.lane < 16) SSQ[(size_t)m * 16 + F.lane] = (F.lane == 0) ? s : 0.f;
        }
    }
    if (pe_lo < pe_hi) {
        bf16* PEB = (bf16*)(ws + WS_PEB);
        const size_t gt = (size_t)gw * 64 + F.lane, NGT = (size_t)NGW * 64;
        const size_t nlayer = (size_t)MT * 256 / 8, nchunk = (size_t)pe_hi * nlayer;
        for (size_t c = (size_t)pe_lo * nlayer + gt; c < nchunk; c += NGT) {
            const size_t e = c * 8; const int l = (int)(e / ((size_t)MT * 256)); const size_t rem = e - (size_t)l * MT * 256; const size_t row = rem >> 8; const int col = (int)(rem & 255);
            const float* src = (row < (size_t)MP) ? a->in[6] + ((size_t)l * MP + row) * 256 + col : a->in[7] + ((size_t)l * MS + (row - MP)) * 256 + col;
            const f32x4 v0 = *(const GAS f32x4*)src, v1 = *(const GAS f32x4*)(src + 4);
            v4u o; o.x = pk2(v0.x, v0.y); o.y = pk2(v0.z, v0.w); o.z = pk2(v1.x, v1.y); o.w = pk2(v1.z, v1.w);
            *(GAS v4u*)(PEB + e) = o;
        }
    }
}

__device__ __forceinline__ void delta_seq_item(Frame& F, cargs_t a, int item) {
    unsigned char* ws = a->ws;
    const int tid = F.tid, kq = tid >> 7, v = tid & 127, wave = F.wave, lane = F.lane;
    const bool prompt = item < 128;
    int b, h, T; size_t rowbase;
    if (prompt) { b = item >> 3; h = item & 7; T = 2048; rowbase = (size_t)b * 2048; }
    else { const int it = item - 128; b = it >> 3; h = it & 7; T = 8; rowbase = (size_t)MP + (size_t)b * 8; }
    LAS float* L = (LAS float*)(F.lds + RING_OFF);
    LAS float* vec = L;
    LAS float* red = L + 384;
    LAS float* part = L + 512;
    LAS float* opart = L + 1024;
    LAS float* red2 = L + 1536;
    float S[32];
    if (prompt) {
#pragma unroll
        for (int i = 0; i < 32; ++i) S[i] = 0.f;
    } else {
        const float* sd = a->in[2] + ((size_t)(b * 8 + h) * 128 + 32 * kq) * 128 + v;
#pragma unroll
        for (int i = 0; i < 32; ++i) S[i] = sd[(size_t)i * 128];
    }
    const int ch = kq * 1024 + h * 128 + v;
    float cw0 = 0.f, cw1 = 0.f, cw2 = 0.f, cw3 = 0.f, xm3 = 0.f, xm2 = 0.f, xm1 = 0.f;
    if (kq < 3) {
        const float* cw = a->in[10];
        cw0 = cw[ch]; cw1 = cw[3072 + ch]; cw2 = cw[2 * 3072 + ch]; cw3 = cw[3 * 3072 + ch];
        if (!prompt) { const float* sc = a->in[3] + (size_t)b * 3 * 3072 + ch; xm3 = sc[0]; xm2 = sc[3072]; xm1 = sc[2 * 3072]; }
    }
    const float Aneg = -__expf(a->in[11][h]), dtb = a->in[12][h], outg = a->in[13][v];
    const bf16* xsrc = (kq < 3) ? (const bf16*)(ws + WS_QKV) + rowbase * 3072 + ch : (const bf16*)(ws + WS_Z) + rowbase * 1024 + h * 128 + v;
    const size_t xstride = (kq < 3) ? 3072 : 1024;
    const float* absrc = (const float*)(ws + WS_AB) + rowbase * 16 + h;
    bf16* og = (bf16*)(ws + WS_OG) + rowbase * 1024 + h * 128 + v;
    unsigned short xs[8]; float aa[8], bb[8];
#pragma unroll
    for (int j = 0; j < 8; ++j) { xs[j] = xsrc[(size_t)j * xstride]; aa[j] = absrc[(size_t)j * 16]; bb[j] = absrc[(size_t)j * 16 + 8]; }
    float o_prev = 0.f, z_prev = 0.f; bool have_prev = false;
    __syncthreads();
    for (int t0 = 0; t0 < T; t0 += 8) {
        unsigned short xc[8]; float ac[8], bc[8];
#pragma unroll
        for (int j = 0; j < 8; ++j) { xc[j] = xs[j]; ac[j] = aa[j]; bc[j] = bb[j]; }
        if (t0 + 8 < T) {
#pragma unroll
            for (int j = 0; j < 8; ++j) { xs[j] = xsrc[(size_t)(t0 + 8 + j) * xstride]; aa[j] = absrc[(size_t)(t0 + 8 + j) * 16]; bb[j] = absrc[(size_t)(t0 + 8 + j) * 16 + 8]; }
        }
#pragma unroll
        for (int tt = 0; tt < 8; ++tt) {
            const float x = bf2f(xc[tt]);
            float zcur = 0.f;
            if (kq < 3) {
                const float c = (xm3 * cw0 + xm2 * cw1) + (xm1 * cw2 + x * cw3);
                xm3 = xm2; xm2 = xm1; xm1 = x;
                const float s = c * sigmoidf_(c);
                vec[kq * 128 + v] = s;
                if (kq < 2) { const float q2 = wave_sum(s * s); if (lane == 0) red[wave] = q2; }
            } else zcur = x;
            __syncthreads();
            if (kq == 3 && have_prev) {
                const float tot = red2[0] + red2[1];
                const float ov = o_prev * rsqrtf(tot * (1.0f / 128.0f) + 1e-6f) * outg * (z_prev * sigmoidf_(z_prev));
                og[(size_t)(t0 + tt - 1) * 1024] = (bf16)f2bf(ov);
            }
            const float rq = rsqrtf(red[0] + red[1] + 1e-6f) * 0.08838834764831845f, rk = rsqrtf(red[2] + red[3] + 1e-6f);
            const float beta = sigmoidf_(bc[tt]);
            const float sp_in = ac[tt] + dtb; const float sp = (sp_in > 15.f) ? sp_in : log1pf(__expf(sp_in));
            const float adec = __expf(Aneg * sp);
            float kv[32];
            {
                float p = 0.f;
#pragma unroll
                for (int i = 0; i < 8; ++i) { const f32x4 k4 = *(const LAS f32x4*)(vec + 128 + 32 * kq + 4 * i); kv[4 * i] = k4[0]; kv[4 * i + 1] = k4[1]; kv[4 * i + 2] = k4[2]; kv[4 * i + 3] = k4[3];
                    p += (k4[0] * S[4 * i] + k4[1] * S[4 * i + 1]) + (k4[2] * S[4 * i + 2] + k4[3] * S[4 * i + 3]); }
                part[kq * 128 + v] = p;
            }
            __syncthreads();
            {
                const float kS = rk * ((part[v] + part[128 + v]) + (part[256 + v] + part[384 + v]));
                const float d = beta * (vec[256 + v] - adec * kS) * rk;
                float po = 0.f;
#pragma unroll
                for (int i = 0; i < 8; ++i) { const f32x4 q4 = *(const LAS f32x4*)(vec + 32 * kq + 4 * i);
#pragma unroll
                    for (int j = 0; j < 4; ++j) { S[4 * i + j] = adec * S[4 * i + j] + kv[4 * i + j] * d; po += q4[j] * S[4 * i + j]; } }
                opart[kq * 128 + v] = po * rq;
            }
            __syncthreads();
            if (kq == 3) {
                const float o = (opart[v] + opart[128 + v]) + (opart[256 + v] + opart[384 + v]);
                const float o2 = wave_sum(o * o); if (lane == 0) red2[wave - 6] = o2;
                o_prev = o; z_prev = zcur;
            }
            have_prev = true;
        }
    }
    __syncthreads();
    if (kq == 3) {
        const float tot = red2[0] + red2[1];
        const float ov = o_prev * rsqrtf(tot * (1.0f / 128.0f) + 1e-6f) * outg * (z_prev * sigmoidf_(z_prev));
        og[(size_t)(T - 1) * 1024] = (bf16)f2bf(ov);
    }
    {
        float* so = a->out + (prompt ? O_SDP : O_SDS) + ((size_t)(b * 8 + h) * 128 + 32 * kq) * 128 + v;
#pragma unroll
        for (int i = 0; i < 32; ++i) so[(size_t)i * 128] = S[i];
    }
}

__device__ __forceinline__ void delta_seq_samples(Frame& F, cargs_t a, int it0, int itstride, int itend) {
    unsigned char* ws = a->ws;
    const int tid = F.tid, kq = tid >> 7, v = tid & 127, wave = F.wave, lane = F.lane;
    LAS float* L = (LAS float*)(F.lds + RING_OFF);
    LAS float* vec = L;
    LAS float* zbuf = L + 3072;
    LAS float* part = L + 4096;
    LAS float* opart = L + 5120;
    LAS float* red = L + 9216;
    LAS float* red2 = L + 9248;
    const float outg = a->in[13][v];
    f32x4 Sp[8]; float aap[8], bbp[8], xmp[3], cwp[4], hp[2]; unsigned short xsp[8];
#define DS_PRE(it_) do { const int b_ = (it_) >> 3, h_ = (it_) & 7; const size_t rb_ = (size_t)MP + (size_t)b_ * 8; const int ch_ = kq * 1024 + h_ * 128 + v; \
        const float* sd_ = a->in[2] + ((size_t)(b_ * 8 + h_) * 128 + 32 * kq) * 128 + v; \
        _Pragma("unroll") for (int i = 0; i < 32; ++i) Sp[i >> 2][i & 3] = sd_[(size_t)i * 128]; \
        const bf16* xsrc_ = (kq < 3) ? (const bf16*)(ws + WS_QKV) + rb_ * 3072 + ch_ : (const bf16*)(ws + WS_Z) + rb_ * 1024 + h_ * 128 + v; \
        const size_t xstride_ = (kq < 3) ? 3072 : 1024; const float* absrc_ = (const float*)(ws + WS_AB) + rb_ * 16 + h_; \
        _Pragma("unroll") for (int j = 0; j < 8; ++j) { xsp[j] = xsrc_[(size_t)j * xstride_]; aap[j] = absrc_[(size_t)j * 16]; bbp[j] = absrc_[(size_t)j * 16 + 8]; } \
        if (kq < 3) { const float* cw_ = a->in[10]; cwp[0] = cw_[ch_]; cwp[1] = cw_[3072 + ch_]; cwp[2] = cw_[2 * 3072 + ch_]; cwp[3] = cw_[3 * 3072 + ch_]; \
            const float* sc_ = a->in[3] + (size_t)b_ * 3 * 3072 + ch_; xmp[0] = sc_[0]; xmp[1] = sc_[3072]; xmp[2] = sc_[2 * 3072]; } \
        hp[0] = a->in[11][h_]; hp[1] = a->in[12][h_]; } while (0)
    if (it0 < itend) DS_PRE(it0);
#pragma unroll 1
    for (int it = it0; it < itend; it += itstride) {
        const int b = it >> 3, h = it & 7; const size_t rowbase = (size_t)MP + (size_t)b * 8;
        f32x4 S[8]; float ac[8], bc[8]; unsigned short xc[8];
#pragma unroll
        for (int i = 0; i < 8; ++i) S[i] = Sp[i];
#pragma unroll
        for (int j = 0; j < 8; ++j) { xc[j] = xsp[j]; ac[j] = aap[j]; bc[j] = bbp[j]; }
        float cw0 = 0.f, cw1 = 0.f, cw2 = 0.f, cw3 = 0.f, xm3 = 0.f, xm2 = 0.f, xm1 = 0.f;
        if (kq < 3) { cw0 = cwp[0]; cw1 = cwp[1]; cw2 = cwp[2]; cw3 = cwp[3]; xm3 = xmp[0]; xm2 = xmp[1]; xm1 = xmp[2]; }
        const float Aneg = -__expf(hp[0]), dtb = hp[1];
        asm volatile("" ::: "memory");
        if (it + itstride < itend) DS_PRE(it + itstride);
        bf16* og = (bf16*)(ws + WS_OG) + rowbase * 1024 + h * 128 + v;
        __syncthreads();
#pragma unroll
        for (int tt = 0; tt < 8; ++tt) {
            const float x = bf2f(xc[tt]);
            if (kq < 3) {
                const float c = (xm3 * cw0 + xm2 * cw1) + (xm1 * cw2 + x * cw3);
                xm3 = xm2; xm2 = xm1; xm1 = x;
                const float s = c * sigmoidf_(c);
                vec[(tt * 3 + kq) * 128 + v] = s;
                if (kq < 2) { const float q2 = wave_sum(s * s); if (lane == 0) red[tt * 4 + wave] = q2; }
            } else zbuf[tt * 128 + v] = x;
        }
        __syncthreads();
#pragma unroll
        for (int tt = 0; tt < 8; ++tt) {
            f32x4 kv[8], qv[8];
            f32x4 pa = (f32x4){0.f, 0.f, 0.f, 0.f}, pb = (f32x4){0.f, 0.f, 0.f, 0.f};
#pragma unroll
            for (int i = 0; i < 8; ++i) kv[i] = *(const LAS f32x4*)(vec + (tt * 3 + 1) * 128 + 32 * kq + 4 * i);
#pragma unroll
            for (int i = 0; i < 8; i += 2) { pa += kv[i] * S[i]; pb += kv[i + 1] * S[i + 1]; }
            { const f32x4 ps = pa + pb; part[((tt & 1) * 4 + kq) * 128 + v] = (ps[0] + ps[1]) + (ps[2] + ps[3]); }
#pragma unroll
            for (int i = 0; i < 8; ++i) qv[i] = *(const LAS f32x4*)(vec + (tt * 3) * 128 + 32 * kq + 4 * i);
            const f32x4 rd = *(const LAS f32x4*)(red + tt * 4);
            const float vval = vec[(tt * 3 + 2) * 128 + v];
            const float rq = rsqrtf(rd[0] + rd[1] + 1e-6f) * 0.08838834764831845f, rk = rsqrtf(rd[2] + rd[3] + 1e-6f);
            const float beta = sigmoidf_(bc[tt]);
            const float sp_in = ac[tt] + dtb; const float sp = (sp_in > 15.f) ? sp_in : log1pf(__expf(sp_in));
            const float adec = __expf(Aneg * sp);
            __syncthreads();
            {
                LAS const float* pp = part + (tt & 1) * 512 + v;
                const float kS = rk * ((pp[0] + pp[128]) + (pp[256] + pp[384]));
                const float d = beta * (vval - adec * kS) * rk;
                f32x4 oa4 = (f32x4){0.f, 0.f, 0.f, 0.f}, ob4 = (f32x4){0.f, 0.f, 0.f, 0.f};
                const f32x4 ad4 = (f32x4){adec, adec, adec, adec}, d4 = (f32x4){d, d, d, d};
#pragma unroll
                for (int i = 0; i < 8; i += 2) { S[i] = kv[i] * d4 + ad4 * S[i]; S[i + 1] = kv[i + 1] * d4 + ad4 * S[i + 1]; oa4 += qv[i] * S[i]; ob4 += qv[i + 1] * S[i + 1]; }
                const f32x4 os = oa4 + ob4;
                opart[(tt * 4 + kq) * 128 + v] = ((os[0] + os[1]) + (os[2] + os[3])) * rq;
            }
        }
        __syncthreads();
        float oa, ob;
        {
            LAS const float* pa = opart + (kq * 4) * 128 + v; LAS const float* pb = opart + ((kq + 4) * 4) * 128 + v;
            oa = (pa[0] + pa[128]) + (pa[256] + pa[384]); ob = (pb[0] + pb[128]) + (pb[256] + pb[384]);
            const float sa = wave_sum(oa * oa), sb = wave_sum(ob * ob);
            if (lane == 0) { red2[kq * 2 + (wave & 1)] = sa; red2[(kq + 4) * 2 + (wave & 1)] = sb; }
        }
        __syncthreads();
        {
            const float ta = red2[kq * 2] + red2[kq * 2 + 1], tb2 = red2[(kq + 4) * 2] + red2[(kq + 4) * 2 + 1];
            const float za = zbuf[kq * 128 + v], zb = zbuf[(kq + 4) * 128 + v];
            og[(size_t)kq * 1024] = (bf16)f2bf(oa * rsqrtf(ta * (1.0f / 128.0f) + 1e-6f) * outg * (za * sigmoidf_(za)));
            og[(size_t)(kq + 4) * 1024] = (bf16)f2bf(ob * rsqrtf(tb2 * (1.0f / 128.0f) + 1e-6f) * outg * (zb * sigmoidf_(zb)));
        }
        {
            float* so = a->out + O_SDS + ((size_t)(b * 8 + h) * 128 + 32 * kq) * 128 + v;
#pragma unroll
            for (int i = 0; i < 32; ++i) so[(size_t)i * 128] = S[i >> 2][i & 3];
        }
    }
#undef DS_PRE
}

__device__ __forceinline__ void attn_sample_item(Frame& F, cargs_t a, int item) {
    unsigned char* ws = a->ws;
    const int kvh = item & 3, b = item >> 2;
    const int tid = F.tid;
    LAS float* Kf = (LAS float*)(F.lds + RING_OFF);
    LAS float* Vf = Kf + 136 * 64;
    LAS float* Sc = Vf + 136 * 64;
    const bf16* KV = (const bf16*)(ws + WS_KV);
    __syncthreads();
    {
        f32x4 cv[8];
#pragma unroll
        for (int i = 0; i < 8; ++i) { const int idx = tid + 512 * i, key = idx >> 5, c = idx & 31; const int isv = c >> 4, cc = c & 15;
            cv[i] = *(const GAS f32x4*)(a->in[isv ? 5 : 4] + ((size_t)(b * 128 + key) * 4 + kvh) * 64 + cc * 4); }
#pragma unroll
        for (int i = 0; i < 8; ++i) { const int idx = tid + 512 * i, key = idx >> 5, c = idx & 31; const int isv = c >> 4, cc = c & 15;
            *(LAS f32x4*)((isv ? Vf : Kf) + key * 64 + cc * 4) = cv[i];
            if (key >= 8) *(GAS f32x4*)(a->out + (isv ? O_VWS : O_KWS) + ((size_t)(b * 128 + key - 8) * 4 + kvh) * 64 + cc * 4) = cv[i]; }
    }
    for (int idx = tid; idx < 8 * 16; idx += 512) {
        const int t = idx >> 4, c = idx & 15;
        const v4u w = *(const GAS v4u*)(KV + ((size_t)MP + (size_t)b * 8 + t) * 512 + (c < 8 ? kvh * 64 + c * 8 : 256 + kvh * 64 + (c - 8) * 8));
        LAS float* dst = (c < 8 ? Kf + (128 + t) * 64 + c * 8 : Vf + (128 + t) * 64 + (c - 8) * 8);
        *(LAS f32x4*)dst = (f32x4){__uint_as_float(w.x << 16), __uint_as_float(w.x & 0xffff0000u), __uint_as_float(w.y << 16), __uint_as_float(w.y & 0xffff0000u)};
        *(LAS f32x4*)(dst + 4) = (f32x4){__uint_as_float(w.z << 16), __uint_as_float(w.z & 0xffff0000u), __uint_as_float(w.w << 16), __uint_as_float(w.w & 0xffff0000u)};
    }
    __syncthreads();
    const int r = tid & 31, ks = tid >> 5;
    const int t = r >> 2, g = r & 3, head = kvh * 4 + g;
    const size_t row = (size_t)MP + (size_t)b * 8 + t;
    {
        float q[64];
        const bf16* qp = (const bf16*)(ws + WS_Q) + row * 1024 + head * 64;
#pragma unroll
        for (int c = 0; c < 8; ++c) { const v4u w = *(const GAS v4u*)(qp + c * 8);
            q[c * 8 + 0] = __uint_as_float(w.x << 16); q[c * 8 + 1] = __uint_as_float(w.x & 0xffff0000u); q[c * 8 + 2] = __uint_as_float(w.y << 16); q[c * 8 + 3] = __uint_as_float(w.y & 0xffff0000u);
            q[c * 8 + 4] = __uint_as_float(w.z << 16); q[c * 8 + 5] = __uint_as_float(w.z & 0xffff0000u); q[c * 8 + 6] = __uint_as_float(w.w << 16); q[c * 8 + 7] = __uint_as_float(w.w & 0xffff0000u); }
        for (int j = ks; j < 136; j += 16) {
            const LAS float* kr = Kf + j * 64; float s = 0.f;
#pragma unroll
            for (int d = 0; d < 16; ++d) { const f32x4 k4 = *(const LAS f32x4*)(kr + 4 * d); s += (q[4 * d] * k4[0] + q[4 * d + 1] * k4[1]) + (q[4 * d + 2] * k4[2] + q[4 * d + 3] * k4[3]); }
            const bool ok = (j < 128) ? (j >= t + 1) : (j - 128 <= t);
            Sc[r * 136 + j] = ok ? s : -1e30f;
        }
    }
    __syncthreads();
    {
        const float sink = a->in[19][head];
        LAS float* red = Sc + 32 * 136;
        float mloc = -1e30f;
        for (int j = ks; j < 136; j += 16) mloc = fmaxf(mloc, Sc[r * 136 + j]);
        red[ks * 32 + r] = mloc;
        __syncthreads();
        float mx = sink;
#pragma unroll
        for (int i = 0; i < 16; ++i) mx = fmaxf(mx, red[i * 32 + r]);
        float lloc = 0.f;
        for (int j = ks; j < 136; j += 16) { const float p = __expf(Sc[r * 136 + j] - mx); Sc[r * 136 + j] = p; lloc += p; }
        red[512 + ks * 32 + r] = lloc;
        __syncthreads();
        float l = __expf(sink - mx);
#pragma unroll
        for (int i = 0; i < 16; ++i) l += red[512 + i * 32 + r];
        f32x4 o = (f32x4){0.f, 0.f, 0.f, 0.f};
#pragma unroll 8
        for (int j = 0; j < 136; ++j) { const float p = Sc[r * 136 + j]; const f32x4 v4 = *(const LAS f32x4*)(Vf + j * 64 + ks * 4); o += v4 * p; }
        const float inv = 1.0f / l;
        bf16* op = (bf16*)(ws + WS_OB) + row * 1024 + head * 64 + ks * 4;
        *(GAS unsigned long long*)op = (unsigned long long)pk2(o[0] * inv, o[1] * inv) | ((unsigned long long)pk2(o[2] * inv, o[3] * inv) << 32);
    }
}

__device__ __forceinline__ void final_norm(Frame& F, cargs_t a) {
    const int gw = F.vcu * NWAVES + F.wave, NGW = F.G * NWAVES;
    const GAS f32x4* gn = (const GAS f32x4*)a->in[27] + F.lane;
    f32x4 g[4];
#pragma unroll
    for (int j = 0; j < 4; ++j) g[j] = gn[64 * j];
    const bf16* H = (const bf16*)(a->ws + WS_HB); const float* SSQ = (const float*)(a->ws + WS_SSQB);
    for (int m = gw; m < MT; m += NGW) {
        unsigned long long w[4];
#pragma unroll
        for (int j = 0; j < 4; ++j) w[j] = *(const GAS unsigned long long*)(H + (size_t)m * DM + 4 * F.lane + 256 * j);
        float s = (F.lane < 16) ? SSQ[(size_t)m * 16 + F.lane] : 0.f;
        s = wave_sum(s);
        const float rstd = rsqrtf(s * (1.f / DM) + 1e-6f);
        GAS f32x4* yr = (GAS f32x4*)(a->out + O_Y + (size_t)m * DM) + F.lane;
#pragma unroll
        for (int j = 0; j < 4; ++j) { const unsigned lo = (unsigned)w[j], hi = (unsigned)(w[j] >> 32);
            const f32x4 v = (f32x4){__uint_as_float(lo << 16), __uint_as_float(lo & 0xffff0000u), __uint_as_float(hi << 16), __uint_as_float(hi & 0xffff0000u)};
            yr[64 * j] = v * rstd * g[j]; }
    }
}
typedef short bf16x8 __attribute__((ext_vector_type(8)));
typedef short bf16x4 __attribute__((ext_vector_type(4)));
typedef LAS const unsigned char* lcp;
#define LDS_BARRIER() do { asm volatile("s_waitcnt lgkmcnt(0)" ::: "memory"); __builtin_amdgcn_s_barrier(); asm volatile("" ::: "memory"); } while (0)
constexpr int PREP_HALF = 79872, PL_QKT = 71680;
constexpr int PL_KB = 0, PL_QB = 17408, PL_VB = 34816, PL_AM = 52224, PL_TB = 69632;
__device__ __forceinline__ unsigned cvtpk(float lo, float hi) { unsigned r; asm volatile("v_cvt_pk_bf16_f32 %0, %1, %2" : "=v"(r) : "v"(lo), "v"(hi)); return r; }
__device__ __forceinline__ f32x4 bfx4lo(unsigned a, unsigned b) { return (f32x4){__uint_as_float(a << 16), __uint_as_float(a & 0xffff0000u), __uint_as_float(b << 16), __uint_as_float(b & 0xffff0000u)}; }

#ifndef PROF_BLK
#define PROF_BLK 0
#endif
#ifdef PROF_A
#define ISTAMP(cond, k) do { if (((k) == PROF_A || (k) == PROF_AE || (k) == PROF_B || (k) == PROF_BE) && (cond) && blockIdx.x == PROF_BLK && threadIdx.x == 0) ((unsigned long long*)(a->ws + WS_CTL + 2048))[(k)] = __builtin_amdgcn_s_memrealtime(); } while (0)
#else
#define ISTAMP(cond, k) do { } while (0)
#endif
__device__ __forceinline__ void dprep_loop(Frame& F, cargs_t a) {
    unsigned char* ws = a->ws;
    int tid_ = threadIdx.x; asm volatile("" : "+v"(tid_));
    const int tid = tid_, half = tid >> 8, t8 = tid & 255, lane = tid & 63, w4 = (tid >> 6) & 3;
    LAS unsigned char* L = F.lds + RING_OFF + half * PREP_HALF;
    const int tg = t8 >> 4, cg = t8 & 15;
    v4u raw[3][7]; float abv[2];
#define DP_LOAD(pair_) do { const int it_ = 2 * (pair_) + half, c_ = it_ & 31, h_ = (it_ >> 5) & 7, b_ = it_ >> 8; const size_t t0_ = (size_t)b_ * 2048 + (size_t)c_ * 64; \
        const bf16* Q_ = (const bf16*)(ws + WS_QKV); const bf16* H_ = (const bf16*)(ws + WS_HALO); \
        _Pragma("unroll") for (int p_ = 0; p_ < 3; ++p_) { const int cb_ = p_ * 1024 + h_ * 128 + 8 * cg; \
            _Pragma("unroll") for (int i_ = 0; i_ < 7; ++i_) { const int lr_ = 4 * tg - 3 + i_; \
                if (lr_ >= 0) raw[p_][i_] = *(const GAS v4u*)(Q_ + (t0_ + lr_) * 3072 + cb_); \
                else if (c_ > 0) raw[p_][i_] = *(const GAS v4u*)(H_ + ((size_t)(b_ * 32 + c_ - 1) * 3 + (lr_ + 3)) * 3072 + cb_); \
                else raw[p_][i_] = (v4u){0u, 0u, 0u, 0u}; } } \
        if (w4 == 0) { const float* ab_ = (const float*)(ws + WS_AB) + (t0_ + lane) * 16 + h_; abv[0] = ab_[0]; abv[1] = ab_[8]; } } while (0)
#pragma unroll 1
    for (int pair = blockIdx.x; pair < 2048; pair += F.G) {
    DP_LOAD(pair);
    const int item = 2 * pair + half, c = item & 31, h = (item >> 5) & 7, b = item >> 8;
    const size_t t0 = (size_t)b * 2048 + (size_t)c * 64; const int chunkg = b * 32 + c;
    LAS float* TB = (LAS float*)(L + PL_TB);
    LAS float* AM = (LAS float*)(L + PL_AM);
    LDS_BARRIER();
    ISTAMP(pair == 256, 32);
    {
#pragma unroll
        for (int p = 0; p < 3; ++p) {
            const int colbase = p * 1024 + h * 128 + 8 * cg;
            const float* cw = a->in[10] + colbase;
            f32x4 w[4][2];
#pragma unroll
            for (int k = 0; k < 4; ++k) { w[k][0] = *(const GAS f32x4*)(cw + k * 3072); w[k][1] = *(const GAS f32x4*)(cw + k * 3072 + 4); }
            f32x4 o[4][2];
#pragma unroll
            for (int tok = 0; tok < 4; ++tok) { o[tok][0] = (f32x4){0.f, 0.f, 0.f, 0.f}; o[tok][1] = o[tok][0]; }
#pragma unroll
            for (int i = 0; i < 7; ++i) {
                const f32x4 x0 = bfx4lo(raw[p][i].x, raw[p][i].y), x1 = bfx4lo(raw[p][i].z, raw[p][i].w);
#pragma unroll
                for (int tok = 0; tok < 4; ++tok) { const int k = i - tok; if (k >= 0 && k < 4) { o[tok][0] += x0 * w[k][0]; o[tok][1] += x1 * w[k][1]; } }
            }
            LAS unsigned char* dst = L + (p == 0 ? PL_QB : (p == 1 ? PL_KB : PL_VB));
#pragma unroll
            for (int tok = 0; tok < 4; ++tok) {
                float ss = 0.f;
#pragma unroll
                for (int e = 0; e < 4; ++e) { float x = o[tok][0][e]; x = x * sigmoidf_(x); o[tok][0][e] = x; ss += x * x; float y = o[tok][1][e]; y = y * sigmoidf_(y); o[tok][1][e] = y; ss += y * y; }
                if (p < 2) {
                    ss += __shfl_xor(ss, 1); ss += __shfl_xor(ss, 2); ss += __shfl_xor(ss, 4); ss += __shfl_xor(ss, 8);
                    const float rn = rsqrtf(ss + 1e-6f) * (p == 0 ? 0.08838834764831845f : 1.0f);
                    o[tok][0] = o[tok][0] * rn; o[tok][1] = o[tok][1] * rn;
                }
                v4u pk; pk.x = cvtpk(o[tok][0][0], o[tok][0][1]); pk.y = cvtpk(o[tok][0][2], o[tok][0][3]); pk.z = cvtpk(o[tok][1][0], o[tok][1][1]); pk.w = cvtpk(o[tok][1][2], o[tok][1][3]);
                *(LAS v4u*)(dst + (4 * tg + tok) * 272 + cg * 16) = pk;
            }
        }
    }
    ISTAMP(pair == 256, 33);
    if (w4 == 0) {
        const float av = abv[0], bv = abv[1];
        const float Aneg = -__expf(a->in[11][h]), dtb = a->in[12][h];
        const float beta = sigmoidf_(bv);
        const float spi = av + dtb; const float sp = (spi > 15.f) ? spi : log1pf(__expf(spi));
        float gc = Aneg * sp;
#pragma unroll
        for (int o = 1; o < 64; o <<= 1) { const float t = __shfl_up(gc, o); if (lane >= o) gc += t; }
        const float glast = __shfl(gc, 63);
        const float eg = __expf(gc), ek = __expf(glast - gc);
        TB[lane] = beta; TB[64 + lane] = gc; TB[128 + lane] = eg; TB[192 + lane] = ek; TB[256 + lane] = beta; TB[320 + lane] = beta * eg;
        float* scl = (float*)(ws + WS_SCL) + ((size_t)chunkg * 8 + h) * 128;
        scl[lane] = eg; scl[64 + lane] = ek;
    }
    LDS_BARRIER();
    ISTAMP(pair == 256, 34);
    {
        const int fr = lane & 15, fq = lane >> 4;
        f32x4 kk[4], qq[4];
#pragma unroll
        for (int nt = 0; nt < 4; ++nt) { kk[nt] = (f32x4){0.f, 0.f, 0.f, 0.f}; qq[nt] = kk[nt]; }
#pragma unroll
        for (int ks = 0; ks < 4; ++ks) {
            const bf16x8 ak = *(const LAS bf16x8*)(L + PL_KB + (16 * w4 + fr) * 272 + ks * 64 + fq * 16);
            const bf16x8 aq = *(const LAS bf16x8*)(L + PL_QB + (16 * w4 + fr) * 272 + ks * 64 + fq * 16);
#pragma unroll
            for (int nt = 0; nt < 4; ++nt) {
                const bf16x8 bk = *(const LAS bf16x8*)(L + PL_KB + (16 * nt + fr) * 272 + ks * 64 + fq * 16);
                kk[nt] = __builtin_amdgcn_mfma_f32_16x16x32_bf16(ak, bk, kk[nt], 0, 0, 0);
                qq[nt] = __builtin_amdgcn_mfma_f32_16x16x32_bf16(aq, bk, qq[nt], 0, 0, 0);
            }
        }
#pragma unroll
        for (int j = 0; j < 4; ++j) {
            const int i = 16 * w4 + 4 * fq + j; const float gi = TB[64 + i], bi = TB[i];
#pragma unroll
            for (int nt = 0; nt < 4; ++nt) {
                const int jj = 16 * nt + fr; const float d = __expf(fminf(gi - TB[64 + jj], 0.f));
                AM[i * 68 + jj] = (i > jj) ? bi * kk[nt][j] * d : 0.f;
                ((LAS bf16*)(L + PL_QKT))[i * 64 + jj] = (bf16)f2bf((i >= jj) ? qq[nt][j] * d : 0.f);
            }
        }
    }
    LDS_BARRIER();
    ISTAMP(pair == 256, 35);
    {
        const bool isv = t8 < 128; const int col = t8 & 127;
        LAS const bf16* src = (LAS const bf16*)(L + (isv ? PL_VB : PL_KB)) + col;
        LAS const float* coef = TB + (isv ? 256 : 320);
        float x[64];
#pragma unroll
        for (int i0 = 0; i0 < 64; i0 += 16) {
            unsigned short rv[16]; f32x4 cf[4];
#pragma unroll
            for (int r = 0; r < 16; ++r) rv[r] = src[(i0 + r) * 136];
#pragma unroll
            for (int r = 0; r < 4; ++r) cf[r] = *(LAS const f32x4*)(coef + i0 + 4 * r);
            __builtin_amdgcn_sched_barrier(0);
#pragma unroll
            for (int r = 0; r < 16; ++r) x[i0 + r] = bf2f(rv[r]) * cf[r >> 2][r & 3];
            __builtin_amdgcn_sched_barrier(0);
        }
#pragma unroll
        for (int jb = 0; jb < 16; ++jb) {
            const int j0 = 4 * jb;
            {
                const f32x4 a1 = *(LAS const f32x4*)(AM + (j0 + 1) * 68 + j0), a2 = *(LAS const f32x4*)(AM + (j0 + 2) * 68 + j0), a3 = *(LAS const f32x4*)(AM + (j0 + 3) * 68 + j0);
                x[j0 + 1] -= a1[0] * x[j0];
                x[j0 + 2] -= a2[0] * x[j0] + a2[1] * x[j0 + 1];
                x[j0 + 3] -= (a3[0] * x[j0] + a3[1] * x[j0 + 1]) + a3[2] * x[j0 + 2];
            }
            {
                f32x4 avA[6], avB[6];
#define SV_LOAD(dst, i0_) do { _Pragma("unroll") for (int r_ = 0; r_ < 6; ++r_) if ((i0_) + r_ < 64) dst[r_] = *(LAS const f32x4*)(AM + ((i0_) + r_) * 68 + j0); } while (0)
#define SV_FMA(src, i0_) do { _Pragma("unroll") for (int r_ = 0; r_ < 6; ++r_) if ((i0_) + r_ < 64) x[(i0_) + r_] -= (src[r_][0] * x[j0] + src[r_][1] * x[j0 + 1]) + (src[r_][2] * x[j0 + 2] + src[r_][3] * x[j0 + 3]); } while (0)
                if (j0 + 4 < 64) SV_LOAD(avA, j0 + 4);
#pragma unroll
                for (int i0 = j0 + 4; i0 < 64; i0 += 12) {
                    if (i0 + 6 < 64) SV_LOAD(avB, i0 + 6);
                    __builtin_amdgcn_sched_barrier(0);
                    SV_FMA(avA, i0);
                    __builtin_amdgcn_sched_barrier(0);
                    if (i0 + 12 < 64) SV_LOAD(avA, i0 + 12);
                    __builtin_amdgcn_sched_barrier(0);
                    if (i0 + 6 < 64) SV_FMA(avB, i0 + 6);
                    __builtin_amdgcn_sched_barrier(0);
                }
#undef SV_LOAD
#undef SV_FMA
            }
        }
        if (isv) {
            bf16* ut = (bf16*)(ws + WS_UTB) + (t0 + (col >> 1)) * 1024 + h * 128 + (col & 1) * 64;
#pragma unroll
            for (int g = 0; g < 8; ++g) { v4u pk; pk.x = cvtpk(x[8 * g], x[8 * g + 1]); pk.y = cvtpk(x[8 * g + 2], x[8 * g + 3]); pk.z = cvtpk(x[8 * g + 4], x[8 * g + 5]); pk.w = cvtpk(x[8 * g + 6], x[8 * g + 7]); *(GAS v4u*)(ut + 8 * g) = pk; }
        }
        LDS_BARRIER();
        if (!isv) {
            LAS bf16* nwt = (LAS bf16*)(L + PL_VB) + col;
#pragma unroll
            for (int i = 0; i < 64; ++i) nwt[i * 136] = (bf16)f2bf(-x[i]);
        }
    }
    LDS_BARRIER();
    ISTAMP(pair == 256, 36);
    {
        bf16* qd = (bf16*)(ws + WS_QKV) + t0 * 3072 + h * 128;
#pragma unroll
        for (int i = 0; i < 4; ++i) { const int ch = t8 + 256 * i, row = ch >> 4, cc = ch & 15; *(GAS v4u*)(qd + (size_t)row * 3072 + cc * 8) = *(const LAS v4u*)(L + PL_QB + row * 272 + cc * 16); }
        bf16* nd = (bf16*)(ws + WS_QKV) + t0 * 3072 + 2048 + h * 128;
#pragma unroll
        for (int i = 0; i < 4; ++i) { const int ch = t8 + 256 * i, row = ch >> 4, cc = ch & 15; *(GAS v4u*)(nd + (size_t)row * 3072 + cc * 8) = *(const LAS v4u*)(L + PL_VB + row * 272 + cc * 16); }
        bf16* qkd = (bf16*)(ws + WS_QKM) + t0 * 512 + h * 64;
#pragma unroll
        for (int i = 0; i < 2; ++i) { const int ch = t8 + 256 * i, row = ch >> 3, cc = ch & 7; *(GAS v4u*)(qkd + (size_t)row * 512 + cc * 8) = *(const LAS v4u*)(L + PL_QKT + row * 128 + cc * 16); }
        bf16* kd = (bf16*)(ws + WS_QKV) + t0 * 3072 + 1024 + h * 128;
        LAS const bf16* kb = (LAS const bf16*)(L + PL_KB);
#pragma unroll
        for (int i = 0; i < 4; ++i) {
            const int ch = t8 + 256 * i, k = ch >> 3, cgp = ch & 7;
            unsigned short e[8];
#pragma unroll
            for (int j = 0; j < 8; ++j) e[j] = kb[(8 * cgp + j) * 136 + k];
            v4u pk; pk.x = e[0] | ((unsigned)e[1] << 16); pk.y = e[2] | ((unsigned)e[3] << 16); pk.z = e[4] | ((unsigned)e[5] << 16); pk.w = e[6] | ((unsigned)e[7] << 16);
            *(GAS v4u*)(kd + (size_t)(k >> 1) * 3072 + (k & 1) * 64 + cgp * 8) = pk;
        }
    }
    ISTAMP(pair == 256, 37);
    }
#undef DP_LOAD
}

constexpr int SL_Q = 0, SL_W = 17408, SL_KT = 34816, SL_QK = 53248, SL_SC = 62464, SL_OT = 62976;
__device__ __forceinline__ bf16x8 frag2(LAS const unsigned char* p) {
    const bf16x4 lo = *(LAS const bf16x4*)p, hi = *(LAS const bf16x4*)(p + 32);
    return (bf16x8){lo[0], lo[1], lo[2], lo[3], hi[0], hi[1], hi[2], hi[3]};
}
__device__ __forceinline__ bf16x8 packB(const f32x4 lo, const f32x4 hi) {
    const unsigned a = cvtpk(lo[0], lo[1]), b = cvtpk(lo[2], lo[3]), c = cvtpk(hi[0], hi[1]), d = cvtpk(hi[2], hi[3]);
    return __builtin_bit_cast(bf16x8, (v4u){a, b, c, d});
}
__device__ __forceinline__ void dscan_item(Frame& F, cargs_t a, int item) {
    unsigned char* ws = a->ws;
    int tid_ = threadIdx.x; asm volatile("" : "+v"(tid_));
    const int tid = tid_, lane = tid & 63, w = F.wave, fr = lane & 15, fq = lane >> 4;
    const int b = item >> 3, h = item & 7;
    const size_t tb = (size_t)b * 2048;
    LAS unsigned char* L = F.lds + RING_OFF;
    const bf16* QKV = (const bf16*)(ws + WS_QKV); const bf16* QKM = (const bf16*)(ws + WS_QKM); const bf16* UTB = (const bf16*)(ws + WS_UTB);
    const bf16* Zb = (const bf16*)(ws + WS_Z); const float* SCL = (const float*)(ws + WS_SCL);
    bf16* OGp = (bf16*)(ws + WS_OG);
    f32x4 S[8];
#pragma unroll
    for (int st = 0; st < 8; ++st) S[st] = (f32x4){0.f, 0.f, 0.f, 0.f};
    const int r0 = tid >> 4, c0 = tid & 15;
    const int r1 = tid >> 3, c1 = tid & 7;
    const int grow = tid >> 3, gcg = tid & 7;
    v4u pq[2], pw[2], pk[2], pqk, psc, pz[2]; unsigned long long put[4];
    const float* og_gain = a->in[13] + 16 * gcg;
#define DS_LOAD(ci) do { const size_t t0_ = tb + (size_t)(ci) * 64; if ((ci) < 32) { \
        _Pragma("unroll") for (int i_ = 0; i_ < 2; ++i_) { const bf16* rp = QKV + (t0_ + r0 + 32 * i_) * 3072 + h * 128 + c0 * 8; pq[i_] = *(const GAS v4u*)rp; pk[i_] = *(const GAS v4u*)(rp + 1024); pw[i_] = *(const GAS v4u*)(rp + 2048); } \
        pqk = *(const GAS v4u*)(QKM + (t0_ + r1) * 512 + h * 64 + c1 * 8); \
        if (tid < 32) psc = *(const GAS v4u*)(SCL + ((size_t)(b * 32 + (ci)) * 8 + h) * 128 + tid * 4); \
        { const int v_ = 16 * w + fr; const bf16* up = UTB + (t0_ + (v_ >> 1)) * 1024 + h * 128 + (v_ & 1) * 64 + 4 * fq; \
          _Pragma("unroll") for (int mt_ = 0; mt_ < 4; ++mt_) put[mt_] = *(const GAS unsigned long long*)(up + 16 * mt_); } } \
        if ((ci) > 0) { _Pragma("unroll") for (int i_ = 0; i_ < 2; ++i_) pz[i_] = *(const GAS v4u*)(Zb + (t0_ - 64 + grow) * 1024 + h * 128 + gcg * 16 + i_ * 8); } } while (0)
    DS_LOAD(0);
    __syncthreads();
#pragma unroll 1
    for (int ci = 0; ci <= 32; ++ci) {
        LDS_BARRIER(); ISTAMP(ci == 10, 40); ISTAMP(ci == 11, 44);
        f32x4 u[4];
        if (ci < 32) {
#pragma unroll
            for (int i = 0; i < 2; ++i) {
                *(LAS v4u*)(L + SL_Q + (r0 + 32 * i) * 272 + c0 * 16) = pq[i];
                *(LAS v4u*)(L + SL_W + (r0 + 32 * i) * 272 + c0 * 16) = pw[i];
                { const int kr = 2 * (r0 + 32 * i) + (c0 >> 3); *(LAS v4u*)(L + SL_KT + kr * 144 + (c0 & 7) * 16) = pk[i]; }
            }
            *(LAS v4u*)(L + SL_QK + r1 * 144 + c1 * 16) = pqk;
            if (tid < 32) *(LAS v4u*)(L + SL_SC + tid * 16) = psc;
#pragma unroll
            for (int mt = 0; mt < 4; ++mt) u[mt] = bfx4lo((unsigned)put[mt], (unsigned)(put[mt] >> 32));
        }
        if (ci > 0) {
            const v4u o0 = *(const LAS v4u*)(L + SL_OT + grow * 272 + gcg * 32), o1 = *(const LAS v4u*)(L + SL_OT + grow * 272 + gcg * 32 + 16);
            f32x4 ov[4] = {bfx4lo(o0.x, o0.y), bfx4lo(o0.z, o0.w), bfx4lo(o1.x, o1.y), bfx4lo(o1.z, o1.w)};
            float ss = (dot4s(ov[0]) + dot4s(ov[1])) + (dot4s(ov[2]) + dot4s(ov[3]));
            ss += __shfl_xor(ss, 1); ss += __shfl_xor(ss, 2); ss += __shfl_xor(ss, 4);
            const float rn = rsqrtf(ss * (1.0f / 128.0f) + 1e-6f);
            const f32x4 zv[4] = {bfx4lo(pz[0].x, pz[0].y), bfx4lo(pz[0].z, pz[0].w), bfx4lo(pz[1].x, pz[1].y), bfx4lo(pz[1].z, pz[1].w)};
            unsigned pkd[8];
#pragma unroll
            for (int q4 = 0; q4 < 4; ++q4) {
                const f32x4 gn = *(const GAS f32x4*)(og_gain + 4 * q4); f32x4 r;
#pragma unroll
                for (int e = 0; e < 4; ++e) { const float z = zv[q4][e]; r[e] = ov[q4][e] * rn * gn[e] * (z * sigmoidf_(z)); }
                pkd[2 * q4] = cvtpk(r[0], r[1]); pkd[2 * q4 + 1] = cvtpk(r[2], r[3]);
            }
            bf16* op = OGp + (tb + (size_t)(ci - 1) * 64 + grow) * 1024 + h * 128 + gcg * 16;
            *(GAS v4u*)op = (v4u){pkd[0], pkd[1], pkd[2], pkd[3]}; *(GAS v4u*)(op + 8) = (v4u){pkd[4], pkd[5], pkd[6], pkd[7]};
        }
        if (ci == 32) break;
        if (ci + 1 <= 32) DS_LOAD(ci + 1);
        ISTAMP(ci == 10, 41); LDS_BARRIER(); ISTAMP(ci == 10, 42);
        f32x4 o[4];
        lcp wbase = (lcp)(L + SL_W + fr * 272 + fq * 8), qbase = (lcp)(L + SL_Q + fr * 272 + fq * 8);
        lcp kbase = (lcp)(L + SL_QK + fr * 144 + fq * 8), tbase = (lcp)(L + SL_KT + fr * 144 + fq * 8);
        bf16x8 fA[4];
#define DS_SB() __builtin_amdgcn_sched_barrier(0)
#pragma unroll
        for (int mt = 0; mt < 4; ++mt) o[mt] = (f32x4){0.f, 0.f, 0.f, 0.f};
#pragma unroll
        for (int ks = 0; ks < 4; ++ks) {
            const bf16x8 sbk = packB(S[2 * ks], S[2 * ks + 1]);
#pragma unroll
            for (int mt = 0; mt < 4; ++mt) fA[mt] = frag2(wbase + mt * 16 * 272 + ks * 64);
            DS_SB();
#pragma unroll
            for (int mt = 0; mt < 4; ++mt) u[mt] = __builtin_amdgcn_mfma_f32_16x16x32_bf16(fA[mt], sbk, u[mt], 0, 0, 0);
            DS_SB();
#pragma unroll
            for (int mt = 0; mt < 4; ++mt) fA[mt] = frag2(qbase + mt * 16 * 272 + ks * 64);
            DS_SB();
#pragma unroll
            for (int mt = 0; mt < 4; ++mt) o[mt] = __builtin_amdgcn_mfma_f32_16x16x32_bf16(fA[mt], sbk, o[mt], 0, 0, 0);
            DS_SB();
        }
        LAS const float* sc = (LAS const float*)(L + SL_SC);
        const float gl = sc[63];
        bf16x8 ub[2], ub2[2];
        {
#pragma unroll
            for (int mt = 0; mt < 4; ++mt) { const f32x4 eg = *(LAS const f32x4*)(sc + 16 * mt + 4 * fq); o[mt] = o[mt] * eg; }
            ub[0] = packB(u[0], u[1]); ub[1] = packB(u[2], u[3]);
#pragma unroll
            for (int mt = 0; mt < 4; ++mt) { const f32x4 ek = *(LAS const f32x4*)(sc + 64 + 16 * mt + 4 * fq); u[mt] = u[mt] * ek; }
            ub2[0] = packB(u[0], u[1]); ub2[1] = packB(u[2], u[3]);
        }
#pragma unroll
        for (int st = 0; st < 8; ++st) S[st] = S[st] * gl;
        DS_SB();
#pragma unroll
        for (int m2 = 0; m2 < 2; ++m2) {
#pragma unroll
            for (int mt = 0; mt < 2; ++mt) { fA[2 * mt] = frag2(kbase + (2 * m2 + mt) * 16 * 144); fA[2 * mt + 1] = frag2(kbase + (2 * m2 + mt) * 16 * 144 + 64); }
            DS_SB();
#pragma unroll
            for (int mt = 0; mt < 2; ++mt)
#pragma unroll
                for (int ks = 0; ks < 2; ++ks) o[2 * m2 + mt] = __builtin_amdgcn_mfma_f32_16x16x32_bf16(fA[2 * mt + ks], ub[ks], o[2 * m2 + mt], 0, 0, 0);
            DS_SB();
        }
#pragma unroll
        for (int s2 = 0; s2 < 4; ++s2) {
#pragma unroll
            for (int st = 0; st < 2; ++st) { fA[2 * st] = frag2(tbase + (2 * s2 + st) * 16 * 144); fA[2 * st + 1] = frag2(tbase + (2 * s2 + st) * 16 * 144 + 64); }
            DS_SB();
#pragma unroll
            for (int st = 0; st < 2; ++st)
#pragma unroll
                for (int ks = 0; ks < 2; ++ks) S[2 * s2 + st] = __builtin_amdgcn_mfma_f32_16x16x32_bf16(fA[2 * st + ks], ub2[ks], S[2 * s2 + st], 0, 0, 0);
            DS_SB();
        }
#undef LD_W
#undef LD_Q
#undef MM_U
#undef MM_O
#undef DS_SB
        ISTAMP(ci == 10, 43);
        LAS bf16* ot = (LAS bf16*)(L + SL_OT) + 16 * w + fr;
#pragma unroll
        for (int mt = 0; mt < 4; ++mt)
#pragma unroll
            for (int j = 0; j < 4; ++j) ot[(16 * mt + 4 * fq + j) * 136] = (bf16)f2bf(o[mt][j]);
    }
#undef DS_LOAD
    float* so = a->out + O_SDP + ((size_t)(b * 8 + h) * 128) * 128 + 16 * w + fr;
#pragma unroll
    for (int st = 0; st < 8; ++st)
#pragma unroll
        for (int j = 0; j < 4; ++j) so[(size_t)(16 * st + 4 * fq + j) * 128] = S[st][j];
}
constexpr int TH_KB = 0, TH_QB = 17408, TH_TB = 34816, TH_QKT = 36352, TH_HALF = 44544, TS_SLOT0 = 2 * TH_HALF, TS_SLOTB = 8448;
constexpr size_t QT_STRIDE = 1024;
__host__ __device__ constexpr int tri_off(int l) { return 4 * (2 * (l >> 2) * (l >> 2) + (l >> 2) + ((l & 3) ? (l >> 2) + ((l & 3) - 1) * ((l >> 2) + 1) : 0)); }
__device__ __forceinline__ int tri_off_rt(int l) { const int q = l >> 2, p = l & 3; return 4 * (2 * q * q + q + (p ? q + (p - 1) * (q + 1) : 0)); }

__device__ __forceinline__ void dprep_loop_t(Frame& F, cargs_t a) {
    unsigned char* ws = a->ws;
    int tid_ = threadIdx.x; asm volatile("" : "+v"(tid_));
    const int tid = tid_, half = tid >> 8, t8 = tid & 255, lane = tid & 63, w4 = (tid >> 6) & 3, w8 = tid >> 6;
    LAS unsigned char* L = F.lds + RING_OFF + half * TH_HALF;
    LAS unsigned char* L0 = F.lds + RING_OFF;
    bf16* QT = (bf16*)(a->out + O_Y);
    const int ngrp = ((2048 + F.G - 1) / F.G + 3) >> 2;
    v4u raw[3][7]; float abv[2] = {0.f, 0.f};
#pragma unroll 1
    for (int grp = 0; grp < ngrp; ++grp) {
    ISTAMP(grp == 0, 70);
#define DP_LOAD(pp_, plo_, phi_) do { int pr_ = (int)((blockIdx.x + 7u * (unsigned)(grp * 4 + (pp_))) % (unsigned)F.G) + (grp * 4 + (pp_)) * F.G; pr_ = pr_ < 2048 ? pr_ : 2047; \
        const int it_ = 2 * pr_ + half, c_ = it_ & 31, h_ = (it_ >> 5) & 7, b_ = it_ >> 8; const size_t t0_ = (size_t)b_ * 2048 + (size_t)c_ * 64; const int cgk_ = b_ * 32 + c_; \
        int t8p_ = t8; asm volatile("" : "+v"(t8p_)); const int tg_ = t8p_ >> 4, cg_ = t8p_ & 15; \
        const bf16* Q_ = (const bf16*)(ws + WS_QKV); const bf16* H_ = (const bf16*)(ws + WS_HALO); \
        _Pragma("unroll") for (int p = (plo_); p < (phi_); ++p) { const int cb = p * 1024 + h_ * 128 + 8 * cg_; \
            _Pragma("unroll") for (int i = 0; i < 7; ++i) { const int lr = 4 * tg_ - 3 + i; \
                if (lr >= 0) raw[p][i] = *(const GAS v4u*)(Q_ + (t0_ + lr) * 3072 + cb); \
                else if (c_ > 0) raw[p][i] = *(const GAS v4u*)(H_ + ((size_t)(cgk_ - 1) * 3 + (lr + 3)) * 3072 + cb); \
                else raw[p][i] = (v4u){0u, 0u, 0u, 0u}; } } \
        if ((phi_) == 3 && w4 == 0) { const float* ab_ = (const float*)(ws + WS_AB) + (t0_ + lane) * 16 + h_; abv[0] = ab_[0]; abv[1] = ab_[8]; } } while (0)
    if (grp == 0) DP_LOAD(0, 0, 2);
#pragma unroll 1
    for (int pp = 0; pp < 4; ++pp) {
        ISTAMP(grp == 0 && pp == 1, 73);
        int pair = (int)((blockIdx.x + 7u * (unsigned)(grp * 4 + pp)) % (unsigned)F.G) + (grp * 4 + pp) * F.G; pair = pair < 2048 ? pair : 2047;
        const int item = 2 * pair + half, c = item & 31, h = (item >> 5) & 7, b = item >> 8;
        const size_t t0 = (size_t)b * 2048 + (size_t)c * 64; const int chunkg = b * 32 + c;
        int t8o = t8; asm volatile("" : "+v"(t8o));
        const int tg = t8o >> 4, cg = t8o & 15;
        LAS float* TB = (LAS float*)(L + TH_TB);
        DP_LOAD(pp, 2, 3);
        LDS_BARRIER();
        ISTAMP(grp == 0 && pp == 1, 74);
#pragma unroll
        for (int p = 0; p < 3; ++p) {
            const int colbase = p * 1024 + h * 128 + 8 * cg;
            const float* cw = a->in[10] + colbase;
            f32x4 w[4][2];
#pragma unroll
            for (int k = 0; k < 4; ++k) { w[k][0] = *(const GAS f32x4*)(cw + k * 3072); w[k][1] = *(const GAS f32x4*)(cw + k * 3072 + 4); }
            f32x4 o[4][2];
#pragma unroll
            for (int tok = 0; tok < 4; ++tok) { o[tok][0] = (f32x4){0.f, 0.f, 0.f, 0.f}; o[tok][1] = o[tok][0]; }
#pragma unroll
            for (int i = 0; i < 7; ++i) {
                const f32x4 x0 = bfx4lo(raw[p][i].x, raw[p][i].y), x1 = bfx4lo(raw[p][i].z, raw[p][i].w);
#pragma unroll
                for (int tok = 0; tok < 4; ++tok) { const int k = i - tok; if (k >= 0 && k < 4) { o[tok][0] += x0 * w[k][0]; o[tok][1] += x1 * w[k][1]; } }
            }
#pragma unroll
            for (int tok = 0; tok < 4; ++tok) {
                float ss = 0.f;
#pragma unroll
                for (int e = 0; e < 4; ++e) { float x = o[tok][0][e]; x = x * sigmoidf_(x); o[tok][0][e] = x; ss += x * x; float y = o[tok][1][e]; y = y * sigmoidf_(y); o[tok][1][e] = y; ss += y * y; }
                if (p < 2) {
                    ss += __shfl_xor(ss, 1); ss += __shfl_xor(ss, 2); ss += __shfl_xor(ss, 4); ss += __shfl_xor(ss, 8);
                    const float rn = rsqrtf(ss + 1e-6f) * (p == 0 ? 0.08838834764831845f : 1.0f);
                    o[tok][0] = o[tok][0] * rn; o[tok][1] = o[tok][1] * rn;
                    v4u pk; pk.x = cvtpk(o[tok][0][0], o[tok][0][1]); pk.y = cvtpk(o[tok][0][2], o[tok][0][3]); pk.z = cvtpk(o[tok][1][0], o[tok][1][1]); pk.w = cvtpk(o[tok][1][2], o[tok][1][3]);
                    *(LAS v4u*)(L + (p == 0 ? TH_QB : TH_KB) + (4 * tg + tok) * 272 + cg * 16) = pk;
                }
            }
            if (p == 2) {
#pragma unroll
                for (int e = 0; e < 8; ++e) {
                    const int v = 8 * cg + e;
                    const unsigned lo = cvtpk(o[0][e >> 2][e & 3], o[1][e >> 2][e & 3]), hi = cvtpk(o[2][e >> 2][e & 3], o[3][e >> 2][e & 3]);
                    *(GAS unsigned long long*)((bf16*)(ws + WS_UTB) + (t0 + (v >> 1)) * 1024 + h * 128 + (v & 1) * 64 + 4 * tg) = (unsigned long long)lo | ((unsigned long long)hi << 32);
                }
            }
        }
        ISTAMP(grp == 0 && pp == 1, 75);
        if (w4 == 0) {
            const float av = abv[0], bv = abv[1];
            const float Aneg = -__expf(a->in[11][h]), dtb = a->in[12][h];
            const float beta = sigmoidf_(bv);
            const float spi = av + dtb; const float sp = (spi > 15.f) ? spi : log1pf(__expf(spi));
            float gc = Aneg * sp;
#pragma unroll
            for (int o = 1; o < 64; o <<= 1) { const float t = __shfl_up(gc, o); if (lane >= o) gc += t; }
            const float glast = __shfl(gc, 63);
            TB[lane] = beta; TB[64 + lane] = gc;
            float* scl = (float*)(ws + WS_SCL) + ((size_t)chunkg * 8 + h) * 192;
            scl[lane] = __expf(gc); scl[64 + lane] = __expf(glast - gc); scl[128 + lane] = beta;
        }
        LDS_BARRIER();
        {
            int lane_o = lane; asm volatile("" : "+v"(lane_o));
            const int fr = lane_o & 15, fq = lane_o >> 4;
            f32x4 kk[4], qq[4];
#pragma unroll
            for (int nt = 0; nt < 4; ++nt) { kk[nt] = (f32x4){0.f, 0.f, 0.f, 0.f}; qq[nt] = kk[nt]; }
#pragma unroll
            for (int ks = 0; ks < 4; ++ks) {
                const bf16x8 ak = *(const LAS bf16x8*)(L + TH_KB + (16 * w4 + fr) * 272 + ks * 64 + fq * 16);
                const bf16x8 aq = *(const LAS bf16x8*)(L + TH_QB + (16 * w4 + fr) * 272 + ks * 64 + fq * 16);
#pragma unroll
                for (int nt = 0; nt < 4; ++nt) {
                    const bf16x8 bk = *(const LAS bf16x8*)(L + TH_KB + (16 * nt + fr) * 272 + ks * 64 + fq * 16);
                    kk[nt] = __builtin_amdgcn_mfma_f32_16x16x32_bf16(ak, bk, kk[nt], 0, 0, 0);
                    qq[nt] = __builtin_amdgcn_mfma_f32_16x16x32_bf16(aq, bk, qq[nt], 0, 0, 0);
                }
            }
            LAS float* slot = (LAS float*)(L0 + TS_SLOT0 + (2 * pp + half) * TS_SLOTB);
#pragma unroll
            for (int j = 0; j < 4; ++j) {
                const int i = 16 * w4 + 4 * fq + j; const float gi = TB[64 + i], bi = TB[i];
                const int ro = tri_off_rt(i), rl = (i + 3) & ~3;
#pragma unroll
                for (int nt = 0; nt < 4; ++nt) {
                    const int jj = 16 * nt + fr; const float d = __expf(fminf(gi - TB[64 + jj], 0.f));
                    if (jj < rl) slot[ro + jj] = (i > jj) ? bi * kk[nt][j] * d : 0.f;
                    ((LAS bf16*)(L + TH_QKT))[i * 64 + jj] = (bf16)f2bf((i >= jj) ? qq[nt][j] * d : 0.f);
                }
            }
        }
        ISTAMP(grp == 0 && pp == 1, 76);
        if (pp < 3 || grp + 1 < ngrp) DP_LOAD(pp + 1, 0, 2);
        LDS_BARRIER();
        {
            int t8c = t8; asm volatile("" : "+v"(t8c));
            bf16* qd = (bf16*)(ws + WS_QKV) + t0 * 3072 + h * 128;
#pragma unroll
            for (int i = 0; i < 4; ++i) { const int ch = t8c + 256 * i, row = ch >> 4, cc = ch & 15;
                *(GAS v4u*)(qd + (size_t)row * 3072 + cc * 8) = *(const LAS v4u*)(L + TH_QB + row * 272 + cc * 16);
                *(GAS v4u*)(qd + 1024 + (size_t)row * 3072 + cc * 8) = *(const LAS v4u*)(L + TH_KB + row * 272 + cc * 16); }
            bf16* qkd = QT + t0 * QT_STRIDE + h * 128;
#pragma unroll
            for (int i = 0; i < 2; ++i) { const int ch = t8c + 256 * i, row = ch >> 3, cc = ch & 7; *(GAS v4u*)(qkd + (size_t)row * QT_STRIDE + cc * 8) = *(const LAS v4u*)(L + TH_QKT + row * 128 + cc * 16); }
            bf16* kd = (bf16*)(ws + WS_QKV) + t0 * 3072 + 2048 + h * 128;
            LAS const bf16* kb = (LAS const bf16*)(L + TH_KB);
#pragma unroll
            for (int i = 0; i < 4; ++i) {
                const int ch = t8c + 256 * i, k = ch >> 3, cgp = ch & 7;
                unsigned short e[8];
#pragma unroll
                for (int j = 0; j < 8; ++j) e[j] = kb[(8 * cgp + j) * 136 + k];
                v4u pk; pk.x = e[0] | ((unsigned)e[1] << 16); pk.y = e[2] | ((unsigned)e[3] << 16); pk.z = e[4] | ((unsigned)e[5] << 16); pk.w = e[6] | ((unsigned)e[7] << 16);
                *(GAS v4u*)(kd + (size_t)(k >> 1) * 3072 + (k & 1) * 64 + cgp * 8) = pk;
            }
        }
    }
#undef DP_LOAD
    ISTAMP(grp == 0, 71);
    LDS_BARRIER();
    {
        const int pp = w8 >> 1, hh = w8 & 1;
        int pair = (int)((blockIdx.x + 7u * (unsigned)(grp * 4 + pp)) % (unsigned)F.G) + (grp * 4 + pp) * F.G; pair = pair < 2048 ? pair : 2047;
        const int item = 2 * pair + hh, c = item & 31, h = (item >> 5) & 7, b = item >> 8;
        const size_t t0 = (size_t)b * 2048 + (size_t)c * 64;
        LAS const float* A = (LAS const float*)(L0 + TS_SLOT0 + w8 * TS_SLOTB);
        f32x4 xv[16];
        int lane_s = lane; asm volatile("" : "+v"(lane_s));
#pragma unroll
        for (int g = 0; g < 16; ++g) xv[g] = (f32x4){(4 * g == lane_s) ? 1.f : 0.f, (4 * g + 1 == lane_s) ? 1.f : 0.f, (4 * g + 2 == lane_s) ? 1.f : 0.f, (4 * g + 3 == lane_s) ? 1.f : 0.f};
#pragma unroll
        for (int lbr = 0; lbr < 16; ++lbr) {
            const int lb = 15 - lbr, l0 = 4 * lb;
            {
                const f32x4 a1 = *(LAS const f32x4*)(A + tri_off(l0 + 1) + l0), a2 = *(LAS const f32x4*)(A + tri_off(l0 + 2) + l0), a3 = *(LAS const f32x4*)(A + tri_off(l0 + 3) + l0);
                f32x4 t = xv[lb];
                t[2] -= t[3] * a3[2];
                t[1] -= t[3] * a3[1] + t[2] * a2[1];
                t[0] -= (t[3] * a3[0] + t[2] * a2[0]) + t[1] * a1[0];
                xv[lb] = t;
            }
            const float x0 = xv[lb][0], x1 = xv[lb][1], x2 = xv[lb][2], x3 = xv[lb][3];
#pragma unroll
            for (int ig = 0; ig < lb; ig += 4) {
                f32x4 av[4][4];
#pragma unroll
                for (int g2 = 0; g2 < 4; ++g2) if (ig + g2 < lb) {
#pragma unroll
                    for (int q = 0; q < 4; ++q) av[g2][q] = *(LAS const f32x4*)(A + tri_off(l0 + q) + 4 * (ig + g2));
                }
                __builtin_amdgcn_sched_barrier(0);
#pragma unroll
                for (int g2 = 0; g2 < 4; ++g2) if (ig + g2 < lb) xv[ig + g2] = xv[ig + g2] - ((av[g2][0] * x0 + av[g2][1] * x1) + (av[g2][2] * x2 + av[g2][3] * x3));
                __builtin_amdgcn_sched_barrier(0);
            }
        }
        float x[64];
#pragma unroll
        for (int i = 0; i < 64; ++i) x[i] = xv[i >> 2][i & 3];
        bf16* td = QT + (t0 + lane) * QT_STRIDE + h * 128 + 64;
#pragma unroll
        for (int g = 0; g < 8; ++g) { v4u pk; pk.x = cvtpk(x[8 * g], x[8 * g + 1]); pk.y = cvtpk(x[8 * g + 2], x[8 * g + 3]); pk.z = cvtpk(x[8 * g + 4], x[8 * g + 5]); pk.w = cvtpk(x[8 * g + 6], x[8 * g + 7]); *(GAS v4u*)(td + 8 * g) = pk; }
    }
    ISTAMP(grp == 0, 72); ISTAMP(grp == 1, 78);
#if defined(PROF_A) && defined(PROF_FIN2)
    if (grp == 1 && threadIdx.x == 0) ((unsigned long long*)(a->ws + WS_CTL + 2048))[256 + blockIdx.x] = __builtin_amdgcn_s_memrealtime();
#endif
    }
}

constexpr int TL_Q = 0, TL_K = 17408, TL_KT = 34816, TL_QT = 53248, TL_SC = 70656, TL_OT = 71680;
__device__ __forceinline__ void dscan_item_t(Frame& F, cargs_t a, int item) {
    unsigned char* ws = a->ws;
    int tid_ = threadIdx.x; asm volatile("" : "+v"(tid_));
    const int tid = tid_, lane = tid & 63, w = F.wave, fr = lane & 15, fq = lane >> 4;
    const int b = item >> 3, h = item & 7;
    const size_t tb = (size_t)b * 2048;
    LAS unsigned char* L = F.lds + RING_OFF;
    const bf16* QKV = (const bf16*)(ws + WS_QKV); const bf16* QT = (const bf16*)(a->out + O_Y); const bf16* VTB = (const bf16*)(ws + WS_UTB);
    const bf16* Zb = (const bf16*)(ws + WS_Z); const float* SCL = (const float*)(ws + WS_SCL);
    bf16* OGp = (bf16*)(ws + WS_OG);
    f32x4 S[8];
#pragma unroll
    for (int st = 0; st < 8; ++st) S[st] = (f32x4){0.f, 0.f, 0.f, 0.f};
    const int r0 = tid >> 4, c0 = tid & 15;
    const int grow = tid >> 3, gcg = tid & 7;
    v4u pq[2], pw[2], pk[2], pt[2], psc, pz[2]; unsigned long long pvt[4];
    const float* og_gain = a->in[13] + 16 * gcg;
#define DT_ROW(cn, i_) (QKV + (tb + (size_t)(cn) * 64 + r0 + 32 * (i_)) * 3072 + h * 128 + c0 * 8)
#define DT_L(n, cn, cz) do { \
        if ((n) == 0) pq[0] = *(const GAS v4u*)DT_ROW(cn, 0); else if ((n) == 1) pw[0] = *(const GAS v4u*)(DT_ROW(cn, 0) + 1024); else if ((n) == 2) pk[0] = *(const GAS v4u*)(DT_ROW(cn, 0) + 2048); \
        else if ((n) == 3) pt[0] = *(const GAS v4u*)(QT + (tb + (size_t)(cn) * 64 + r0) * QT_STRIDE + h * 128 + c0 * 8); \
        else if ((n) == 4) pq[1] = *(const GAS v4u*)DT_ROW(cn, 1); else if ((n) == 5) pw[1] = *(const GAS v4u*)(DT_ROW(cn, 1) + 1024); else if ((n) == 6) pk[1] = *(const GAS v4u*)(DT_ROW(cn, 1) + 2048); \
        else if ((n) == 7) pt[1] = *(const GAS v4u*)(QT + (tb + (size_t)(cn) * 64 + r0 + 32) * QT_STRIDE + h * 128 + c0 * 8); \
        else if ((n) == 8) { if (tid < 48) psc = *(const GAS v4u*)(SCL + ((size_t)(b * 32 + (cn)) * 8 + h) * 192 + tid * 4); } \
        else if ((n) < 13) { const int v_ = 16 * w + fr; pvt[(n) - 9] = *(const GAS unsigned long long*)(VTB + (tb + (size_t)(cn) * 64 + (v_ >> 1)) * 1024 + h * 128 + (v_ & 1) * 64 + 4 * fq + 16 * ((n) - 9)); } \
        else pz[(n) - 13] = *(const GAS v4u*)(Zb + (tb + (size_t)(cz) * 64 + grow) * 1024 + h * 128 + gcg * 16 + ((n) - 13) * 8); } while (0)
#pragma unroll
    for (int n = 0; n < 13; ++n) DT_L(n, 0, 0);
    __syncthreads();
#pragma unroll 1
    for (int ci = 0; ci <= 32; ++ci) {
        LDS_BARRIER();
        ISTAMP(ci == 16, 60); ISTAMP(ci == 17, 69);
        f32x4 vt[4];
        if (ci < 32) {
#pragma unroll
            for (int i = 0; i < 2; ++i) {
                *(LAS v4u*)(L + TL_Q + (r0 + 32 * i) * 272 + c0 * 16) = pq[i];
                *(LAS v4u*)(L + TL_K + (r0 + 32 * i) * 272 + c0 * 16) = pw[i];
                { const int kr = 2 * (r0 + 32 * i) + (c0 >> 3); *(LAS v4u*)(L + TL_KT + kr * 144 + (c0 & 7) * 16) = pk[i]; }
                *(LAS v4u*)(L + TL_QT + (r0 + 32 * i) * 272 + c0 * 16) = pt[i];
            }
            if (tid < 48) *(LAS v4u*)(L + TL_SC + tid * 16) = psc;
#pragma unroll
            for (int mt = 0; mt < 4; ++mt) vt[mt] = bfx4lo((unsigned)pvt[mt], (unsigned)(pvt[mt] >> 32));
        }
        ISTAMP(ci == 16, 61);
        if (ci > 0) {
            const v4u o0 = *(const LAS v4u*)(L + TL_OT + grow * 272 + gcg * 32), o1 = *(const LAS v4u*)(L + TL_OT + grow * 272 + gcg * 32 + 16);
            f32x4 ov[4] = {bfx4lo(o0.x, o0.y), bfx4lo(o0.z, o0.w), bfx4lo(o1.x, o1.y), bfx4lo(o1.z, o1.w)};
            float ss = (dot4s(ov[0]) + dot4s(ov[1])) + (dot4s(ov[2]) + dot4s(ov[3]));
            ss += __shfl_xor(ss, 1); ss += __shfl_xor(ss, 2); ss += __shfl_xor(ss, 4);
            const float rn = rsqrtf(ss * (1.0f / 128.0f) + 1e-6f);
            const f32x4 zv[4] = {bfx4lo(pz[0].x, pz[0].y), bfx4lo(pz[0].z, pz[0].w), bfx4lo(pz[1].x, pz[1].y), bfx4lo(pz[1].z, pz[1].w)};
            unsigned pkd[8];
#pragma unroll
            for (int q4 = 0; q4 < 4; ++q4) {
                const f32x4 gn = *(const GAS f32x4*)(og_gain + 4 * q4); f32x4 r;
#pragma unroll
                for (int e = 0; e < 4; ++e) { const float z = zv[q4][e]; r[e] = ov[q4][e] * rn * gn[e] * (z * sigmoidf_(z)); }
                pkd[2 * q4] = cvtpk(r[0], r[1]); pkd[2 * q4 + 1] = cvtpk(r[2], r[3]);
            }
            bf16* op = OGp + (tb + (size_t)(ci - 1) * 64 + grow) * 1024 + h * 128 + gcg * 16;
            *(GAS v4u*)op = (v4u){pkd[0], pkd[1], pkd[2], pkd[3]}; *(GAS v4u*)(op + 8) = (v4u){pkd[4], pkd[5], pkd[6], pkd[7]};
        }
        if (ci == 32) break;
        ISTAMP(ci == 16, 62);
        const int cn = (ci + 1 < 32) ? ci + 1 : 31;
        ISTAMP(ci == 16, 63);
        LDS_BARRIER();
        ISTAMP(ci == 16, 64);
        f32x4 o[4], u[4];
        lcp kb_ = (lcp)(L + TL_K + fr * 272 + fq * 8), qb_ = (lcp)(L + TL_Q + fr * 272 + fq * 8);
        lcp tq_ = (lcp)(L + TL_QT + fr * 272 + fq * 8), kt_ = (lcp)(L + TL_KT + fr * 144 + fq * 8);
        bf16x8 fA[4];
#define DS_SB() __builtin_amdgcn_sched_barrier(0)
#define MF_HI() __builtin_amdgcn_s_setprio(1)
#define MF_LO() __builtin_amdgcn_s_setprio(0)
#pragma unroll
        for (int mt = 0; mt < 4; ++mt) { o[mt] = (f32x4){0.f, 0.f, 0.f, 0.f}; u[mt] = (f32x4){0.f, 0.f, 0.f, 0.f}; }
#pragma unroll
        for (int ks = 0; ks < 4; ++ks) {
            const bf16x8 sbk = packB(S[2 * ks], S[2 * ks + 1]);
#pragma unroll
            for (int mt = 0; mt < 4; ++mt) fA[mt] = frag2(kb_ + mt * 16 * 272 + ks * 64);
            DS_SB();
            MF_HI();
#pragma unroll
            for (int mt = 0; mt < 4; ++mt) u[mt] = __builtin_amdgcn_mfma_f32_16x16x32_bf16(fA[mt], sbk, u[mt], 0, 0, 0);
            MF_LO();
            DT_L(2 * ks, cn, ci);
            DS_SB();
#pragma unroll
            for (int mt = 0; mt < 4; ++mt) fA[mt] = frag2(qb_ + mt * 16 * 272 + ks * 64);
            DS_SB();
            MF_HI();
#pragma unroll
            for (int mt = 0; mt < 4; ++mt) o[mt] = __builtin_amdgcn_mfma_f32_16x16x32_bf16(fA[mt], sbk, o[mt], 0, 0, 0);
            MF_LO();
            DT_L(2 * ks + 1, cn, ci);
            DS_SB();
        }
        ISTAMP(ci == 16, 65);
        LAS const float* sc = (LAS const float*)(L + TL_SC);
        const float gl = sc[63];
        bf16x8 rb[2];
        {
            f32x4 r[4];
#pragma unroll
            for (int mt = 0; mt < 4; ++mt) { const f32x4 eg = *(LAS const f32x4*)(sc + 16 * mt + 4 * fq), be = *(LAS const f32x4*)(sc + 128 + 16 * mt + 4 * fq); r[mt] = be * (vt[mt] - eg * u[mt]); o[mt] = o[mt] * eg; }
            rb[0] = packB(r[0], r[1]); rb[1] = packB(r[2], r[3]);
        }
#pragma unroll
        for (int m2 = 0; m2 < 2; ++m2) {
#pragma unroll
            for (int mt = 0; mt < 2; ++mt) { fA[2 * mt] = frag2(tq_ + (2 * m2 + mt) * 16 * 272 + 128); fA[2 * mt + 1] = frag2(tq_ + (2 * m2 + mt) * 16 * 272 + 128 + 64); }
            DS_SB();
#pragma unroll
            for (int mt = 0; mt < 2; ++mt) {
                u[2 * m2 + mt] = __builtin_amdgcn_mfma_f32_16x16x32_bf16(fA[2 * mt], rb[0], (f32x4){0.f, 0.f, 0.f, 0.f}, 0, 0, 0);
                u[2 * m2 + mt] = __builtin_amdgcn_mfma_f32_16x16x32_bf16(fA[2 * mt + 1], rb[1], u[2 * m2 + mt], 0, 0, 0);
            }
            if (m2 == 0) DT_L(8, cn, ci); else { DT_L(9, cn, ci); DT_L(10, cn, ci); }
            DS_SB();
        }
        ISTAMP(ci == 16, 66);
        bf16x8 ub[2], ub2[2];
        {
            ub[0] = packB(u[0], u[1]); ub[1] = packB(u[2], u[3]);
#pragma unroll
            for (int mt = 0; mt < 4; ++mt) { const f32x4 ek = *(LAS const f32x4*)(sc + 64 + 16 * mt + 4 * fq); u[mt] = u[mt] * ek; }
            ub2[0] = packB(u[0], u[1]); ub2[1] = packB(u[2], u[3]);
        }
#pragma unroll
        for (int st = 0; st < 8; ++st) S[st] = S[st] * gl;
        DS_SB();
#pragma unroll
        for (int m2 = 0; m2 < 2; ++m2) {
#pragma unroll
            for (int mt = 0; mt < 2; ++mt) { fA[2 * mt] = frag2(tq_ + (2 * m2 + mt) * 16 * 272); fA[2 * mt + 1] = frag2(tq_ + (2 * m2 + mt) * 16 * 272 + 64); }
            DS_SB();
#pragma unroll
            for (int mt = 0; mt < 2; ++mt)
#pragma unroll
                for (int ks = 0; ks < 2; ++ks) o[2 * m2 + mt] = __builtin_amdgcn_mfma_f32_16x16x32_bf16(fA[2 * mt + ks], ub[ks], o[2 * m2 + mt], 0, 0, 0);
            if (m2 == 0) { DT_L(11, cn, ci); DT_L(12, cn, ci); } else DT_L(13, cn, ci);
            DS_SB();
        }
#pragma unroll
        for (int s2 = 0; s2 < 4; ++s2) {
#pragma unroll
            for (int st = 0; st < 2; ++st) { fA[2 * st] = frag2(kt_ + (2 * s2 + st) * 16 * 144); fA[2 * st + 1] = frag2(kt_ + (2 * s2 + st) * 16 * 144 + 64); }
            DS_SB();
#pragma unroll
            for (int st = 0; st < 2; ++st)
#pragma unroll
                for (int ks = 0; ks < 2; ++ks) S[2 * s2 + st] = __builtin_amdgcn_mfma_f32_16x16x32_bf16(fA[2 * st + ks], ub2[ks], S[2 * s2 + st], 0, 0, 0);
            if (s2 == 0) DT_L(14, cn, ci);
            DS_SB();
        }
#undef DS_SB
#undef MF_HI
#undef MF_LO
        ISTAMP(ci == 16, 67);
        LAS bf16* ot = (LAS bf16*)(L + TL_OT) + 16 * w + fr;
#pragma unroll
        for (int mt = 0; mt < 4; ++mt)
#pragma unroll
            for (int j = 0; j < 4; ++j) ot[(16 * mt + 4 * fq + j) * 136] = (bf16)f2bf(o[mt][j]);
    }
#undef DT_L
#undef DT_ROW
    float* so = a->out + O_SDP + ((size_t)(b * 8 + h) * 128) * 128 + 16 * w + fr;
#pragma unroll
    for (int st = 0; st < 8; ++st)
#pragma unroll
        for (int j = 0; j < 4; ++j) so[(size_t)(16 * st + 4 * fq + j) * 128] = S[st][j];
}
constexpr int DB_Q = 0, DB_K = 16384, DB_KT = 32768, DB_QT = 49152, DB_SC = 65536, DB_SIZE = 66560, DL_OT = 2 * DB_SIZE;
__device__ __forceinline__ bf16x8 frag2s(LAS const unsigned char* base, int off0, int off1) {
    const bf16x4 lo = *(LAS const bf16x4*)(base + off0), hi = *(LAS const bf16x4*)(base + off1);
    return (bf16x8){lo[0], lo[1], lo[2], lo[3], hi[0], hi[1], hi[2], hi[3]};
}
__device__ __forceinline__ void dscan_item_t2(Frame& F, cargs_t a, int item) {
    unsigned char* ws = a->ws;
    int tid_ = threadIdx.x; asm volatile("" : "+v"(tid_));
    const int tid = tid_, lane = tid & 63, w = F.wave, fr = lane & 15, fq = lane >> 4;
    const int b = item >> 3, h = item & 7;
    const size_t tb = (size_t)b * 2048;
    LAS unsigned char* L = F.lds + RING_OFF;
    const bf16* QKV = (const bf16*)(ws + WS_QKV); const bf16* QT = (const bf16*)(a->out + O_Y); const bf16* VTB = (const bf16*)(ws + WS_UTB);
    const bf16* Zb = (const bf16*)(ws + WS_Z); const float* SCL = (const float*)(ws + WS_SCL);
    bf16* OGp = (bf16*)(ws + WS_OG);
    f32x4 S[8];
#pragma unroll
    for (int st = 0; st < 8; ++st) S[st] = (f32x4){0.f, 0.f, 0.f, 0.f};
    const int grow = tid >> 3, gcg = tid & 7;
    v4u pz[2]; unsigned long long pvt[4];
    const float* og_gain = a->in[13] + 16 * gcg;
    int offA[4][2], offT[2][2];
#pragma unroll
    for (int ks = 0; ks < 4; ++ks)
#pragma unroll
        for (int hf = 0; hf < 2; ++hf) offA[ks][hf] = fr * 256 + ((((4 * ks + (fq >> 1) + 2 * hf) ^ fr) & 15) << 4) + 8 * (fq & 1);
#pragma unroll
    for (int ks = 0; ks < 2; ++ks)
#pragma unroll
        for (int hf = 0; hf < 2; ++hf) offT[ks][hf] = fr * 128 + ((((4 * ks + (fq >> 1) + 2 * hf) ^ (fr >> 1)) & 7) << 4) + 8 * (fq & 1);
#define DM_ISSUE(ci, bufo) do { const size_t t0_ = tb + (size_t)(ci) * 64; \
        _Pragma("unroll") for (int i_ = 0; i_ < 2; ++i_) { const int n_ = 2 * w + i_; \
            const int row_ = 4 * n_ + (lane >> 4), ls_ = (lane & 15) ^ (row_ & 15); \
            const bf16* rp_ = QKV + (t0_ + row_) * 3072 + h * 128 + ls_ * 8; \
            __builtin_amdgcn_global_load_lds((const GAS unsigned*)rp_, (LAS unsigned*)(L + (bufo) + DB_Q + n_ * 1024), 16, 0, 0); \
            __builtin_amdgcn_global_load_lds((const GAS unsigned*)(rp_ + 1024), (LAS unsigned*)(L + (bufo) + DB_K + n_ * 1024), 16, 0, 0); \
            __builtin_amdgcn_global_load_lds((const GAS unsigned*)(QT + (t0_ + row_) * QT_STRIDE + h * 128 + ls_ * 8), (LAS unsigned*)(L + (bufo) + DB_QT + n_ * 1024), 16, 0, 0); \
            const int kr_ = 8 * n_ + (lane >> 3), kls_ = (lane & 7) ^ ((kr_ >> 1) & 7); \
            __builtin_amdgcn_global_load_lds((const GAS unsigned*)(QKV + (t0_ + (kr_ >> 1)) * 3072 + 2048 + h * 128 + (kr_ & 1) * 64 + kls_ * 8), (LAS unsigned*)(L + (bufo) + DB_KT + n_ * 1024), 16, 0, 0); } \
        if (w == 0) __builtin_amdgcn_global_load_lds((const GAS unsigned*)(SCL + ((size_t)(b * 32 + (ci)) * 8 + h) * 192 + (lane < 48 ? lane : 47) * 4), (LAS unsigned*)(L + (bufo) + DB_SC), 16, 0, 0); } while (0)
#define DM_VT(ci) do { const size_t t0_ = tb + (size_t)(ci) * 64; const int v_ = 16 * w + fr; const bf16* up = VTB + (t0_ + (v_ >> 1)) * 1024 + h * 128 + (v_ & 1) * 64 + 4 * fq; \
        _Pragma("unroll") for (int mt_ = 0; mt_ < 4; ++mt_) pvt[mt_] = *(const GAS unsigned long long*)(up + 16 * mt_); } while (0)
    __syncthreads();
    DM_ISSUE(0, 0);
    DM_VT(0);
#pragma unroll 1
    for (int ci = 0; ci <= 32; ++ci) {
        const int bufo = (ci & 1) * DB_SIZE;
        asm volatile("s_waitcnt vmcnt(0)" ::: "memory");
        LDS_BARRIER();
        if (ci + 1 < 32) DM_ISSUE(ci + 1, DB_SIZE - bufo);
        f32x4 vt[4];
#pragma unroll
        for (int mt = 0; mt < 4; ++mt) vt[mt] = bfx4lo((unsigned)pvt[mt], (unsigned)(pvt[mt] >> 32));
        if (ci > 0) {
            const v4u o0 = *(const LAS v4u*)(L + DL_OT + grow * 272 + gcg * 32), o1 = *(const LAS v4u*)(L + DL_OT + grow * 272 + gcg * 32 + 16);
            f32x4 ov[4] = {bfx4lo(o0.x, o0.y), bfx4lo(o0.z, o0.w), bfx4lo(o1.x, o1.y), bfx4lo(o1.z, o1.w)};
            float ss = (dot4s(ov[0]) + dot4s(ov[1])) + (dot4s(ov[2]) + dot4s(ov[3]));
            ss += __shfl_xor(ss, 1); ss += __shfl_xor(ss, 2); ss += __shfl_xor(ss, 4);
            const float rn = rsqrtf(ss * (1.0f / 128.0f) + 1e-6f);
            const f32x4 zv[4] = {bfx4lo(pz[0].x, pz[0].y), bfx4lo(pz[0].z, pz[0].w), bfx4lo(pz[1].x, pz[1].y), bfx4lo(pz[1].z, pz[1].w)};
            unsigned pkd[8];
#pragma unroll
            for (int q4 = 0; q4 < 4; ++q4) {
                const f32x4 gn = *(const GAS f32x4*)(og_gain + 4 * q4); f32x4 r;
#pragma unroll
                for (int e = 0; e < 4; ++e) { const float z = zv[q4][e]; r[e] = ov[q4][e] * rn * gn[e] * (z * sigmoidf_(z)); }
                pkd[2 * q4] = cvtpk(r[0], r[1]); pkd[2 * q4 + 1] = cvtpk(r[2], r[3]);
            }
            bf16* op = OGp + (tb + (size_t)(ci - 1) * 64 + grow) * 1024 + h * 128 + gcg * 16;
            *(GAS v4u*)op = (v4u){pkd[0], pkd[1], pkd[2], pkd[3]}; *(GAS v4u*)(op + 8) = (v4u){pkd[4], pkd[5], pkd[6], pkd[7]};
        }
        if (ci == 32) break;
#pragma unroll
        for (int i = 0; i < 2; ++i) pz[i] = *(const GAS v4u*)(Zb + (tb + (size_t)ci * 64 + grow) * 1024 + h * 128 + gcg * 16 + i * 8);
        if (ci + 1 < 32) DM_VT(ci + 1);
        LDS_BARRIER();
        f32x4 o[4], u[4];
        LAS const unsigned char* Bq = L + bufo + DB_Q; LAS const unsigned char* Bk = L + bufo + DB_K; LAS const unsigned char* Bt = L + bufo + DB_QT; LAS const unsigned char* Bkt = L + bufo + DB_KT;
        bf16x8 fA[4];
#define DS_SB() __builtin_amdgcn_sched_barrier(0)
#pragma unroll
        for (int mt = 0; mt < 4; ++mt) { o[mt] = (f32x4){0.f, 0.f, 0.f, 0.f}; u[mt] = (f32x4){0.f, 0.f, 0.f, 0.f}; }
#pragma unroll
        for (int ks = 0; ks < 4; ++ks) {
            const bf16x8 sbk = packB(S[2 * ks], S[2 * ks + 1]);
#pragma unroll
            for (int mt = 0; mt < 4; ++mt) fA[mt] = frag2s(Bk + mt * 4096, offA[ks][0], offA[ks][1]);
            DS_SB();
#pragma unroll
            for (int mt = 0; mt < 4; ++mt) u[mt] = __builtin_amdgcn_mfma_f32_16x16x32_bf16(fA[mt], sbk, u[mt], 0, 0, 0);
            DS_SB();
#pragma unroll
            for (int mt = 0; mt < 4; ++mt) fA[mt] = frag2s(Bq + mt * 4096, offA[ks][0], offA[ks][1]);
            DS_SB();
#pragma unroll
            for (int mt = 0; mt < 4; ++mt) o[mt] = __builtin_amdgcn_mfma_f32_16x16x32_bf16(fA[mt], sbk, o[mt], 0, 0, 0);
            DS_SB();
        }
        LAS const float* sc = (LAS const float*)(L + bufo + DB_SC);
        const float gl = sc[63];
        bf16x8 rb[2];
        {
            f32x4 r[4];
#pragma unroll
            for (int mt = 0; mt < 4; ++mt) { const f32x4 eg = *(LAS const f32x4*)(sc + 16 * mt + 4 * fq), be = *(LAS const f32x4*)(sc + 128 + 16 * mt + 4 * fq); r[mt] = be * (vt[mt] - eg * u[mt]); o[mt] = o[mt] * eg; }
            rb[0] = packB(r[0], r[1]); rb[1] = packB(r[2], r[3]);
        }
#pragma unroll
        for (int m2 = 0; m2 < 2; ++m2) {
#pragma unroll
            for (int mt = 0; mt < 2; ++mt) { fA[2 * mt] = frag2s(Bt + (2 * m2 + mt) * 4096, offA[2][0], offA[2][1]); fA[2 * mt + 1] = frag2s(Bt + (2 * m2 + mt) * 4096, offA[3][0], offA[3][1]); }
            DS_SB();
#pragma unroll
            for (int mt = 0; mt < 2; ++mt) {
                u[2 * m2 + mt] = __builtin_amdgcn_mfma_f32_16x16x32_bf16(fA[2 * mt], rb[0], (f32x4){0.f, 0.f, 0.f, 0.f}, 0, 0, 0);
                u[2 * m2 + mt] = __builtin_amdgcn_mfma_f32_16x16x32_bf16(fA[2 * mt + 1], rb[1], u[2 * m2 + mt], 0, 0, 0);
            }
            DS_SB();
        }
        bf16x8 ub[2], ub2[2];
        {
            ub[0] = packB(u[0], u[1]); ub[1] = packB(u[2], u[3]);
#pragma unroll
            for (int mt = 0; mt < 4; ++mt) { const f32x4 ek = *(LAS const f32x4*)(sc + 64 + 16 * mt + 4 * fq); u[mt] = u[mt] * ek; }
            ub2[0] = packB(u[0], u[1]); ub2[1] = packB(u[2], u[3]);
        }
#pragma unroll
        for (int st = 0; st < 8; ++st) S[st] = S[st] * gl;
        DS_SB();
#pragma unroll
        for (int m2 = 0; m2 < 2; ++m2) {
#pragma unroll
            for (int mt = 0; mt < 2; ++mt) { fA[2 * mt] = frag2s(Bt + (2 * m2 + mt) * 4096, offA[0][0], offA[0][1]); fA[2 * mt + 1] = frag2s(Bt + (2 * m2 + mt) * 4096, offA[1][0], offA[1][1]); }
            DS_SB();
#pragma unroll
            for (int mt = 0; mt < 2; ++mt)
#pragma unroll
                for (int ks = 0; ks < 2; ++ks) o[2 * m2 + mt] = __builtin_amdgcn_mfma_f32_16x16x32_bf16(fA[2 * mt + ks], ub[ks], o[2 * m2 + mt], 0, 0, 0);
            DS_SB();
        }
#pragma unroll
        for (int s2 = 0; s2 < 4; ++s2) {
#pragma unroll
            for (int st = 0; st < 2; ++st) { fA[2 * st] = frag2s(Bkt + (2 * s2 + st) * 2048, offT[0][0], offT[0][1]); fA[2 * st + 1] = frag2s(Bkt + (2 * s2 + st) * 2048, offT[1][0], offT[1][1]); }
            DS_SB();
#pragma unroll
            for (int st = 0; st < 2; ++st)
#pragma unroll
                for (int ks = 0; ks < 2; ++ks) S[2 * s2 + st] = __builtin_amdgcn_mfma_f32_16x16x32_bf16(fA[2 * st + ks], ub2[ks], S[2 * s2 + st], 0, 0, 0);
            DS_SB();
        }
#undef DS_SB
        LAS bf16* ot = (LAS bf16*)(L + DL_OT) + 16 * w + fr;
#pragma unroll
        for (int mt = 0; mt < 4; ++mt)
#pragma unroll
            for (int j = 0; j < 4; ++j) ot[(16 * mt + 4 * fq + j) * 136] = (bf16)f2bf(o[mt][j]);
    }
#undef DM_ISSUE
#undef DM_VT
    float* so = a->out + O_SDP + ((size_t)(b * 8 + h) * 128) * 128 + 16 * w + fr;
#pragma unroll
    for (int st = 0; st < 8; ++st)
#pragma unroll
        for (int j = 0; j < 4; ++j) so[(size_t)(16 * st + 4 * fq + j) * 128] = S[st][j];
}
constexpr int AL_K = 0, AL_VT = 36864, AVT_STRIDE = 592;
__device__ __forceinline__ void attn_prompt_items(Frame& F, cargs_t a, int first, int stride, int end) {
    unsigned char* ws = a->ws;
    const int tid = F.tid, w = F.wave, lane = F.lane, fr = lane & 15, fq = lane >> 4;
    LAS unsigned char* L = F.lds + RING_OFF;
    const bf16* KV = (const bf16*)(ws + WS_KV);
    v4u wv[8];
#define AT_LOAD(it_) do { const int qb_ = (it_) & 15, kh_ = ((it_) >> 4) & 3, b_ = (it_) >> 6; \
        _Pragma("unroll") for (int i = 0; i < 8; ++i) { \
            const int key = 4 * (tid >> 4) + (i & 3) + 128 * (i >> 2), c = tid & 15;     \
            const long srow = (long)qb_ * 128 - 128 + key; \
            wv[i] = (v4u){0u, 0u, 0u, 0u}; \
            if (srow >= 0) wv[i] = *(const GAS v4u*)(KV + ((size_t)b_ * 2048 + (size_t)srow) * 512 + (c < 8 ? kh_ * 64 + c * 8 : 256 + kh_ * 64 + (c - 8) * 8)); } } while (0)
    if (first < end) AT_LOAD(first);
#pragma unroll 1
    for (int item = first; item < end; item += stride) {
    const int qblk = item & 15, kvh = (item >> 4) & 3, b = item >> 6;
    ISTAMP(item == first + stride, 80);
    __syncthreads();
    {
        const int c = tid & 15, kq4 = 4 * (tid >> 4);
        if (c < 8) {
#pragma unroll
            for (int i = 0; i < 8; ++i) *(LAS v4u*)(L + AL_K + (kq4 + (i & 3) + 128 * (i >> 2)) * 144 + c * 16) = wv[i];
        } else {
#pragma unroll
            for (int g4 = 0; g4 < 2; ++g4) {
                LAS unsigned char* vb = L + AL_VT + (size_t)((c - 8) * 8) * AVT_STRIDE + (kq4 + 128 * g4) * 2;
#pragma unroll
                for (int e2 = 0; e2 < 4; ++e2) {
                    const unsigned w0 = ((const unsigned*)&wv[4 * g4])[e2], w1 = ((const unsigned*)&wv[4 * g4 + 1])[e2], w2 = ((const unsigned*)&wv[4 * g4 + 2])[e2], w3 = ((const unsigned*)&wv[4 * g4 + 3])[e2];
                    const unsigned long long ev = (unsigned long long)((w0 & 0xffffu) | (w1 << 16)) | ((unsigned long long)((w2 & 0xffffu) | (w3 << 16)) << 32);
                    const unsigned long long od = (unsigned long long)((w0 >> 16) | (w1 & 0xffff0000u)) | ((unsigned long long)((w2 >> 16) | (w3 & 0xffff0000u)) << 32);
                    *(LAS unsigned long long*)(vb + (size_t)(2 * e2) * AVT_STRIDE) = ev; *(LAS unsigned long long*)(vb + (size_t)(2 * e2 + 1) * AVT_STRIDE) = od;
                }
            }
        }
    }
    if (tid < 256) { const int d = tid >> 2, pc = tid & 3; *(LAS v4u*)(L + AL_VT + d * AVT_STRIDE + 512 + pc * 16) = (v4u){0u, 0u, 0u, 0u}; }
    __syncthreads();
    ISTAMP(item == first + stride, 81);
    if (item + stride < end) AT_LOAD(item + stride);
    const int g = w >> 1, head = kvh * 4 + g;
    const float sink = a->in[19][head];
    const bf16* Qb_ = (const bf16*)(ws + WS_Q); bf16* OBp = (bf16*)(ws + WS_OB);
    bf16x8 qc[2];
#pragma unroll
    for (int ks = 0; ks < 2; ++ks) qc[ks] = *(const GAS bf16x8*)(Qb_ + ((size_t)b * 2048 + (size_t)qblk * 128 + (w & 1) * 64 + fr) * 1024 + head * 64 + ks * 32 + fq * 8);
#pragma unroll 2
    for (int qt = 0; qt < 4; ++qt) {
        const int q0 = (w & 1) * 64 + 16 * qt, mt0 = q0 >> 4, qi = q0 + fr;
        const size_t row = (size_t)b * 2048 + (size_t)qblk * 128 + qi;
        const bf16x8 qb[2] = {qc[0], qc[1]};
        if (qt < 3) {
#pragma unroll
            for (int ks = 0; ks < 2; ++ks) qc[ks] = *(const GAS bf16x8*)(Qb_ + (row + 16) * 1024 + head * 64 + ks * 32 + fq * 8);
        }
        f32x4 s[10];
#pragma unroll
        for (int kt = 0; kt < 9; ++kt) {
            s[kt] = (f32x4){0.f, 0.f, 0.f, 0.f};
#pragma unroll
            for (int ks = 0; ks < 2; ++ks) {
                const bf16x8 ka = *(const LAS bf16x8*)(L + AL_K + (16 * (mt0 + kt) + fr) * 144 + ks * 64 + fq * 16);
                s[kt] = __builtin_amdgcn_mfma_f32_16x16x32_bf16(ka, qb[ks], s[kt], 0, 0, 0);
            }
        }
        float m = sink;
#pragma unroll
        for (int kt = 0; kt < 9; ++kt) {
            const bool tok = (qblk > 0) || (mt0 + kt >= 8);
#pragma unroll
            for (int jj = 0; jj < 4; ++jj) {
                const int j = 16 * (mt0 + kt) + 4 * fq + jj;
                const bool ok = tok && (kt == 0 ? (j >= qi + 1) : (kt == 8 ? (j <= qi + 128) : true));
                const float sv = ok ? s[kt][jj] : -1e30f; s[kt][jj] = sv; m = fmaxf(m, sv);
            }
        }
        m = fmaxf(m, __shfl_xor(m, 16)); m = fmaxf(m, __shfl_xor(m, 32));
        float l = 0.f;
#pragma unroll
        for (int kt = 0; kt < 9; ++kt)
#pragma unroll
            for (int jj = 0; jj < 4; ++jj) { const float p = __expf(s[kt][jj] - m); s[kt][jj] = p; l += p; }
        s[9] = (f32x4){0.f, 0.f, 0.f, 0.f};
        l += __shfl_xor(l, 16); l += __shfl_xor(l, 32);
        l += __expf(sink - m);
        f32x4 o[4];
#pragma unroll
        for (int dt = 0; dt < 4; ++dt) o[dt] = (f32x4){0.f, 0.f, 0.f, 0.f};
#pragma unroll
        for (int k5 = 0; k5 < 5; ++k5) {
            const bf16x8 pb = packB(s[2 * k5], s[2 * k5 + 1]);
#pragma unroll
            for (int dt = 0; dt < 4; ++dt)
                o[dt] = __builtin_amdgcn_mfma_f32_16x16x32_bf16(frag2((lcp)(L + AL_VT + (16 * dt + fr) * AVT_STRIDE + (16 * (mt0 + 2 * k5) + 4 * fq) * 2)), pb, o[dt], 0, 0, 0);
        }
        const float inv = 1.0f / l;
        bf16* op = OBp + row * 1024 + head * 64 + 4 * fq;
#pragma unroll
        for (int dt = 0; dt < 4; ++dt) { const f32x4 r = o[dt] * inv; *(GAS unsigned long long*)(op + 16 * dt) = (unsigned long long)cvtpk(r[0], r[1]) | ((unsigned long long)cvtpk(r[2], r[3]) << 32); }
    }
    }
#undef AT_LOAD
}
__device__ __forceinline__ void attn_sample_items(Frame& F, cargs_t a, int first, int stride, int end) {
    unsigned char* ws = a->ws;
    const int tid = F.tid, w = F.wave, lane = F.lane, fr = lane & 15, fq = lane >> 4;
    LAS unsigned char* L = F.lds + RING_OFF;
    const bf16* KV = (const bf16*)(ws + WS_KV);
    f32x4 cv[8];
#define AS_LOAD(it_) do { const int kh_ = (it_) & 3, b_ = (it_) >> 2; \
        _Pragma("unroll") for (int i = 0; i < 8; ++i) { const int idx = tid + 512 * i, key = idx >> 5, c = idx & 31; const int isv = c >> 4, cc = c & 15; \
            cv[i] = *(const GAS f32x4*)(a->in[isv ? 5 : 4] + ((size_t)(b_ * 128 + key) * 4 + kh_) * 64 + cc * 4); } } while (0)
    if (first < end) AS_LOAD(first);
#pragma unroll 1
    for (int item = first; item < end; item += stride) {
        const int kvh = item & 3, b = item >> 2;
        __syncthreads();
#pragma unroll
        for (int i = 0; i < 8; ++i) { const int idx = tid + 512 * i, key = idx >> 5, c = idx & 31; const int isv = c >> 4, cc = c & 15;
            if (key >= 8) *(GAS f32x4*)(a->out + (isv ? O_VWS : O_KWS) + ((size_t)(b * 128 + key - 8) * 4 + kvh) * 64 + cc * 4) = cv[i];
            const unsigned lo = cvtpk(cv[i][0], cv[i][1]), hi = cvtpk(cv[i][2], cv[i][3]);
            if (!isv) *(LAS unsigned long long*)(L + AL_K + key * 144 + cc * 8) = (unsigned long long)lo | ((unsigned long long)hi << 32);
            else { LAS unsigned short* vt = (LAS unsigned short*)(L + AL_VT) + (size_t)(cc * 4) * (AVT_STRIDE / 2) + key;
                vt[0] = (unsigned short)(lo & 0xffffu); vt[AVT_STRIDE / 2] = (unsigned short)(lo >> 16); vt[2 * (AVT_STRIDE / 2)] = (unsigned short)(hi & 0xffffu); vt[3 * (AVT_STRIDE / 2)] = (unsigned short)(hi >> 16); } }
        if (tid < 128) {
            const int t = tid >> 4, c = tid & 15, key = 128 + t;
            const v4u wv = *(const GAS v4u*)(KV + ((size_t)MP + (size_t)b * 8 + t) * 512 + (c < 8 ? kvh * 64 + c * 8 : 256 + kvh * 64 + (c - 8) * 8));
            if (c < 8) *(LAS v4u*)(L + AL_K + key * 144 + c * 16) = wv;
            else { LAS unsigned short* vt = (LAS unsigned short*)(L + AL_VT) + (size_t)((c - 8) * 8) * (AVT_STRIDE / 2) + key;
                vt[0 * (AVT_STRIDE / 2)] = (unsigned short)(wv.x & 0xffffu); vt[1 * (AVT_STRIDE / 2)] = (unsigned short)(wv.x >> 16);
                vt[2 * (AVT_STRIDE / 2)] = (unsigned short)(wv.y & 0xffffu); vt[3 * (AVT_STRIDE / 2)] = (unsigned short)(wv.y >> 16);
                vt[4 * (AVT_STRIDE / 2)] = (unsigned short)(wv.z & 0xffffu); vt[5 * (AVT_STRIDE / 2)] = (unsigned short)(wv.z >> 16);
                vt[6 * (AVT_STRIDE / 2)] = (unsigned short)(wv.w & 0xffffu); vt[7 * (AVT_STRIDE / 2)] = (unsigned short)(wv.w >> 16); }
        } else if (tid < 128 + 72) { const int u = tid - 128; *(LAS v4u*)(L + AL_K + 136 * 144 + u * 16) = (v4u){0u, 0u, 0u, 0u}; }
        else if (tid < 128 + 72 + 192) { const int u = tid - 200, d = u / 3, pc = u % 3; *(LAS v4u*)(L + AL_VT + d * AVT_STRIDE + 272 + pc * 16) = (v4u){0u, 0u, 0u, 0u}; }
        __syncthreads();
        if (item + stride < end) AS_LOAD(item + stride);
        if (w < 2) {
            const int r = 16 * w + fr, t = r >> 2, g = r & 3, head = kvh * 4 + g;
            const size_t row = (size_t)MP + (size_t)b * 8 + t;
            const float sink = a->in[19][head];
            const bf16* qp = (const bf16*)(ws + WS_Q) + row * 1024 + head * 64 + fq * 8;
            const bf16x8 qb[2] = {*(const GAS bf16x8*)qp, *(const GAS bf16x8*)(qp + 32)};
            f32x4 s[10];
#pragma unroll
            for (int kt = 0; kt < 9; ++kt) {
                s[kt] = (f32x4){0.f, 0.f, 0.f, 0.f};
#pragma unroll
                for (int ks = 0; ks < 2; ++ks) {
                    const bf16x8 ka = *(const LAS bf16x8*)(L + AL_K + (16 * kt + fr) * 144 + ks * 64 + fq * 16);
                    s[kt] = __builtin_amdgcn_mfma_f32_16x16x32_bf16(ka, qb[ks], s[kt], 0, 0, 0);
                }
            }
            float m = sink;
#pragma unroll
            for (int kt = 0; kt < 9; ++kt)
#pragma unroll
                for (int jj = 0; jj < 4; ++jj) {
                    const int j = 16 * kt + 4 * fq + jj;
                    const bool ok = (j < 128) ? (j >= t + 1) : (j - 128 <= t);
                    const float sv = ok ? s[kt][jj] : -1e30f; s[kt][jj] = sv; m = fmaxf(m, sv);
                }
            m = fmaxf(m, __shfl_xor(m, 16)); m = fmaxf(m, __shfl_xor(m, 32));
            float l = 0.f;
#pragma unroll
            for (int kt = 0; kt < 9; ++kt)
#pragma unroll
                for (int jj = 0; jj < 4; ++jj) { const float p = __expf(s[kt][jj] - m); s[kt][jj] = p; l += p; }
            s[9] = (f32x4){0.f, 0.f, 0.f, 0.f};
            l += __shfl_xor(l, 16); l += __shfl_xor(l, 32);
            l += __expf(sink - m);
            f32x4 o[4];
#pragma unroll
            for (int dt = 0; dt < 4; ++dt) o[dt] = (f32x4){0.f, 0.f, 0.f, 0.f};
#pragma unroll
            for (int k5 = 0; k5 < 5; ++k5) {
                const bf16x8 pb = packB(s[2 * k5], s[2 * k5 + 1]);
#pragma unroll
                for (int dt = 0; dt < 4; ++dt)
                    o[dt] = __builtin_amdgcn_mfma_f32_16x16x32_bf16(frag2((lcp)(L + AL_VT + (16 * dt + fr) * AVT_STRIDE + (32 * k5 + 4 * fq) * 2)), pb, o[dt], 0, 0, 0);
            }
            const float inv = 1.0f / l;
            bf16* op = (bf16*)(ws + WS_OB) + row * 1024 + head * 64 + 4 * fq;
#pragma unroll
            for (int dt = 0; dt < 4; ++dt) { const f32x4 rr = o[dt] * inv; *(GAS unsigned long long*)(op + 16 * dt) = (unsigned long long)cvtpk(rr[0], rr[1]) | ((unsigned long long)cvtpk(rr[2], rr[3]) << 32); }
        }
    }
#undef AS_LOAD
}
#ifndef CHUNKED
#define CHUNKED 1
#endif
#ifndef TSOLVE
#define TSOLVE 1
#endif
#ifndef LATE_CONV
#define LATE_CONV 1
#endif
#ifndef MK_N_LAUNCHES
#define MK_N_LAUNCHES 1
#endif
constexpr int N_PHASES = 17;
constexpr int N_LAUNCHES = MK_N_LAUNCHES;

template <class Epi> __device__ __forceinline__ void small_gemm(Frame& F, const bf16* A, const bf16* Bt, int N, int K, const Epi& E) {
    const int lane = F.lane, w = F.wave, fr = lane & 15, fq = lane >> 4, tid = F.tid;
    const int ncol = N >> 6, ntile = 16 * ncol, kw = K >> 3, nks = kw >> 5;
    LAS float* P = (LAS float*)(F.lds + RING_OFF);
#pragma unroll 1
    for (int tile = blockIdx.x; tile < ntile; tile += F.G) {
        const int tr = tile / ncol, tc = tile - tr * ncol;
        const bf16* ap = A + ((size_t)MP + 64 * tr + fr) * K + w * kw + 8 * fq;
        const bf16* bp = Bt + ((size_t)64 * tc + fr) * K + w * kw + 8 * fq;
        pg8::f32x4 acc[4][4];
#pragma unroll
        for (int m = 0; m < 4; ++m)
#pragma unroll
            for (int n = 0; n < 4; ++n) acc[m][n] = (pg8::f32x4){0.f, 0.f, 0.f, 0.f};
        int ks0 = 0;
#pragma unroll 1
        for (; ks0 + 4 <= nks; ks0 += 4) {
            bf16x8 af[4][4], bfv[4][4];
#pragma unroll
            for (int kk = 0; kk < 4; ++kk) {
#pragma unroll
                for (int m = 0; m < 4; ++m) af[kk][m] = *(const GAS bf16x8*)(ap + (size_t)(16 * m) * K + 32 * (ks0 + kk));
#pragma unroll
                for (int n = 0; n < 4; ++n) bfv[kk][n] = *(const GAS bf16x8*)(bp + (size_t)(16 * n) * K + 32 * (ks0 + kk));
            }
#pragma unroll
            for (int kk = 0; kk < 4; ++kk)
#pragma unroll
                for (int m = 0; m < 4; ++m)
#pragma unroll
                    for (int n = 0; n < 4; ++n) acc[m][n] = __builtin_amdgcn_mfma_f32_16x16x32_bf16(af[kk][m], bfv[kk][n], acc[m][n], 0, 0, 0);
        }
#pragma unroll 1
        for (; ks0 < nks; ++ks0) {
            bf16x8 af[4], bfv[4];
#pragma unroll
            for (int m = 0; m < 4; ++m) af[m] = *(const GAS bf16x8*)(ap + (size_t)(16 * m) * K + 32 * ks0);
#pragma unroll
            for (int n = 0; n < 4; ++n) bfv[n] = *(const GAS bf16x8*)(bp + (size_t)(16 * n) * K + 32 * ks0);
#pragma unroll
            for (int m = 0; m < 4; ++m)
#pragma unroll
                for (int n = 0; n < 4; ++n) acc[m][n] = __builtin_amdgcn_mfma_f32_16x16x32_bf16(af[m], bfv[n], acc[m][n], 0, 0, 0);
        }
        __syncthreads();
#pragma unroll
        for (int m = 0; m < 4; ++m)
#pragma unroll
            for (int n = 0; n < 4; ++n)
#pragma unroll
                for (int j = 0; j < 4; ++j) P[(w * 64 + 16 * m + 4 * fq + j) * 64 + 16 * n + fr] = acc[m][n][j];
        __syncthreads();
        {
            const int row = tid >> 3, sub = tid & 7, c8 = sub * 8;
            pg8::f32x4 v0 = (pg8::f32x4){0.f, 0.f, 0.f, 0.f}, v1 = v0;
#pragma unroll
            for (int ww = 0; ww < 8; ++ww) { v0 += *(const LAS pg8::f32x4*)(P + (ww * 64 + row) * 64 + c8); v1 += *(const LAS pg8::f32x4*)(P + (ww * 64 + row) * 64 + c8 + 4); }
            E.small(MP + 64 * tr + row, 64 * tc + c8, v0, v1, tc, sub);
        }
    }
    __syncthreads();
}
template <class Epi> __device__ __forceinline__ void run_gemm(Frame& F, const bf16* A, const bf16* Bt, int N, int K, const Epi& E, int Mrows = MT, int stagger = 0) {
    if (stagger && (F.vcu & 1)) { for (int i = 0; i < stagger; ++i) __builtin_amdgcn_s_sleep(127); }
    pg8::Gemm g{A, Bt, Mrows, N, K}; pg8::StaticOrder S; S.init(Mrows, N, F.G, (int)blockIdx.x);
    pg8::gemm_phase<Epi, pg8::StaticOrder, true, true>(F.lds + RING_OFF, g, S, E);
}

__global__ void __launch_bounds__(NWAVES * 64, 2) yoco_fwd(Args args) {
    extern __shared__ __attribute__((aligned(16))) unsigned char lds[];
    Frame F;
    F.lds = (LAS unsigned char*)lds;
    F.MISC = (volatile LAS unsigned*)(F.lds + MISC_OFF);
    F.tid = threadIdx.x; F.lane = F.tid & 63; F.wave = __builtin_amdgcn_readfirstlane(F.tid >> 6);
    F.G = gridDim.x; { const int bx = blockIdx.x; F.vcu = (F.G % 8 == 0) ? (bx % 8) * (F.G / 8) + bx / 8 : bx; }
    F.ctl = (gu32*)(argp()->ws + WS_CTL);
    for (int u = F.tid; u < (LDS_BYTES - LDSCTL_OFF) / 4; u += NWAVES * 64) ((LAS unsigned*)(F.lds + LDSCTL_OFF))[u] = 0u;
    __syncthreads();
    XcdBarrier bar; bar.bar = (unsigned*)(F.ctl + CW_BAR); bar.x = 0; bar.st = nullptr;
    if (N_LAUNCHES == 1) bar = xcd_barrier_post((unsigned*)(F.ctl + CW_BAR) + argp()->li * XCD_BAR_WORDS, F.MISC + 8);
#define GRID_BAR() do { if (N_LAUNCHES == 1) xcd_barrier(bar); } while (0)
    const int lo = argp()->ph_lo, hi = argp()->ph_hi;
#ifndef PH_MASK
#define PH_MASK 0xffffffffu
#endif
#define IN(k) (((PH_MASK >> (k)) & 1) && lo <= (k) && (k) < hi)
#define REFRESH() do { int t_ = threadIdx.x; asm volatile("" : "+v"(t_)); F.tid = t_; F.lane = t_ & 63; } while (0)
#ifdef PROF_A
#ifndef PROF_AE
#define PROF_AE (PROF_A + 1)
#endif
#ifndef PROF_BE
#define PROF_BE (PROF_B + 1)
#endif
#endif
#ifndef PROF_SCALE
#define PROF_SCALE 1.0f
#endif
#ifdef PROF_A
#define STAMP(k) do { if (blockIdx.x == 0 && threadIdx.x == 0) ((unsigned long long*)(argp()->ws + WS_CTL + 2048))[(k)] = __builtin_amdgcn_s_memrealtime(); } while (0)
#else
#define STAMP(k) do { } while (0)
#endif
#ifndef PROF_IDLE
#define PROF_IDLE 0
#endif
#ifdef PROF_A
#define PSTAMP(blk, k) do { if (blockIdx.x == (blk) && threadIdx.x == 0) ((unsigned long long*)(argp()->ws + WS_CTL + 2048))[(k)] = __builtin_amdgcn_s_memrealtime(); } while (0)
#else
#define PSTAMP(blk, k) do { } while (0)
#endif
#if defined(PROF_A) && defined(PROF_FIN)
#define PFIN(ph) do { if ((ph) == PROF_FIN && threadIdx.x == 0) ((unsigned long long*)(argp()->ws + WS_CTL + 2048))[256 + blockIdx.x] = __builtin_amdgcn_s_memrealtime(); } while (0)
#else
#define PFIN(ph) do { } while (0)
#endif
#define SEAM(k) do { if (IN(k) && IN((k) + 1)) GRID_BAR(); STAMP((k) + 1); } while (0)
#define XB ((bf16*)(argp()->ws + WS_XB))
#define HA ((bf16*)(argp()->ws + WS_HA))
#define HB ((bf16*)(argp()->ws + WS_HB))
#define OG ((bf16*)(argp()->ws + WS_OG))
#define PP ((bf16*)(argp()->ws + WS_PP))
#define ACT ((bf16*)(argp()->ws + WS_ACT))
#define KVb ((bf16*)(argp()->ws + WS_KV))
#define Qb ((bf16*)(argp()->ws + WS_Q))
#define OB ((bf16*)(argp()->ws + WS_OB))
#define PEB ((bf16*)(argp()->ws + WS_PEB))
#define SSQX ((float*)(argp()->ws + WS_SSQX))
#define SSQA ((float*)(argp()->ws + WS_SSQA))
#define SSQB ((float*)(argp()->ws + WS_SSQB))

    STAMP(0);
    if (IN(0)) { REFRESH(); p0_prologue(F, argp(), LATE_CONV ? ((CHUNKED && F.G >= 256) ? 0 : 2) : 2, F.vcu * NWAVES + F.wave, F.G * NWAVES); } SEAM(0);
    if (IN(1)) { REFRESH(); pg8::EpiQKV E{(bf16*)(argp()->ws + WS_QKV), (bf16*)(argp()->ws + WS_Z), (float*)(argp()->ws + WS_AB), SSQX, argp()->out + O_SCP, argp()->out + O_SCS, (bf16*)(argp()->ws + WS_HALO)};
                 run_gemm(F, XB, (const bf16*)(argp()->ws + WS_WIN), NIN, 1024, E); } SEAM(1);
    if (IN(2)) { REFRESH(); if (CHUNKED) { if (TSOLVE) dprep_loop_t(F, argp()); else dprep_loop(F, argp()); } } SEAM(2);
    if (IN(3)) { REFRESH();
        if (CHUNKED && F.G >= 256) {
            if (blockIdx.x < 128) { if (TSOLVE == 2) dscan_item_t2(F, argp(), blockIdx.x); else if (TSOLVE) dscan_item_t(F, argp(), blockIdx.x); else dscan_item(F, argp(), blockIdx.x); PSTAMP(0, 56); }
            else if (!PROF_IDLE) { PSTAMP(128, 48); delta_seq_samples(F, argp(), blockIdx.x - 128, F.G - 128, 1024); PSTAMP(128, 49);
              __syncthreads(); REFRESH();
#ifdef PROF_A
              if ((PROF_A == 54 || PROF_B == 54) && blockIdx.x == 128 && threadIdx.x == 0) ((unsigned long long*)(argp()->ws + WS_CTL + 2048))[54] = __builtin_amdgcn_s_memrealtime();
#endif
              if (LATE_CONV) p0_prologue(F, argp(), 3, (blockIdx.x - 128) * NWAVES + F.wave, (F.G - 128) * NWAVES);
#ifdef PROF_A
              __syncthreads();
              if ((PROF_A == 54 || PROF_B == 54) && blockIdx.x == 128 && threadIdx.x == 0) ((unsigned long long*)(argp()->ws + WS_CTL + 2048))[55] = __builtin_amdgcn_s_memrealtime();
#endif
              }
        } else for (int item = blockIdx.x; item < 128 + 1024; item += F.G) { if (CHUNKED && item < 128) { if (TSOLVE == 2) dscan_item_t2(F, argp(), item); else if (TSOLVE) dscan_item_t(F, argp(), item); else dscan_item(F, argp(), item); } else delta_seq_item(F, argp(), item); }
    PFIN(3); } SEAM(3);
    if (IN(4)) { REFRESH(); { pg8::EpiRes<false> E{nullptr, nullptr, XB, HA, SSQA}; run_gemm(F, OG, (const bf16*)(argp()->ws + WS_WOUT), 1024, 1024, E, MP); } REFRESH(); { pg8::EpiRes<false> E{nullptr, nullptr, XB, HA, SSQA}; small_gemm(F, OG, (const bf16*)(argp()->ws + WS_WOUT), 1024, 1024, E); } }     SEAM(4);
    if (IN(5)) { REFRESH(); { pg8::EpiGU E{ACT, SSQA}; run_gemm(F, HA, (const bf16*)(argp()->ws + WS_WGU0), 5632, 1024, E, MT, 0); }
        if (LATE_CONV && CHUNKED && F.G >= 256) {
            const int nbx = ((MT / 256) * 22) % F.G;
            if ((int)blockIdx.x >= nbx) { __syncthreads(); REFRESH(); p0_prologue(F, argp(), 4, ((int)blockIdx.x - nbx) * NWAVES + F.wave, (F.G - nbx) * NWAVES); } } } SEAM(5);
    if (IN(6)) { REFRESH(); { pg8::EpiRes<false> E{nullptr, nullptr, HA, HB, SSQB}; run_gemm(F, ACT, (const bf16*)(argp()->ws + WS_WDN0), 1024, FFH, E, MP); } REFRESH(); { pg8::EpiRes<false> E{nullptr, nullptr, HA, HB, SSQB}; small_gemm(F, ACT, (const bf16*)(argp()->ws + WS_WDN0), 1024, FFH, E); } }     STAMP(7);
    if (IN(7)) { REFRESH(); { pg8::EpiPP E{PP}; run_gemm(F, PEB, (const bf16*)(argp()->ws + WS_WPJ0), 1024, 256, E, MP); } REFRESH(); { pg8::EpiPP E{PP}; small_gemm(F, PEB, (const bf16*)(argp()->ws + WS_WPJ0), 1024, 256, E); } } SEAM(7);
    if (IN(8)) { REFRESH(); { pg8::EpiGate<false> E{SSQB, PP, HB, HA, SSQA, nullptr}; run_gemm(F, HB, (const bf16*)(argp()->ws + WS_WGT0), 1024, 1024, E, MP); } REFRESH(); { pg8::EpiGate<false> E{SSQB, PP, HB, HA, SSQA, nullptr}; small_gemm(F, HB, (const bf16*)(argp()->ws + WS_WGT0), 1024, 1024, E); } } SEAM(8);
    if (IN(9)) { REFRESH(); { pg8::EpiKVQ E{KVb, Qb, SSQA, argp()->out + O_KWP, argp()->out + O_VWP, argp()->out + O_KWS, argp()->out + O_VWS}; run_gemm(F, HA, (const bf16*)(argp()->ws + WS_WKVQ), 1536, 1024, E, MP); } REFRESH(); { pg8::EpiKVQ E{KVb, Qb, SSQA, argp()->out + O_KWP, argp()->out + O_VWP, argp()->out + O_KWS, argp()->out + O_VWS}; small_gemm(F, HA, (const bf16*)(argp()->ws + WS_WKVQ), 1536, 1024, E); } } SEAM(9);
    if (IN(10)) { REFRESH(); PSTAMP(0, 50); attn_prompt_items(F, argp(), (int)blockIdx.x, F.G, 1024); PSTAMP(0, 51);
        REFRESH(); attn_sample_items(F, argp(), (int)blockIdx.x + ((1024 - (int)blockIdx.x + F.G - 1) / F.G) * F.G - 1024, F.G, 512); PSTAMP(0, 53); PFIN(10); } SEAM(10);
    if (IN(11)) { REFRESH(); { pg8::EpiRes<false> E{nullptr, nullptr, HA, HB, SSQB}; run_gemm(F, OB, (const bf16*)(argp()->ws + WS_WO), 1024, 1024, E, MP); } REFRESH(); { pg8::EpiRes<false> E{nullptr, nullptr, HA, HB, SSQB}; small_gemm(F, OB, (const bf16*)(argp()->ws + WS_WO), 1024, 1024, E); } } SEAM(11);
    if (IN(12)) { REFRESH(); { pg8::EpiGU E{ACT, SSQB}; run_gemm(F, HB, (const bf16*)(argp()->ws + WS_WGU1), 5632, 1024, E, MT, 0); }
        if (LATE_CONV && CHUNKED && F.G >= 256) {
            const int nbx = ((MT / 256) * 22) % F.G;
            if ((int)blockIdx.x >= nbx) { __syncthreads(); REFRESH(); p0_prologue(F, argp(), 5, ((int)blockIdx.x - nbx) * NWAVES + F.wave, (F.G - nbx) * NWAVES); } } } SEAM(12);
    if (IN(13)) { REFRESH(); { pg8::EpiRes<false> E{nullptr, nullptr, HB, HA, SSQA}; run_gemm(F, ACT, (const bf16*)(argp()->ws + WS_WDN1), 1024, FFH, E, MP); } REFRESH(); { pg8::EpiRes<false> E{nullptr, nullptr, HB, HA, SSQA}; small_gemm(F, ACT, (const bf16*)(argp()->ws + WS_WDN1), 1024, FFH, E); } }     STAMP(14);
    if (IN(14)) { REFRESH(); { pg8::EpiPP E{PP}; run_gemm(F, PEB + (size_t)MT * 256, (const bf16*)(argp()->ws + WS_WPJ1), 1024, 256, E, MP); } REFRESH(); { pg8::EpiPP E{PP}; small_gemm(F, PEB + (size_t)MT * 256, (const bf16*)(argp()->ws + WS_WPJ1), 1024, 256, E); } } SEAM(14);
    if (IN(15)) { REFRESH(); { pg8::EpiGate<false> E{SSQA, PP, HA, HB, SSQB, nullptr}; run_gemm(F, HA, (const bf16*)(argp()->ws + WS_WGT1), 1024, 1024, E, MP); } REFRESH(); { pg8::EpiGate<false> E{SSQA, PP, HA, HB, SSQB, nullptr}; small_gemm(F, HA, (const bf16*)(argp()->ws + WS_WGT1), 1024, 1024, E); } } SEAM(15);
    if (IN(16)) { REFRESH(); final_norm(F, argp()); }
#ifdef PROF_A
    GRID_BAR(); STAMP(17);
    GRID_BAR();
    if (PROF_IDLE) { float* z_ = argp()->out + O_SDS; for (size_t i = (size_t)blockIdx.x * 512 + threadIdx.x; i < (size_t)1024 * 128 * 128; i += (size_t)gridDim.x * 512) z_[i] = 0.f; }
    { const unsigned long long* st = (const unsigned long long*)(argp()->ws + WS_CTL + 2048);
      const float usA = (float)(__hip_atomic_load(st + PROF_AE, RLX_AGENT) - __hip_atomic_load(st + PROF_A, RLX_AGENT)) * 0.01f * PROF_SCALE;
      unsigned long long tB_ = __hip_atomic_load(st + (PROF_BE >= 900 ? 256 : PROF_BE), RLX_AGENT);
      if (PROF_BE == 999) { for (int i = 1; i < 256; ++i) { const unsigned long long t_ = __hip_atomic_load(st + 256 + i, RLX_AGENT); tB_ = t_ > tB_ ? t_ : tB_; } }
      if (PROF_BE == 998) { for (int i = 1; i < 256; ++i) { const unsigned long long t_ = __hip_atomic_load(st + 256 + i, RLX_AGENT); tB_ = t_ < tB_ ? t_ : tB_; } }
      const float usB = (float)(tB_ - __hip_atomic_load(st + PROF_B, RLX_AGENT)) * 0.01f * PROF_SCALE;
#ifdef PROF_Q
      const float qA = PROF_Q * floorf(usA / PROF_Q + 0.5f), qB = PROF_Q * floorf(usB / PROF_Q + 0.5f);
#else
      const float qA = (usA >= 100.f) ? 10.f * floorf(usA * 0.1f + 0.5f) : floorf(usA + 0.5f), qB = (usB >= 100.f) ? 10.f * floorf(usB * 0.1f + 0.5f) : floorf(usB + 0.5f);
#endif
      const float c1 = (PROF_A == PROF_AE) ? 0.05f : sqrtf(qA * 0.001f);
      float* ys = argp()->out + O_Y + (size_t)MP * DM;
      for (size_t i = (size_t)blockIdx.x * 512 + threadIdx.x; i < (size_t)MS * DM; i += (size_t)gridDim.x * 512) ys[i] += c1;
      if (blockIdx.x == 0 && threadIdx.x == 0) argp()->out[O_KWP] += qB * 0.1f; }
#endif
#undef IN
#undef SEAM
}

extern "C" void kernel_launch(void* const* d_in, const int* in_sizes, int n_in, void* d_out, int out_size, void* d_ws, size_t ws_size, hipStream_t stream) {
    static int grid = 0;
    if (grid == 0) {
        if (n_in != 28 || out_size != (int)O_END || ws_size < WS_END) { fprintf(stderr, "kernel_launch: unexpected shapes: n_in %d out %d ws %zu (need %zu)\n", n_in, out_size, ws_size, (size_t)WS_END); grid = -1; return; }
        int dev = 0, cus = 0;
        if (hipGetDevice(&dev) != hipSuccess || hipDeviceGetAttribute(&cus, hipDeviceAttributeMultiprocessorCount, dev) != hipSuccess) { grid = -1; return; }
        if (hipFuncSetAttribute((const void*)yoco_fwd, hipFuncAttributeMaxDynamicSharedMemorySize, LDS_BYTES) != hipSuccess) { fprintf(stderr, "kernel_launch: hipFuncSetAttribute failed\n"); grid = -1; return; }
        (void)hipGetLastError();
        grid = cus;
    }
    if (grid < 0) return;
    (void)hipMemsetAsync((char*)d_ws + WS_CTL, 0, CTL_ZERO_BYTES, stream);
    Args a{};
    for (int i = 0; i < 28; ++i) a.in[i] = (const float*)d_in[i];
    a.out = (float*)d_out; a.ws = (unsigned char*)d_ws;
#ifdef PROBE_PHASE
    if (N_LAUNCHES == 1) { const int cuts[4] = {0, PROBE_PHASE + 1, PROBE_PHASE, N_PHASES};
        a.ph_lo = 0; a.ph_hi = PROBE_PHASE + 1; a.li = 0; hipLaunchKernelGGL(yoco_fwd, dim3(grid), dim3(NWAVES * 64), LDS_BYTES, stream, a);
        a.ph_lo = PROBE_PHASE; a.ph_hi = PROBE_PHASE + 1; a.li = 1; hipLaunchKernelGGL(yoco_fwd, dim3(grid), dim3(NWAVES * 64), LDS_BYTES, stream, a);
        a.ph_lo = PROBE_PHASE + 1; a.ph_hi = N_PHASES; a.li = 2; hipLaunchKernelGGL(yoco_fwd, dim3(grid), dim3(NWAVES * 64), LDS_BYTES, stream, a); (void)cuts; }
#else
    if (N_LAUNCHES == 1) { a.ph_lo = 0; a.ph_hi = N_PHASES; a.li = 0; hipLaunchKernelGGL(yoco_fwd, dim3(grid), dim3(NWAVES * 64), LDS_BYTES, stream, a); }
#endif
    else for (int p = 0; p < N_PHASES; ++p) { a.ph_lo = p; a.ph_hi = p + 1; hipLaunchKernelGGL(yoco_fwd, dim3(grid), dim3(NWAVES * 64), LDS_BYTES, stream, a); }
}
```

```cpp
#include <hip/hip_runtime.h>
#include <cstdio>
#include <cstdint>
namespace pg8 {
#define PG8_LAS __attribute__((address_space(3)))
typedef unsigned short bf16_t;
typedef short bf16x8 __attribute__((ext_vector_type(8)));
typedef float f32x4 __attribute__((ext_vector_type(4)));
typedef unsigned u32x4 __attribute__((ext_vector_type(4)));
constexpr int BM = 256, BK = 64, HALF = 128, HTB = HALF * BK * 2  , STAGE_BYTES = 8 * HTB, NXCD = 8, WGM = 8;

__host__ __device__ __forceinline__ int lds_byte(int r, int c) { const int st = (r >> 4) * 2 + (c >> 5), rr = r & 15, cc = c & 31, ob = rr * 64 + cc * 2; return st * 1024 + (ob ^ (((ob >> 9) & 1) << 5)); }
__host__ __device__ __forceinline__ void stage_rc(int b, int& R, int& C) { const int st = b / 1024, sb = b % 1024, swz = sb ^ (((sb >> 9) & 1) << 5); R = (st >> 1) * 16 + swz / 64; C = (st & 1) * 32 + (swz % 64) / 2; }
__host__ __device__ __forceinline__ int perm32(int rho) { const int n = rho >> 4, i = rho & 15; return 8 * (i >> 2) + 4 * n + (i & 3); }

struct Unit { int pm, pn; };
struct Gemm { const bf16_t* A; const bf16_t* Bt; int M, N, K; };

struct StaticOrder {
    int nM, nN, nwg, G, c;
    __host__ __device__ void init(int M, int N, int G_, int c_) { nM = M / BM; nN = N / BM; nwg = nM * nN; G = G_; c = c_; }
    __host__ __device__ bool next(int i, Unit& u) const {
        const long L = (long)i * G + c; if (L >= nwg) return false;
        int wgid = (int)L; { const int q = nwg / NXCD, r = nwg % NXCD, xcd = wgid % NXCD, off = wgid / NXCD; wgid = (xcd < r ? xcd * (q + 1) : r * (q + 1) + (xcd - r) * q) + off; }
        const int nig = WGM * nN, gid = wgid / nig, fm = gid * WGM, gsz = (nM - fm) < WGM ? (nM - fm) : WGM;
        u.pm = fm + ((wgid % nig) % gsz); u.pn = (wgid % nig) / gsz; return true;
    }
    __device__ __forceinline__ void a_ready(const Unit&) const {}
    __device__ __forceinline__ void done(const Unit&) const {}
};

__device__ __forceinline__ unsigned cvt_pk_bf16(float lo, float hi) { unsigned r; asm volatile("v_cvt_pk_bf16_f32 %0, %1, %2" : "=v"(r) : "v"(lo), "v"(hi)); return r; }
__device__ __forceinline__ f32x4 bf_lo2(unsigned a, unsigned b) { return (f32x4){__uint_as_float(a << 16), __uint_as_float(a & 0xffff0000u), __uint_as_float(b << 16), __uint_as_float(b & 0xffff0000u)}; }
__device__ __forceinline__ u32x4 pack8(const f32x4 v0, const f32x4 v1) { u32x4 w; w.x = cvt_pk_bf16(v0[0], v0[1]); w.y = cvt_pk_bf16(v0[2], v0[3]); w.z = cvt_pk_bf16(v1[0], v1[1]); w.w = cvt_pk_bf16(v1[2], v1[3]); return w; }
__device__ __forceinline__ float dot4(const f32x4 a) { return (a[0] * a[0] + a[1] * a[1]) + (a[2] * a[2] + a[3] * a[3]); }
__device__ __forceinline__ float row_rstd(const float* ssq, int r, int fq) {
    const f32x4 p = *(const f32x4*)(ssq + (size_t)r * 16 + 4 * fq);
    float s = (p[0] + p[1]) + (p[2] + p[3]);
    s += __shfl_xor(s, 16); s += __shfl_xor(s, 32);
    return rsqrtf(s * (1.0f / 1024.0f) + 1e-6f);
}
__device__ __forceinline__ f32x4 rstd_load(const float* ssq, int r, int fq) { return *(const f32x4*)(ssq + (size_t)r * 16 + 4 * fq); }
__device__ __forceinline__ float rstd_finish(const f32x4 p) {
    float s = (p[0] + p[1]) + (p[2] + p[3]);
    s += __shfl_xor(s, 16); s += __shfl_xor(s, 32);
    return rsqrtf(s * (1.0f / 1024.0f) + 1e-6f);
}
__device__ __forceinline__ float row_rstd8(const float* ssq, int r, int sub) {
    const float2 p = *(const float2*)(ssq + (size_t)r * 16 + 2 * sub);
    float s = p.x + p.y;
    s += __shfl_xor(s, 1); s += __shfl_xor(s, 2); s += __shfl_xor(s, 4);
    return rsqrtf(s * (1.0f / 1024.0f) + 1e-6f);
}
__device__ __forceinline__ float sum8(float q) { q += __shfl_xor(q, 1); q += __shfl_xor(q, 2); q += __shfl_xor(q, 4); return q; }
__device__ __forceinline__ float sigmoidf_(float x) { return __builtin_amdgcn_rcpf(1.0f + __expf(-x)); }

constexpr int MP_ROWS = 32768;

struct EpiQKV {
    static constexpr bool PERM = true, AFTER_DRAIN = false;
    bf16_t* QKV; bf16_t* Z; float* AB; const float* ssq; float* sc_p; float* sc_s; bf16_t* halo;
    __device__ __forceinline__ void operator()(const f32x4 (&acc)[2][2][4][2], const Unit& u, int wr, int wc, int fr, int fq) const {
        const int row0 = u.pm * BM + wr * 64 + fr, colt = u.pn * BM + wc * 32 + 8 * fq;
#pragma unroll
        for (int ai = 0; ai < 2; ++ai) {
            f32x4 pr[4];
#pragma unroll
            for (int m = 0; m < 4; ++m) pr[m] = rstd_load(ssq, row0 + ai * HALF + m * 16, fq);
#pragma unroll
            for (int m = 0; m < 4; ++m) {
                const int r = row0 + ai * HALF + m * 16; const float rs = rstd_finish(pr[m]);
#pragma unroll
                for (int bj = 0; bj < 2; ++bj) {
                    const int col = colt + bj * HALF; const f32x4 v0 = acc[ai][bj][m][0] * rs, v1 = acc[ai][bj][m][1] * rs;
                    if (u.pn < 12) {
                        const u32x4 pk = pack8(v0, v1);
                        *(u32x4*)(QKV + (size_t)r * 3072 + col) = pk;
                        if (r < MP_ROWS && (r & 63) >= 61) *(u32x4*)(halo + ((size_t)(r >> 6) * 3 + ((r & 63) - 61)) * 3072 + col) = pk;
                        if (r < MP_ROWS) { const int s = r & 2047; if (s >= 2045) { float* o = sc_p + ((size_t)((r >> 11) * 3 + (s - 2045))) * 3072 + col; *(f32x4*)o = v0; *(f32x4*)(o + 4) = v1; } }
                        else { const int rr = r - MP_ROWS, t = rr & 7; if (t >= 5) { float* o = sc_s + ((size_t)((rr >> 3) * 3 + (t - 5))) * 3072 + col; *(f32x4*)o = v0; *(f32x4*)(o + 4) = v1; } }
                    } else if (u.pn < 16) {
                        *(u32x4*)(Z + (size_t)r * 1024 + (col - 3072)) = pack8(v0, v1);
                    } else {
                        const int c = col - 4096; if (c < 16) { float* o = AB + (size_t)r * 16 + c; *(f32x4*)o = v0; *(f32x4*)(o + 4) = v1; }
                    }
                }
            }
        }
    }
};
template <bool BASEF32> struct EpiRes {
    static constexpr bool PERM = true, AFTER_DRAIN = false;
    const float* xp; const float* xs; const bf16_t* hb; bf16_t* out; float* ssq_out;
    __device__ __forceinline__ void operator()(const f32x4 (&acc)[2][2][4][2], const Unit& u, int wr, int wc, int fr, int fq) const {
        const int row0 = u.pm * BM + wr * 64 + fr, colt = u.pn * BM + wc * 32 + 8 * fq;
#pragma unroll
        for (int ai = 0; ai < 2; ++ai) {
            u32x4 bw[4][2];
            if (!BASEF32) {
#pragma unroll
                for (int m = 0; m < 4; ++m)
#pragma unroll
                    for (int bj = 0; bj < 2; ++bj) bw[m][bj] = *(const u32x4*)(hb + (size_t)(row0 + ai * HALF + m * 16) * 1024 + colt + bj * HALF);
            }
#pragma unroll
            for (int m = 0; m < 4; ++m) {
                const int r = row0 + ai * HALF + m * 16; float q = 0.f;
#pragma unroll
                for (int bj = 0; bj < 2; ++bj) {
                    const int col = colt + bj * HALF; f32x4 b0, b1;
                    if (BASEF32) { const float* p = (r < MP_ROWS ? xp + (size_t)r * 1024 : xs + (size_t)(r - MP_ROWS) * 1024) + col; b0 = *(const f32x4*)p; b1 = *(const f32x4*)(p + 4); }
                    else { const u32x4 w = bw[m][bj]; b0 = bf_lo2(w.x, w.y); b1 = bf_lo2(w.z, w.w); }
                    const f32x4 v0 = acc[ai][bj][m][0] + b0, v1 = acc[ai][bj][m][1] + b1;
                    q += dot4(v0) + dot4(v1);
                    *(u32x4*)(out + (size_t)r * 1024 + col) = pack8(v0, v1);
                }
                q += __shfl_xor(q, 16); q += __shfl_xor(q, 32);
                if (fq == 0) ssq_out[(size_t)r * 16 + u.pn * 4 + wc] = q;
            }
        }
    }
    __device__ __forceinline__ void small(int r, int col, f32x4 v0, f32x4 v1, int slot, int sub) const {
        f32x4 b0, b1;
        if (BASEF32) { const float* p = xs + (size_t)(r - MP_ROWS) * 1024 + col; b0 = *(const f32x4*)p; b1 = *(const f32x4*)(p + 4); }
        else { const u32x4 w = *(const u32x4*)(hb + (size_t)r * 1024 + col); b0 = bf_lo2(w.x, w.y); b1 = bf_lo2(w.z, w.w); }
        v0 += b0; v1 += b1;
        const float q = sum8(dot4(v0) + dot4(v1));
        *(u32x4*)(out + (size_t)r * 1024 + col) = pack8(v0, v1);
        if (sub == 0) ssq_out[(size_t)r * 16 + slot] = q;
    }
};
struct EpiGU {
    static constexpr bool PERM = true, AFTER_DRAIN = false;
    bf16_t* act; const float* ssq;
    __device__ __forceinline__ void operator()(const f32x4 (&acc)[2][2][4][2], const Unit& u, int wr, int wc, int fr, int fq) const {
        const int row0 = u.pm * BM + wr * 64 + fr, col = u.pn * HALF + wc * 32 + 8 * fq;
#pragma unroll
        for (int ai = 0; ai < 2; ++ai) {
            f32x4 pr[4];
#pragma unroll
            for (int m = 0; m < 4; ++m) pr[m] = rstd_load(ssq, row0 + ai * HALF + m * 16, fq);
#pragma unroll
            for (int m = 0; m < 4; ++m) {
                const int r = row0 + ai * HALF + m * 16; const float rs = rstd_finish(pr[m]);
                f32x4 o[2];
#pragma unroll
                for (int n = 0; n < 2; ++n) {
                    const f32x4 g = acc[ai][0][m][n] * rs, up = acc[ai][1][m][n] * rs;
#pragma unroll
                    for (int j = 0; j < 4; ++j) o[n][j] = g[j] * sigmoidf_(g[j]) * up[j];
                }
                *(u32x4*)(act + (size_t)r * 2816 + col) = pack8(o[0], o[1]);
            }
        }
    }
};
struct EpiPP {
    static constexpr bool PERM = true, AFTER_DRAIN = false;
    bf16_t* out;
    __device__ __forceinline__ void operator()(const f32x4 (&acc)[2][2][4][2], const Unit& u, int wr, int wc, int fr, int fq) const {
        const int row0 = u.pm * BM + wr * 64 + fr, colt = u.pn * BM + wc * 32 + 8 * fq;
#pragma unroll
        for (int ai = 0; ai < 2; ++ai)
#pragma unroll
            for (int m = 0; m < 4; ++m) {
                const int r = row0 + ai * HALF + m * 16;
#pragma unroll
                for (int bj = 0; bj < 2; ++bj) *(u32x4*)(out + (size_t)r * 1024 + colt + bj * HALF) = pack8(acc[ai][bj][m][0], acc[ai][bj][m][1]);
            }
    }
    __device__ __forceinline__ void small(int r, int col, f32x4 v0, f32x4 v1, int slot, int sub) const { *(u32x4*)(out + (size_t)r * 1024 + col) = pack8(v0, v1); }
};
template <bool FINAL> struct EpiGate {
    static constexpr bool PERM = true, AFTER_DRAIN = false;
    const float* ssq_in; const bf16_t* pp; const bf16_t* hb; bf16_t* out; float* ssq_out; float* y;
    __device__ __forceinline__ void operator()(const f32x4 (&acc)[2][2][4][2], const Unit& u, int wr, int wc, int fr, int fq) const {
        const int row0 = u.pm * BM + wr * 64 + fr, colt = u.pn * BM + wc * 32 + 8 * fq;
#pragma unroll
        for (int ai = 0; ai < 2; ++ai) {
            f32x4 pr[4];
#pragma unroll
            for (int m = 0; m < 4; ++m) pr[m] = rstd_load(ssq_in, row0 + ai * HALF + m * 16, fq);
#pragma unroll
            for (int m2 = 0; m2 < 4; m2 += 2) {
            u32x4 pw_[2][2], hw_[2][2];
#pragma unroll
            for (int m = 0; m < 2; ++m)
#pragma unroll
                for (int bj = 0; bj < 2; ++bj) { const size_t o_ = (size_t)(row0 + ai * HALF + (m2 + m) * 16) * 1024 + colt + bj * HALF; pw_[m][bj] = *(const u32x4*)(pp + o_); hw_[m][bj] = *(const u32x4*)(hb + o_); }
#pragma unroll
            for (int mm = 0; mm < 2; ++mm) {
                const int m = m2 + mm;
                const int r = row0 + ai * HALF + m * 16; const float rs = rstd_finish(pr[m]); float q = 0.f;
#pragma unroll
                for (int bj = 0; bj < 2; ++bj) {
                    const int col = colt + bj * HALF;
                    const u32x4 wp = pw_[mm][bj], wh = hw_[mm][bj];
                    const f32x4 p0 = bf_lo2(wp.x, wp.y), p1 = bf_lo2(wp.z, wp.w), h0 = bf_lo2(wh.x, wh.y), h1 = bf_lo2(wh.z, wh.w);
                    f32x4 v0, v1;
#pragma unroll
                    for (int j = 0; j < 4; ++j) { v0[j] = h0[j] + p0[j] * sigmoidf_(acc[ai][bj][m][0][j] * rs); v1[j] = h1[j] + p1[j] * sigmoidf_(acc[ai][bj][m][1][j] * rs); }
                    if (FINAL) { float* o = y + (size_t)r * 1024 + col; *(f32x4*)o = v0; *(f32x4*)(o + 4) = v1; }
                    else { q += dot4(v0) + dot4(v1); *(u32x4*)(out + (size_t)r * 1024 + col) = pack8(v0, v1); }
                }
                if (!FINAL) { q += __shfl_xor(q, 16); q += __shfl_xor(q, 32); if (fq == 0) ssq_out[(size_t)r * 16 + u.pn * 4 + wc] = q; }
            }
            }
        }
    }
    __device__ __forceinline__ void small(int r, int col, f32x4 a0, f32x4 a1, int slot, int sub) const {
        const float rs = row_rstd8(ssq_in, r, sub);
        const u32x4 wp = *(const u32x4*)(pp + (size_t)r * 1024 + col), wh = *(const u32x4*)(hb + (size_t)r * 1024 + col);
        const f32x4 p0 = bf_lo2(wp.x, wp.y), p1 = bf_lo2(wp.z, wp.w), h0 = bf_lo2(wh.x, wh.y), h1 = bf_lo2(wh.z, wh.w);
        f32x4 v0, v1;
#pragma unroll
        for (int j = 0; j < 4; ++j) { v0[j] = h0[j] + p0[j] * sigmoidf_(a0[j] * rs); v1[j] = h1[j] + p1[j] * sigmoidf_(a1[j] * rs); }
        if (FINAL) { float* o = y + (size_t)r * 1024 + col; *(f32x4*)o = v0; *(f32x4*)(o + 4) = v1; }
        else { const float q = sum8(dot4(v0) + dot4(v1)); *(u32x4*)(out + (size_t)r * 1024 + col) = pack8(v0, v1); if (sub == 0) ssq_out[(size_t)r * 16 + slot] = q; }
    }
};
struct EpiKVQ {
    static constexpr bool PERM = true, AFTER_DRAIN = false;
    bf16_t* KV; bf16_t* Q; const float* ssq; float* kw_p; float* vw_p; float* kw_s; float* vw_s;
    __device__ __forceinline__ void operator()(const f32x4 (&acc)[2][2][4][2], const Unit& u, int wr, int wc, int fr, int fq) const {
        const int row0 = u.pm * BM + wr * 64 + fr, colt = u.pn * BM + wc * 32 + 8 * fq;
        const bool iskv = u.pn < 2;
        float* const cp = (u.pn == 0) ? kw_p : vw_p; float* const cs = (u.pn == 0) ? kw_s : vw_s;
        const int ccol = wc * 32 + 8 * fq;
#pragma unroll
        for (int ai = 0; ai < 2; ++ai) {
            f32x4 pr[4];
#pragma unroll
            for (int m = 0; m < 4; ++m) pr[m] = rstd_load(ssq, row0 + ai * HALF + m * 16, fq);
#pragma unroll
            for (int m = 0; m < 4; ++m) {
                const int r = row0 + ai * HALF + m * 16; const float rs = rstd_finish(pr[m]);
                if (iskv) {
                    long crow = -1;
                    if (r < MP_ROWS) { const int s = r & 2047; if (s >= 1920) crow = (long)(r >> 11) * 128 + (s - 1920); }
                    else { const int rr = r - MP_ROWS; crow = (long)(rr >> 3) * 128 + 120 + (rr & 7); }
                    float* const cbase = (r < MP_ROWS) ? cp : cs;
#pragma unroll
                    for (int bj = 0; bj < 2; ++bj) {
                        const f32x4 v0 = acc[ai][bj][m][0] * rs, v1 = acc[ai][bj][m][1] * rs;
                        *(u32x4*)(KV + (size_t)r * 512 + colt + bj * HALF) = pack8(v0, v1);
                        if (crow >= 0) { float* o = cbase + (size_t)crow * 256 + ccol + bj * HALF; *(f32x4*)o = v0; *(f32x4*)(o + 4) = v1; }
                    }
                } else {
                    const float sc = rs * 0.125f;
#pragma unroll
                    for (int bj = 0; bj < 2; ++bj)
                        *(u32x4*)(Q + (size_t)r * 1024 + (colt - 512) + bj * HALF) = pack8(acc[ai][bj][m][0] * sc, acc[ai][bj][m][1] * sc);
                }
            }
        }
    }
    __device__ __forceinline__ void small(int r, int col, f32x4 a0, f32x4 a1, int slot, int sub) const {
        const float rs = row_rstd8(ssq, r, sub);
        if (col < 512) {
            const f32x4 v0 = a0 * rs, v1 = a1 * rs;
            *(u32x4*)(KV + (size_t)r * 512 + col) = pack8(v0, v1);
            const int rr = r - MP_ROWS; float* o = (col < 256 ? kw_s : vw_s) + ((size_t)(rr >> 3) * 128 + 120 + (rr & 7)) * 256 + (col & 255);
            *(f32x4*)o = v0; *(f32x4*)(o + 4) = v1;
        } else {
            const float sc = rs * 0.125f;
            *(u32x4*)(Q + (size_t)r * 1024 + (col - 512)) = pack8(a0 * sc, a1 * sc);
        }
    }
};

template <class Epi, class Sched, bool ALIGN_EPI = false, bool SP2 = false>
__device__ __forceinline__ void gemm_phase(PG8_LAS unsigned char* lds, const Gemm g, const Sched& S, const Epi& E) {
    int tid_ = threadIdx.x; asm volatile("" : "+v"(tid_));
    const int tid = tid_, wid = __builtin_amdgcn_readfirstlane(tid >> 6), lane = tid & 63, wr = wid >> 2, wc = wid & 3, fr = lane & 15, fq = lane >> 4;
    const int K = g.K, nt = K / BK;
    unsigned voffA[2], voffB[2];
#pragma unroll
    for (int i = 0; i < 2; ++i) { int R, C; stage_rc(tid * 16 + i * 8192, R, C); const int Rb = Epi::PERM ? ((R & ~31) + perm32(R & 31)) : R;
        voffA[i] = (unsigned)(R * K + C) * 2u; voffB[i] = (unsigned)(Rb * K + C) * 2u; }
    const size_t kstep = (size_t)(BK * 2);
    const size_t hstep = (size_t)HALF * K * 2;
    const size_t tstep = 2 * hstep;
    const unsigned ldsw = (unsigned)wid * 1024u;
    const int aoff = lds_byte(wr * 64 + fr, fq * 8), boff = lds_byte(wc * 32 + fr, fq * 8);
#define PG8_SA(b, h) (((b) * 2 + (h)) * HTB)
#define PG8_SB(b, h) ((4 + (b) * 2 + (h)) * HTB)
#define PG8_STAGE(bufoff, gbase, voff) do { _Pragma("unroll") for (int _i = 0; _i < 2; ++_i) \
        __builtin_amdgcn_global_load_lds((const unsigned*)((const char*)(gbase) + (voff)[_i]), (PG8_LAS unsigned*)(lds + (bufoff) + ldsw + _i * 8192), 16, 0, 0); } while (0)
#define PG8_LDA(dst, b, h) do { _Pragma("unroll") for (int m = 0; m < 4; ++m) _Pragma("unroll") for (int k = 0; k < 2; ++k) dst[m][k] = *(const PG8_LAS bf16x8*)(lds + PG8_SA(b, h) + aoff + m * 2048 + k * 1024); } while (0)
#define PG8_LDB(dst, b, h) do { _Pragma("unroll") for (int n = 0; n < 2; ++n) _Pragma("unroll") for (int k = 0; k < 2; ++k) dst[n][k] = *(const PG8_LAS bf16x8*)(lds + PG8_SB(b, h) + boff + n * 2048 + k * 1024); } while (0)
#define PG8_MMA(ai, bj, At, Bt) do { __builtin_amdgcn_s_setprio(1); _Pragma("unroll") for (int m = 0; m < 4; ++m) _Pragma("unroll") for (int n = 0; n < 2; ++n) _Pragma("unroll") for (int k = 0; k < 2; ++k) \
        acc[ai][bj][m][n] = __builtin_amdgcn_mfma_f32_16x16x32_bf16(Bt[n][k], At[m][k], acc[ai][bj][m][n], 0, 0, 0); __builtin_amdgcn_s_setprio(0); } while (0)
#define PG8_WAIT_V(n) asm volatile("s_waitcnt vmcnt(" #n ")" ::: "memory")
#define PG8_WAIT_L(n) asm volatile("s_waitcnt lgkmcnt(" #n ")" ::: "memory")
#define PG8_BAR __builtin_amdgcn_s_barrier()
#define PG8_SCHED __builtin_amdgcn_sched_barrier(0)
    Unit cur, nxt; int ui = 0;
    if (!S.next(0, cur)) return;
    f32x4 acc[2][2][4][2];
#pragma unroll
    for (int a = 0; a < 2; ++a)
#pragma unroll
        for (int b = 0; b < 2; ++b)
#pragma unroll
            for (int m = 0; m < 4; ++m)
#pragma unroll
                for (int n = 0; n < 2; ++n) acc[a][b][m][n] = (f32x4){0.f, 0.f, 0.f, 0.f};
    bf16x8 At[4][2], B0[2][2], B1[2][2];
    const char* cA = (const char*)g.A + (size_t)cur.pm * tstep; const char* cB = (const char*)g.Bt + (size_t)cur.pn * tstep;
    S.a_ready(cur);
    if constexpr (SP2) {
        PG8_STAGE(PG8_SB(0, 0), cB, voffB); PG8_STAGE(PG8_SB(0, 1), cB + hstep, voffB); PG8_STAGE(PG8_SA(0, 0), cA, voffA); PG8_STAGE(PG8_SA(0, 1), cA + hstep, voffA);
        if (wr == 1) PG8_BAR;
        PG8_WAIT_V(2); PG8_BAR;
        PG8_STAGE(PG8_SB(1, 0), cB + kstep, voffB); PG8_STAGE(PG8_SA(1, 0), cA + kstep, voffA); PG8_STAGE(PG8_SB(1, 1), cB + hstep + kstep, voffB);
        PG8_WAIT_V(6); PG8_BAR;
    } else {
        PG8_STAGE(PG8_SB(0, 0), cB, voffB); PG8_STAGE(PG8_SA(0, 0), cA, voffA); PG8_STAGE(PG8_SB(0, 1), cB + hstep, voffB); PG8_STAGE(PG8_SA(0, 1), cA + hstep, voffA);
        if (wr == 1) PG8_BAR;
        PG8_WAIT_V(4); PG8_BAR;
        PG8_STAGE(PG8_SB(1, 0), cB + kstep, voffB); PG8_STAGE(PG8_SA(1, 0), cA + kstep, voffA); PG8_STAGE(PG8_SB(1, 1), cB + hstep + kstep, voffB);
        PG8_WAIT_V(6); PG8_BAR;
    }
    for (;;) {
        const bool has_next = S.next(ui + 1, nxt);
        const char* nA = has_next ? (const char*)g.A + (size_t)nxt.pm * tstep : cA; const char* nB = has_next ? (const char*)g.Bt + (size_t)nxt.pn * tstep : cB;
        for (int t = 0; t < nt; t += 2) {
            const bool last = (t == nt - 2);
            const char* a1 = cA + (size_t)(t + 1) * kstep;
            const char* a2 = last ? nA : cA + (size_t)(t + 2) * kstep; const char* b2 = last ? nB : cB + (size_t)(t + 2) * kstep;
            const char* a3 = a2 + kstep; const char* b3 = b2 + kstep;
            if (last && has_next) S.a_ready(nxt);
            if constexpr (SP2) {
            PG8_LDB(B0, 0, 0); PG8_LDB(B1, 0, 1); PG8_SCHED; PG8_LDA(At, 0, 0); PG8_STAGE(PG8_SA(1, 1), a1 + hstep, voffA);
            PG8_WAIT_V(8); PG8_WAIT_L(0); PG8_BAR; PG8_MMA(0, 0, At, B0); PG8_MMA(0, 1, At, B1); PG8_BAR; PG8_SCHED;
            PG8_LDA(At, 0, 1); PG8_STAGE(PG8_SB(0, 0), b2, voffB); PG8_STAGE(PG8_SB(0, 1), b2 + hstep, voffB); PG8_STAGE(PG8_SA(0, 0), a2, voffA);
            PG8_WAIT_V(8); PG8_WAIT_L(0); PG8_BAR; PG8_MMA(1, 0, At, B0); PG8_MMA(1, 1, At, B1); PG8_BAR; PG8_SCHED;
            PG8_LDB(B0, 1, 0); PG8_LDB(B1, 1, 1); PG8_SCHED; PG8_LDA(At, 1, 0); PG8_STAGE(PG8_SA(0, 1), a2 + hstep, voffA);
            PG8_WAIT_V(8); PG8_WAIT_L(0); PG8_BAR; PG8_MMA(0, 0, At, B0); PG8_MMA(0, 1, At, B1); PG8_BAR; PG8_SCHED;
            PG8_LDA(At, 1, 1); PG8_STAGE(PG8_SB(1, 0), b3, voffB); PG8_STAGE(PG8_SB(1, 1), b3 + hstep, voffB); PG8_STAGE(PG8_SA(1, 0), a3, voffA);
            PG8_WAIT_V(8); PG8_WAIT_L(0); PG8_BAR; PG8_MMA(1, 0, At, B0); PG8_MMA(1, 1, At, B1); PG8_BAR; PG8_SCHED;
            } else {
            PG8_LDB(B0, 0, 0); PG8_SCHED; PG8_LDA(At, 0, 0); PG8_STAGE(PG8_SA(1, 1), a1 + hstep, voffA);
            PG8_WAIT_L(8); PG8_BAR; PG8_WAIT_L(0); PG8_MMA(0, 0, At, B0); PG8_BAR; PG8_SCHED;
            PG8_LDB(B1, 0, 1); PG8_STAGE(PG8_SB(0, 0), b2, voffB);
            PG8_BAR; PG8_WAIT_L(0); PG8_MMA(0, 1, At, B1); PG8_BAR;
            PG8_LDA(At, 0, 1); PG8_STAGE(PG8_SA(0, 0), a2, voffA);
            PG8_BAR; PG8_WAIT_L(0); PG8_MMA(1, 0, At, B0); PG8_BAR; PG8_SCHED;
            PG8_STAGE(PG8_SB(0, 1), b2 + hstep, voffB);
            PG8_WAIT_V(6); PG8_BAR; PG8_MMA(1, 1, At, B1); PG8_BAR;
            PG8_LDB(B0, 1, 0); PG8_SCHED; PG8_LDA(At, 1, 0); PG8_STAGE(PG8_SA(0, 1), a2 + hstep, voffA);
            PG8_WAIT_L(8); PG8_BAR; PG8_WAIT_L(0); PG8_MMA(0, 0, At, B0); PG8_BAR; PG8_SCHED;
            PG8_LDB(B1, 1, 1); PG8_STAGE(PG8_SB(1, 0), b3, voffB);
            PG8_BAR; PG8_WAIT_L(0); PG8_MMA(0, 1, At, B1); PG8_BAR;
            PG8_LDA(At, 1, 1); PG8_STAGE(PG8_SA(1, 0), a3, voffA);
            PG8_BAR; PG8_WAIT_L(0); PG8_MMA(1, 0, At, B0); PG8_BAR; PG8_SCHED;
            PG8_STAGE(PG8_SB(1, 1), b3 + hstep, voffB);
            PG8_WAIT_V(6); PG8_BAR; PG8_MMA(1, 1, At, B1); PG8_BAR;
            }
        }
        if constexpr (ALIGN_EPI) { if (wr == 0) PG8_BAR; }
        if constexpr (!Epi::AFTER_DRAIN) { E(acc, cur, wr, wc, fr, fq); S.done(cur); }
        if (!has_next) break;
#pragma unroll
        for (int a = 0; a < 2; ++a)
#pragma unroll
            for (int b = 0; b < 2; ++b)
#pragma unroll
                for (int m = 0; m < 4; ++m)
#pragma unroll
                    for (int n = 0; n < 2; ++n) acc[a][b][m][n] = (f32x4){0.f, 0.f, 0.f, 0.f};
        cur = nxt; cA = nA; cB = nB; ++ui;
        if constexpr (ALIGN_EPI) { if (wr == 1) PG8_BAR; }
    }
    PG8_WAIT_V(0);
    if constexpr (!ALIGN_EPI) { if (wr == 0) PG8_BAR; }
    PG8_BAR;
    if constexpr (Epi::AFTER_DRAIN) { E.fused(acc, cur, wr, wc, fr, fq, lds, wid, lane); S.done(cur); }
#undef PG8_SA
#undef PG8_SB
#undef PG8_STAGE
#undef PG8_LDA
#undef PG8_LDB
#undef PG8_MMA
#undef PG8_WAIT_V
#undef PG8_WAIT_L
#undef PG8_BAR
#undef PG8_SCHED
}
}
constexpr int NWAVES = 8;
constexpr int DM = 1024, MP = 32768, MS = 1024, MT = MP + MS;
constexpr int NIN = 4352;
constexpr int FFH = 2816;
constexpr size_t MiB = 1u << 20;
constexpr size_t WS_CTL = 0, CTL_ZERO_BYTES = 1 * MiB;
constexpr size_t WS_SSQX = 1 * MiB, WS_SSQA = 13 * MiB / 4, WS_SSQB = 11 * MiB / 2, WS_AB = 31 * MiB / 4;
constexpr size_t WS_WIN = 16 * MiB, WS_WOUT = 25 * MiB, WS_WGU0 = 27 * MiB, WS_WGU1 = 38 * MiB, WS_WDN0 = 49 * MiB, WS_WDN1 = 55 * MiB,
                 WS_WGT0 = 61 * MiB, WS_WGT1 = 63 * MiB, WS_WPJ0 = 65 * MiB, WS_WPJ1 = 66 * MiB, WS_WKVQ = 67 * MiB, WS_WO = 70 * MiB;
constexpr size_t WS_PEB = 72 * MiB, WS_XB = 436 * MiB, WS_QKV = 172 * MiB, WS_Z = 370 * MiB, WS_END = 511 * MiB;
constexpr size_t WS_UTB = 106 * MiB, WS_OG = WS_UTB;
constexpr size_t WS_QKM = 436 * MiB, WS_SCL = 10 * MiB, WS_HALO = 502 * MiB;
constexpr size_t WS_HA = 436 * MiB, WS_HB = WS_Z, WS_PP = 106 * MiB, WS_ACT = WS_QKV, WS_KV = 172 * MiB, WS_Q = 205 * MiB, WS_OB = 271 * MiB;
constexpr int CW_BAR = 4096;
constexpr size_t O_Y = 0, O_SDP = (size_t)MT * DM, O_SDS = O_SDP + 2097152, O_SCP = O_SDS + 16777216, O_SCS = O_SCP + 147456,
                 O_KWP = O_SCS + 1179648, O_KWS = O_KWP + 524288, O_VWP = O_KWS + 4194304, O_VWS = O_VWP + 524288, O_END = O_VWS + 4194304;
constexpr int RING_OFF = 0, RING_BYTES = 131072, LDS_BYTES = 163840, LDSCTL_OFF = LDS_BYTES - 1024, MISC_OFF = LDSCTL_OFF + 320;

#define GAS __attribute__((address_space(1)))
#define LAS __attribute__((address_space(3)))
typedef unsigned short bf16;
typedef unsigned v4u __attribute__((ext_vector_type(4)));
typedef float f32x4 __attribute__((ext_vector_type(4)));
typedef GAS unsigned gu32;
#define RLX_AGENT __ATOMIC_RELAXED, __HIP_MEMORY_SCOPE_AGENT
#define LDS_WAIT() asm volatile("s_waitcnt lgkmcnt(0)" ::: "memory")
#define VM_WAIT() asm volatile("s_waitcnt vmcnt(0)" ::: "memory")
__device__ __forceinline__ unsigned f2bf(float f) { unsigned u = __builtin_bit_cast(unsigned, f); return (u + 0x7fffu + ((u >> 16) & 1u)) >> 16; }
__device__ __forceinline__ unsigned pk2(float lo, float hi) { return f2bf(lo) | (f2bf(hi) << 16); }
__device__ __forceinline__ float bf2f(unsigned short b) { return __uint_as_float((unsigned)b << 16); }
using pg8::sigmoidf_;
__device__ __forceinline__ float dot4s(const f32x4 a) { return (a[0] * a[0] + a[1] * a[1]) + (a[2] * a[2] + a[3] * a[3]); }
__device__ __forceinline__ float wave_sum(float v) {
#pragma unroll
    for (int o = 1; o < 64; o <<= 1) v += __shfl_xor(v, o);
    return v;
}
#define XB_TMO      128
#define XB_XCNT(j)  (256  + 64 * (j))
#define XB_XSUB(j)  (1280 + 64 * (j))
#define XB_XGEN(j)  (2304 + 64 * (j))
#define XB_TOP      3328
#define XB_TOPGEN   3392
#define XCD_BAR_WORDS 3456
#define XB_SPIN_CAP (1u << 18)

__device__ __forceinline__ unsigned xb_ld(unsigned* p)              { return __hip_atomic_load(p, __ATOMIC_RELAXED, __HIP_MEMORY_SCOPE_AGENT); }
__device__ __forceinline__ unsigned xb_add(unsigned* p, unsigned v) { return __hip_atomic_fetch_add(p, v, __ATOMIC_RELAXED, __HIP_MEMORY_SCOPE_AGENT); }
__device__ __forceinline__ unsigned xb_xcc_id() { return (unsigned)__builtin_amdgcn_s_getreg((3 << 11) | 20) & 0xFu; }
#define XB_SPIN(cond, bar) do { unsigned _sp = 0; while (cond) { __builtin_amdgcn_s_sleep(1); \
    if ((++_sp & 255u) == 0u) { if (xb_ld(&(bar)[XB_TMO])) break; if (_sp > XB_SPIN_CAP) { atomicAdd(&(bar)[XB_TMO], 1u); break; } } } } while (0)

struct XcdBarrier {
    unsigned* bar; unsigned x;
    volatile LAS unsigned* st;
};

__device__ __forceinline__ XcdBarrier xcd_barrier_post(unsigned* bar, volatile LAS unsigned* st) {
    XcdBarrier b; b.bar = bar; b.x = xb_xcc_id(); b.st = st;
    if (threadIdx.x == 0) (void)xb_add(&bar[XB_XCNT(b.x)], 1u);
    return b;
}
__device__ __forceinline__ void xcd_barrier_complete(unsigned* bar, unsigned x, unsigned& nloc, unsigned& nx) {
    const unsigned G = gridDim.x * gridDim.y * gridDim.z;
    unsigned sum, cnt, mine, sp = 0u;
    for (;;) {
        sum = 0u; cnt = 0u; mine = 0u;
#pragma unroll
        for (unsigned j = 0; j < 16; ++j) { const unsigned c = xb_ld(&bar[XB_XCNT(j)]); sum += c; cnt += (c > 0u) ? 1u : 0u; mine = (j == x) ? c : mine; }
        if (sum == G) break;
        __builtin_amdgcn_s_sleep(1);
        if ((++sp & 255u) == 0u) { if (xb_ld(&bar[XB_TMO])) break; if (sp > XB_SPIN_CAP) { atomicAdd(&bar[XB_TMO], 1u); break; } }
    }
    nloc = mine > 0u ? mine : 1u; nx = cnt > 0u ? cnt : 1u;
}

__device__ __forceinline__ void xcd_barrier(const XcdBarrier& b) {
    asm volatile("s_waitcnt vmcnt(0)" ::: "memory");
    __syncthreads();
    if (threadIdx.x == 0) {
        unsigned* bar = b.bar;
        __builtin_amdgcn_s_waitcnt(0);
        unsigned nloc = b.st[0], nx = b.st[1];
        if (nloc == 0u) { xcd_barrier_complete(bar, b.x, nloc, nx); b.st[0] = nloc; b.st[1] = nx; }
        const unsigned old = xb_add(&bar[XB_XSUB(b.x)], 1u);
        const unsigned gen = old / nloc;
        if (old + 1u == (gen + 1u) * nloc) {
            __builtin_amdgcn_fence(__ATOMIC_RELEASE, "agent");
            asm volatile("s_waitcnt vmcnt(0)" ::: "memory");
            const unsigned og = xb_add(&bar[XB_TOP], 1u);
            const unsigned tg = og / nx;
            if (og + 1u == (tg + 1u) * nx) xb_add(&bar[XB_TOPGEN], 1u);
            else XB_SPIN(xb_ld(&bar[XB_TOPGEN]) == tg, bar);
            __builtin_amdgcn_fence(__ATOMIC_ACQUIRE, "agent");
            xb_add(&bar[XB_XGEN(b.x)], 1u);
            asm volatile("s_waitcnt vmcnt(0)" ::: "memory");
        } else {
            XB_SPIN(xb_ld(&bar[XB_XGEN(b.x)]) == gen, bar);
            __builtin_amdgcn_fence(__ATOMIC_ACQUIRE, "agent");
            asm volatile("s_waitcnt vmcnt(0)" ::: "memory");
        }
    }
    __syncthreads();
}
struct Args { const float* in[28]; float* out; unsigned char* ws; int ph_lo, ph_hi, li, pad; };
typedef const __attribute__((address_space(4))) Args* cargs_t;
__device__ __forceinline__ cargs_t argp() { cargs_t p = (cargs_t)__builtin_amdgcn_kernarg_segment_ptr(); asm volatile("" : "+s"(p)); return p; }
struct Frame {
    LAS unsigned char* lds;
    volatile LAS unsigned* MISC;
    gu32* ctl;
    int tid, lane, wave, vcu, G;
    const float* const* in;
};

__device__ __forceinline__ void p0_transpose_item(const float* W, int K, int N, const float* gain, bf16* WT, int drow0, LAS float* scr, int k0, int n0, int lane) {
    const int lr = lane >> 4, lc = (lane & 15) * 4;
#pragma unroll 4
    for (int i = 0; i < 16; ++i) { const int kk = 4 * i + lr; f32x4 w = *(const GAS f32x4*)(W + (size_t)(k0 + kk) * N + n0 + lc); if (gain) w = w * gain[k0 + kk];
        LAS float* d = scr + kk * 65 + lc; d[0] = w.x; d[1] = w.y; d[2] = w.z; d[3] = w.w; }
    LDS_WAIT(); asm volatile("" ::: "memory");
    const int c = lane & 7;
#pragma unroll
    for (int j = 0; j < 8; ++j) { const int n = (lane >> 3) + 8 * j; const LAS float* s = scr + (8 * c) * 65 + n;
        v4u o; o.x = pk2(s[0 * 65], s[1 * 65]); o.y = pk2(s[2 * 65], s[3 * 65]); o.z = pk2(s[4 * 65], s[5 * 65]); o.w = pk2(s[6 * 65], s[7 * 65]);
        *(GAS v4u*)(WT + (size_t)(drow0 + n) * K + k0 + 8 * c) = o; }
    LDS_WAIT(); asm volatile("" ::: "memory");
}
struct WDesc { const float* W; const float* gain; bf16* WT; int K, N, Nuse, kind, roff; };
__device__ __forceinline__ void p0_weight(const WDesc& d, int item, LAS float* scr, int lane) {
    const int nblk = d.Nuse / 64, kb = item / nblk, nb = item % nblk, n0 = 64 * nb;
    int drow0;
    if (d.kind == 0) drow0 = d.roff + n0;
    else { const int up = n0 >= FFH, j = up ? n0 - FFH : n0; drow0 = (j >> 7) * 256 + (up ? 128 : 0) + (j & 127); }
    p0_transpose_item(d.W, d.K, d.N, d.gain, d.WT, drow0, scr, 64 * kb, n0, lane);
}
__device__ __forceinline__ void p0_prologue(Frame& F, cargs_t a, int part, int gw, int NGW) {
    unsigned char* ws = a->ws;
    LAS float* scr = (LAS float*)(F.lds + RING_OFF + F.wave * 17408);
    const unsigned wmask = (part == 0) ? 0x0001u : (part == 1) ? 0x1FFEu : (part == 2) ? 0x1FFFu : (part == 3) ? 0x0156u : (part == 4) ? 0x1C08u : (part == 5) ? 0x02A0u : 0u;
    const bool do_x = part == 0 || part == 2; const int pe_lo = (part == 1 || part == 2 || part == 3) ? 0 : 2, pe_hi = (part == 1 || part == 2 || part == 3) ? 2 : 0;
    constexpr int NW = 13;
    int it0 = 0;
#pragma unroll 1
    for (int w = 0; w < 13; ++w) {
        if (!((wmask >> w) & 1u)) continue;
        WDesc d;
        switch (w) {
        case 0:  d = WDesc{a->in[9],  a->in[8],  (bf16*)(ws + WS_WIN),  1024, 4112, 4096, 0, 0}; break;
        case 1:  d = WDesc{a->in[14], nullptr,  (bf16*)(ws + WS_WOUT), 1024, 1024, 1024, 0, 0}; break;
        case 2:  d = WDesc{a->in[22], a->in[21], (bf16*)(ws + WS_WGU0), 1024, 5632, 5632, 1, 0}; break;
        case 3:  d = WDesc{a->in[22] + (size_t)1024 * 5632, a->in[21] + 1024, (bf16*)(ws + WS_WGU1), 1024, 5632, 5632, 1, 0}; break;
        case 4:  d = WDesc{a->in[23], nullptr,  (bf16*)(ws + WS_WDN0), 2816, 1024, 1024, 0, 0}; break;
        case 5:  d = WDesc{a->in[23] + (size_t)2816 * 1024, nullptr, (bf16*)(ws + WS_WDN1), 2816, 1024, 1024, 0, 0}; break;
        case 6:  d = WDesc{a->in[26], a->in[24], (bf16*)(ws + WS_WGT0), 1024, 1024, 1024, 0, 0}; break;
        case 7:  d = WDesc{a->in[26] + (size_t)1024 * 1024, a->in[24] + 1024, (bf16*)(ws + WS_WGT1), 1024, 1024, 1024, 0, 0}; break;
        case 8:  d = WDesc{a->in[25], nullptr,  (bf16*)(ws + WS_WPJ0), 256, 1024, 1024, 0, 0}; break;
        case 9:  d = WDesc{a->in[25] + (size_t)256 * 1024, nullptr, (bf16*)(ws + WS_WPJ1), 256, 1024, 1024, 0, 0}; break;
        case 10: d = WDesc{a->in[16], a->in[15], (bf16*)(ws + WS_WKVQ), 1024, 512, 512, 0, 0}; break;
        case 11: d = WDesc{a->in[18], a->in[17], (bf16*)(ws + WS_WKVQ), 1024, 1024, 1024, 0, 512}; break;
        default: d = WDesc{a->in[20], nullptr,  (bf16*)(ws + WS_WO),   1024, 1024, 1024, 0, 0}; break;
        }
        const int nitems = (d.K / 64) * (d.Nuse / 64);
        int first = (gw - (it0 % NGW) + NGW) % NGW;
        for (int item = first; item < nitems; item += NGW) p0_weight(d, item, scr, F.lane);
        it0 += nitems;
    }
    if (do_x) {
        bf16* WT = (bf16*)(ws + WS_WIN); const float* W = a->in[9]; const float* g = a->in[8];
        const int gt = gw * 64 + F.lane, NGT = NGW * 64;
        for (int e = gt; e < 256 * 1024; e += NGT) { const int n = 4096 + (e >> 10), k = e & 1023; WT[(size_t)n * 1024 + k] = (n < 4112) ? (bf16)f2bf(W[(size_t)k * 4112 + n] * g[k]) : (bf16)0; }
    }
    if (do_x) {
        bf16* XB = (bf16*)(ws + WS_XB); float* SSQ = (float*)(ws + WS_SSQX);
        for (int m = gw; m < MT; m += NGW) {
            const float* xrow = (m < MP) ? a->in[0] + (size_t)m * DM : a->in[1] + (size_t)(m - MP) * DM;
            const GAS f32x4* xr = (const GAS f32x4*)xrow + F.lane;
            f32x4 v[4]; float s = 0.f;
#pragma unroll
            for (int j = 0; j < 4; ++j) { v[j] = xr[64 * j]; s += (v[j].x * v[j].x + v[j].y * v[j].y) + (v[j].z * v[j].z + v[j].w * v[j].w); }
            s = wave_sum(s);
            GAS unsigned long long* o8 = (GAS unsigned long long*)(XB + (size_t)m * DM) + F.lane;
#pragma unroll
            for (int j = 0; j < 4; ++j) o8[64 * j] = (unsigned long long)pk2(v[j].x, v[j].y) | ((unsigned long long)pk2(v[j].z, v[j].w) << 32);
            if (F.lane < 16) SSQ[(size_t)m * 16 + F.lane] = (F.lane == 0) ? s : 0.f;
        }
    }
    if (pe_lo < pe_hi) {
        bf16* PEB = (bf16*)(ws + WS_PEB);
        const size_t gt = (size_t)gw * 64 + F.lane, NGT = (size_t)NGW * 64;
        const size_t nlayer = (size_t)MT * 256 / 8, nchunk = (size_t)pe_hi * nlayer;
        for (size_t c = (size_t)pe_lo * nlayer + gt; c < nchunk; c += NGT) {
            const size_t e = c * 8; const int l = (int)(e / ((size_t)MT * 256)); const size_t rem = e - (size_t)l * MT * 256; const size_t row = rem >> 8; const int col = (int)(rem & 255);
            const float* src = (row < (size_t)MP) ? a->in[6] + ((size_t)l * MP + row) * 256 + col : a->in[7] + ((size_t)l * MS + (row - MP)) * 256 + col;
            const f32x4 v0 = *(const GAS f32x4*)src, v1 = *(const GAS f32x4*)(src + 4);
            v4u o; o.x = pk2(v0.x, v0.y); o.y = pk2(v0.z, v0.w); o.z = pk2(v1.x, v1.y); o.w = pk2(v1.z, v1.w);
            *(GAS v4u*)(PEB + e) = o;
        }
    }
}

__device__ __forceinline__ void delta_seq_item(Frame& F, cargs_t a, int item) {
    unsigned char* ws = a->ws;
    const int tid = F.tid, kq = tid >> 7, v = tid & 127, wave = F.wave, lane = F.lane;
    const bool prompt = item < 128;
    int b, h, T; size_t rowbase;
    if (prompt) { b = item >> 3; h = item & 7; T = 2048; rowbase = (size_t)b * 2048; }
    else { const int it = item - 128; b = it >> 3; h = it & 7; T = 8; rowbase = (size_t)MP + (size_t)b * 8; }
    LAS float* L = (LAS float*)(F.lds + RING_OFF);
    LAS float* vec = L;
    LAS float* red = L + 384;
    LAS float* part = L + 512;
    LAS float* opart = L + 1024;
    LAS float* red2 = L + 1536;
    float S[32];
    if (prompt) {
#pragma unroll
        for (int i = 0; i < 32; ++i) S[i] = 0.f;
    } else {
        const float* sd = a->in[2] + ((size_t)(b * 8 + h) * 128 + 32 * kq) * 128 + v;
#pragma unroll
        for (int i = 0; i < 32; ++i) S[i] = sd[(size_t)i * 128];
    }
    const int ch = kq * 1024 + h * 128 + v;
    float cw0 = 0.f, cw1 = 0.f, cw2 = 0.f, cw3 = 0.f, xm3 = 0.f, xm2 = 0.f, xm1 = 0.f;
    if (kq < 3) {
        const float* cw = a->in[10];
        cw0 = cw[ch]; cw1 = cw[3072 + ch]; cw2 = cw[2 * 3072 + ch]; cw3 = cw[3 * 3072 + ch];
        if (!prompt) { const float* sc = a->in[3] + (size_t)b * 3 * 3072 + ch; xm3 = sc[0]; xm2 = sc[3072]; xm1 = sc[2 * 3072]; }
    }
    const float Aneg = -__expf(a->in[11][h]), dtb = a->in[12][h], outg = a->in[13][v];
    const bf16* xsrc = (kq < 3) ? (const bf16*)(ws + WS_QKV) + rowbase * 3072 + ch : (const bf16*)(ws + WS_Z) + rowbase * 1024 + h * 128 + v;
    const size_t xstride = (kq < 3) ? 3072 : 1024;
    const float* absrc = (const float*)(ws + WS_AB) + rowbase * 16 + h;
    bf16* og = (bf16*)(ws + WS_OG) + rowbase * 1024 + h * 128 + v;
    unsigned short xs[8]; float aa[8], bb[8];
#pragma unroll
    for (int j = 0; j < 8; ++j) { xs[j] = xsrc[(size_t)j * xstride]; aa[j] = absrc[(size_t)j * 16]; bb[j] = absrc[(size_t)j * 16 + 8]; }
    float o_prev = 0.f, z_prev = 0.f; bool have_prev = false;
    __syncthreads();
    for (int t0 = 0; t0 < T; t0 += 8) {
        unsigned short xc[8]; float ac[8], bc[8];
#pragma unroll
        for (int j = 0; j < 8; ++j) { xc[j] = xs[j]; ac[j] = aa[j]; bc[j] = bb[j]; }
        if (t0 + 8 < T) {
#pragma unroll
            for (int j = 0; j < 8; ++j) { xs[j] = xsrc[(size_t)(t0 + 8 + j) * xstride]; aa[j] = absrc[(size_t)(t0 + 8 + j) * 16]; bb[j] = absrc[(size_t)(t0 + 8 + j) * 16 + 8]; }
        }
#pragma unroll
        for (int tt = 0; tt < 8; ++tt) {
            const float x = bf2f(xc[tt]);
            float zcur = 0.f;
            if (kq < 3) {
                const float c = (xm3 * cw0 + xm2 * cw1) + (xm1 * cw2 + x * cw3);
                xm3 = xm2; xm2 = xm1; xm1 = x;
                const float s = c * sigmoidf_(c);
                vec[kq * 128 + v] = s;
                if (kq < 2) { const float q2 = wave_sum(s * s); if (lane == 0) red[wave] = q2; }
            } else zcur = x;
            __syncthreads();
            if (kq == 3 && have_prev) {
                const float tot = red2[0] + red2[1];
                const float ov = o_prev * rsqrtf(tot * (1.0f / 128.0f) + 1e-6f) * outg * (z_prev * sigmoidf_(z_prev));
                og[(size_t)(t0 + tt - 1) * 1024] = (bf16)f2bf(ov);
            }
            const float rq = rsqrtf(red[0] + red[1] + 1e-6f) * 0.08838834764831845f, rk = rsqrtf(red[2] + red[3] + 1e-6f);
            const float beta = sigmoidf_(bc[tt]);
            const float sp_in = ac[tt] + dtb; const float sp = (sp_in > 15.f) ? sp_in : log1pf(__expf(sp_in));
            const float adec = __expf(Aneg * sp);
            float kv[32];
            {
                float p = 0.f;
#pragma unroll
                for (int i = 0; i < 8; ++i) { const f32x4 k4 = *(const LAS f32x4*)(vec + 128 + 32 * kq + 4 * i); kv[4 * i] = k4[0]; kv[4 * i + 1] = k4[1]; kv[4 * i + 2] = k4[2]; kv[4 * i + 3] = k4[3];
                    p += (k4[0] * S[4 * i] + k4[1] * S[4 * i + 1]) + (k4[2] * S[4 * i + 2] + k4[3] * S[4 * i + 3]); }
                part[kq * 128 + v] = p;
            }
            __syncthreads();
            {
                const float kS = rk * ((part[v] + part[128 + v]) + (part[256 + v] + part[384 + v]));
                const float d = beta * (vec[256 + v] - adec * kS) * rk;
                float po = 0.f;
#pragma unroll
                for (int i = 0; i < 8; ++i) { const f32x4 q4 = *(const LAS f32x4*)(vec + 32 * kq + 4 * i);
#pragma unroll
                    for (int j = 0; j < 4; ++j) { S[4 * i + j] = adec * S[4 * i + j] + kv[4 * i + j] * d; po += q4[j] * S[4 * i + j]; } }
                opart[kq * 128 + v] = po * rq;
            }
            __syncthreads();
            if (kq == 3) {
                const float o = (opart[v] + opart[128 + v]) + (opart[256 + v] + opart[384 + v]);
                const float o2 = wave_sum(o * o); if (lane == 0) red2[wave - 6] = o2;
                o_prev = o; z_prev = zcur;
            }
            have_prev = true;
        }
    }
    __syncthreads();
    if (kq == 3) {
        const float tot = red2[0] + red2[1];
        const float ov = o_prev * rsqrtf(tot * (1.0f / 128.0f) + 1e-6f) * outg * (z_prev * sigmoidf_(z_prev));
        og[(size_t)(T - 1) * 1024] = (bf16)f2bf(ov);
    }
    {
        float* so = a->out + (prompt ? O_SDP : O_SDS) + ((size_t)(b * 8 + h) * 128 + 32 * kq) * 128 + v;
#pragma unroll
        for (int i = 0; i < 32; ++i) so[(size_t)i * 128] = S[i];
    }
}

__device__ __forceinline__ void delta_seq_samples(Frame& F, cargs_t a, int it0, int itstride, int itend) {
    unsigned char* ws = a->ws;
    const int tid = F.tid, kq = tid >> 7, v = tid & 127, wave = F.wave, lane = F.lane;
    LAS float* L = (LAS float*)(F.lds + RING_OFF);
    LAS float* vec = L;
    LAS float* zbuf = L + 3072;
    LAS float* part = L + 4096;
    LAS float* opart = L + 5120;
    LAS float* red = L + 9216;
    LAS float* red2 = L + 9248;
    const float outg = a->in[13][v];
    f32x4 Sp[8]; float aap[8], bbp[8], xmp[3], cwp[4], hp[2]; unsigned short xsp[8];
#define DS_PRE(it_) do { const int b_ = (it_) >> 3, h_ = (it_) & 7; const size_t rb_ = (size_t)MP + (size_t)b_ * 8; const int ch_ = kq * 1024 + h_ * 128 + v; \
        const float* sd_ = a->in[2] + ((size_t)(b_ * 8 + h_) * 128 + 32 * kq) * 128 + v; \
        _Pragma("unroll") for (int i = 0; i < 32; ++i) Sp[i >> 2][i & 3] = sd_[(size_t)i * 128]; \
        const bf16* xsrc_ = (kq < 3) ? (const bf16*)(ws + WS_QKV) + rb_ * 3072 + ch_ : (const bf16*)(ws + WS_Z) + rb_ * 1024 + h_ * 128 + v; \
        const size_t xstride_ = (kq < 3) ? 3072 : 1024; const float* absrc_ = (const float*)(ws + WS_AB) + rb_ * 16 + h_; \
        _Pragma("unroll") for (int j = 0; j < 8; ++j) { xsp[j] = xsrc_[(size_t)j * xstride_]; aap[j] = absrc_[(size_t)j * 16]; bbp[j] = absrc_[(size_t)j * 16 + 8]; } \
        if (kq < 3) { const float* cw_ = a->in[10]; cwp[0] = cw_[ch_]; cwp[1] = cw_[3072 + ch_]; cwp[2] = cw_[2 * 3072 + ch_]; cwp[3] = cw_[3 * 3072 + ch_]; \
            const float* sc_ = a->in[3] + (size_t)b_ * 3 * 3072 + ch_; xmp[0] = sc_[0]; xmp[1] = sc_[3072]; xmp[2] = sc_[2 * 3072]; } \
        hp[0] = a->in[11][h_]; hp[1] = a->in[12][h_]; } while (0)
    if (it0 < itend) DS_PRE(it0);
#pragma unroll 1
    for (int it = it0; it < itend; it += itstride) {
        const int b = it >> 3, h = it & 7; const size_t rowbase = (size_t)MP + (size_t)b * 8;
        f32x4 S[8]; float ac[8], bc[8]; unsigned short xc[8];
#pragma unroll
        for (int i = 0; i < 8; ++i) S[i] = Sp[i];
#pragma unroll
        for (int j = 0; j < 8; ++j) { xc[j] = xsp[j]; ac[j] = aap[j]; bc[j] = bbp[j]; }
        float cw0 = 0.f, cw1 = 0.f, cw2 = 0.f, cw3 = 0.f, xm3 = 0.f, xm2 = 0.f, xm1 = 0.f;
        if (kq < 3) { cw0 = cwp[0]; cw1 = cwp[1]; cw2 = cwp[2]; cw3 = cwp[3]; xm3 = xmp[0]; xm2 = xmp[1]; xm1 = xmp[2]; }
        const float Aneg = -__expf(hp[0]), dtb = hp[1];
        asm volatile("" ::: "memory");
        if (it + itstride < itend) DS_PRE(it + itstride);
        bf16* og = (bf16*)(ws + WS_OG) + rowbase * 1024 + h * 128 + v;
        __syncthreads();
#pragma unroll
        for (int tt = 0; tt < 8; ++tt) {
            const float x = bf2f(xc[tt]);
            if (kq < 3) {
                const float c = (xm3 * cw0 + xm2 * cw1) + (xm1 * cw2 + x * cw3);
                xm3 = xm2; xm2 = xm1; xm1 = x;
                const float s = c * sigmoidf_(c);
                vec[(tt * 3 + kq) * 128 + v] = s;
                if (kq < 2) { const float q2 = wave_sum(s * s); if (lane == 0) red[tt * 4 + wave] = q2; }
            } else zbuf[tt * 128 + v] = x;
        }
        __syncthreads();
#pragma unroll
        for (int tt = 0; tt < 8; ++tt) {
            f32x4 kv[8], qv[8];
            f32x4 pa = (f32x4){0.f, 0.f, 0.f, 0.f}, pb = (f32x4){0.f, 0.f, 0.f, 0.f};
#pragma unroll
            for (int i = 0; i < 8; ++i) kv[i] = *(const LAS f32x4*)(vec + (tt * 3 + 1) * 128 + 32 * kq + 4 * i);
#pragma unroll
            for (int i = 0; i < 8; i += 2) { pa += kv[i] * S[i]; pb += kv[i + 1] * S[i + 1]; }
            { const f32x4 ps = pa + pb; part[((tt & 1) * 4 + kq) * 128 + v] = (ps[0] + ps[1]) + (ps[2] + ps[3]); }
#pragma unroll
            for (int i = 0; i < 8; ++i) qv[i] = *(const LAS f32x4*)(vec + (tt * 3) * 128 + 32 * kq + 4 * i);
            const f32x4 rd = *(const LAS f32x4*)(red + tt * 4);
            const float vval = vec[(tt * 3 + 2) * 128 + v];
            const float rq = rsqrtf(rd[0] + rd[1] + 1e-6f) * 0.08838834764831845f, rk = rsqrtf(rd[2] + rd[3] + 1e-6f);
            const float beta = sigmoidf_(bc[tt]);
            const float sp_in = ac[tt] + dtb; const float sp = (sp_in > 15.f) ? sp_in : log1pf(__expf(sp_in));
            const float adec = __expf(Aneg * sp);
            __syncthreads();
            {
                LAS const float* pp = part + (tt & 1) * 512 + v;
                const float kS = rk * ((pp[0] + pp[128]) + (pp[256] + pp[384]));
                const float d = beta * (vval - adec * kS) * rk;
                f32x4 oa4 = (f32x4){0.f, 0.f, 0.f, 0.f}, ob4 = (f32x4){0.f, 0.f, 0.f, 0.f};
                const f32x4 ad4 = (f32x4){adec, adec, adec, adec}, d4 = (f32x4){d, d, d, d};
#pragma unroll
                for (int i = 0; i < 8; i += 2) { S[i] = kv[i] * d4 + ad4 * S[i]; S[i + 1] = kv[i + 1] * d4 + ad4 * S[i + 1]; oa4 += qv[i] * S[i]; ob4 += qv[i + 1] * S[i + 1]; }
                const f32x4 os = oa4 + ob4;
                opart[(tt * 4 + kq) * 128 + v] = ((os[0] + os[1]) + (os[2] + os[3])) * rq;
            }
        }
        __syncthreads();
        float oa, ob;
        {
            LAS const float* pa = opart + (kq * 4) * 128 + v; LAS const float* pb = opart + ((kq + 4) * 4) * 128 + v;
            oa = (pa[0] + pa[128]) + (pa[256] + pa[384]); ob = (pb[0] + pb[128]) + (pb[256] + pb[384]);
            const float sa = wave_sum(oa * oa), sb = wave_sum(ob * ob);
            if (lane == 0) { red2[kq * 2 + (wave & 1)] = sa; red2[(kq + 4) * 2 + (wave & 1)] = sb; }
        }
        __syncthreads();
        {
            const float ta = red2[kq * 2] + red2[kq * 2 + 1], tb2 = red2[(kq + 4) * 2] + red2[(kq + 4) * 2 + 1];
            const float za = zbuf[kq * 128 + v], zb = zbuf[(kq + 4) * 128 + v];
            og[(size_t)kq * 1024] = (bf16)f2bf(oa * rsqrtf(ta * (1.0f / 128.0f) + 1e-6f) * outg * (za * sigmoidf_(za)));
            og[(size_t)(kq + 4) * 1024] = (bf16)f2bf(ob * rsqrtf(tb2 * (1.0f / 128.0f) + 1e-6f) * outg * (zb * sigmoidf_(zb)));
        }
        {
            float* so = a->out + O_SDS + ((size_t)(b * 8 + h) * 128 + 32 * kq) * 128 + v;
#pragma unroll
            for (int i = 0; i < 32; ++i) so[(size_t)i * 128] = S[i >> 2][i & 3];
        }
    }
#undef DS_PRE
}

__device__ __forceinline__ void attn_sample_item(Frame& F, cargs_t a, int item) {
    unsigned char* ws = a->ws;
    const int kvh = item & 3, b = item >> 2;
    const int tid = F.tid;
    LAS float* Kf = (LAS float*)(F.lds + RING_OFF);
    LAS float* Vf = Kf + 136 * 64;
    LAS float* Sc = Vf + 136 * 64;
    const bf16* KV = (const bf16*)(ws + WS_KV);
    __syncthreads();
    {
        f32x4 cv[8];
#pragma unroll
        for (int i = 0; i < 8; ++i) { const int idx = tid + 512 * i, key = idx >> 5, c = idx & 31; const int isv = c >> 4, cc = c & 15;
            cv[i] = *(const GAS f32x4*)(a->in[isv ? 5 : 4] + ((size_t)(b * 128 + key) * 4 + kvh) * 64 + cc * 4); }
#pragma unroll
        for (int i = 0; i < 8; ++i) { const int idx = tid + 512 * i, key = idx >> 5, c = idx & 31; const int isv = c >> 4, cc = c & 15;
            *(LAS f32x4*)((isv ? Vf : Kf) + key * 64 + cc * 4) = cv[i];
            if (key >= 8) *(GAS f32x4*)(a->out + (isv ? O_VWS : O_KWS) + ((size_t)(b * 128 + key - 8) * 4 + kvh) * 64 + cc * 4) = cv[i]; }
    }
    for (int idx = tid; idx < 8 * 16; idx += 512) {
        const int t = idx >> 4, c = idx & 15;
        const v4u w = *(const GAS v4u*)(KV + ((size_t)MP + (size_t)b * 8 + t) * 512 + (c < 8 ? kvh * 64 + c * 8 : 256 + kvh * 64 + (c - 8) * 8));
        LAS float* dst = (c < 8 ? Kf + (128 + t) * 64 + c * 8 : Vf + (128 + t) * 64 + (c - 8) * 8);
        *(LAS f32x4*)dst = (f32x4){__uint_as_float(w.x << 16), __uint_as_float(w.x & 0xffff0000u), __uint_as_float(w.y << 16), __uint_as_float(w.y & 0xffff0000u)};
        *(LAS f32x4*)(dst + 4) = (f32x4){__uint_as_float(w.z << 16), __uint_as_float(w.z & 0xffff0000u), __uint_as_float(w.w << 16), __uint_as_float(w.w & 0xffff0000u)};
    }
    __syncthreads();
    const int r = tid & 31, ks = tid >> 5;
    const int t = r >> 2, g = r & 3, head = kvh * 4 + g;
    const size_t row = (size_t)MP + (size_t)b * 8 + t;
    {
        float q[64];
        const bf16* qp = (const bf16*)(ws + WS_Q) + row * 1024 + head * 64;
#pragma unroll
        for (int c = 0; c < 8; ++c) { const v4u w = *(const GAS v4u*)(qp + c * 8);
            q[c * 8 + 0] = __uint_as_float(w.x << 16); q[c * 8 + 1] = __uint_as_float(w.x & 0xffff0000u); q[c * 8 + 2] = __uint_as_float(w.y << 16); q[c * 8 + 3] = __uint_as_float(w.y & 0xffff0000u);
            q[c * 8 + 4] = __uint_as_float(w.z << 16); q[c * 8 + 5] = __uint_as_float(w.z & 0xffff0000u); q[c * 8 + 6] = __uint_as_float(w.w << 16); q[c * 8 + 7] = __uint_as_float(w.w & 0xffff0000u); }
        for (int j = ks; j < 136; j += 16) {
            const LAS float* kr = Kf + j * 64; float s = 0.f;
#pragma unroll
            for (int d = 0; d < 16; ++d) { const f32x4 k4 = *(const LAS f32x4*)(kr + 4 * d); s += (q[4 * d] * k4[0] + q[4 * d + 1] * k4[1]) + (q[4 * d + 2] * k4[2] + q[4 * d + 3] * k4[3]); }
            const bool ok = (j < 128) ? (j >= t + 1) : (j - 128 <= t);
            Sc[r * 136 + j] = ok ? s : -1e30f;
        }
    }
    __syncthreads();
    {
        const float sink = a->in[19][head];
        LAS float* red = Sc + 32 * 136;
        float mloc = -1e30f;
        for (int j = ks; j < 136; j += 16) mloc = fmaxf(mloc, Sc[r * 136 + j]);
        red[ks * 32 + r] = mloc;
        __syncthreads();
        float mx = sink;
#pragma unroll
        for (int i = 0; i < 16; ++i) mx = fmaxf(mx, red[i * 32 + r]);
        float lloc = 0.f;
        for (int j = ks; j < 136; j += 16) { const float p = __expf(Sc[r * 136 + j] - mx); Sc[r * 136 + j] = p; lloc += p; }
        red[512 + ks * 32 + r] = lloc;
        __syncthreads();
        float l = __expf(sink - mx);
#pragma unroll
        for (int i = 0; i < 16; ++i) l += red[512 + i * 32 + r];
        f32x4 o = (f32x4){0.f, 0.f, 0.f, 0.f};
#pragma unroll 8
        for (int j = 0; j < 136; ++j) { const float p = Sc[r * 136 + j]; const f32x4 v4 = *(const LAS f32x4*)(Vf + j * 64 + ks * 4); o += v4 * p; }
        const float inv = 1.0f / l;
        bf16* op = (bf16*)(ws + WS_OB) + row * 1024 + head * 64 + ks * 4;
        *(GAS unsigned long long*)op = (unsigned long long)pk2(o[0] * inv, o[1] * inv) | ((unsigned long long)pk2(o[2] * inv, o[3] * inv) << 32);
    }
}

__device__ __forceinline__ void final_norm(Frame& F, cargs_t a) {
    const int gw = F.vcu * NWAVES + F.wave, NGW = F.G * NWAVES;
    const GAS f32x4* gn = (const GAS f32x4*)a->in[27] + F.lane;
    f32x4 g[4];
#pragma unroll
    for (int j = 0; j < 4; ++j) g[j] = gn[64 * j];
    const bf16* H = (const bf16*)(a->ws + WS_HB); const float* SSQ = (const float*)(a->ws + WS_SSQB);
    for (int m = gw; m < MT; m += NGW) {
        unsigned long long w[4];
#pragma unroll
        for (int j = 0; j < 4; ++j) w[j] = *(const GAS unsigned long long*)(H + (size_t)m * DM + 4 * F.lane + 256 * j);
        float s = (F.lane < 16) ? SSQ[(size_t)m * 16 + F.lane] : 0.f;
        s = wave_sum(s);
        const float rstd = rsqrtf(s * (1.f / DM) + 1e-6f);
        GAS f32x4* yr = (GAS f32x4*)(a->out + O_Y + (size_t)m * DM) + F.lane;
#pragma unroll
        for (int j = 0; j < 4; ++j) { const unsigned lo = (unsigned)w[j], hi = (unsigned)(w[j] >> 32);
            const f32x4 v = (f32x4){__uint_as_float(lo << 16), __uint_as_float(lo & 0xffff0000u), __uint_as_float(hi << 16), __uint_as_float(hi & 0xffff0000u)};
            yr[64 * j] = v * rstd * g[j]; }
    }
}
typedef short bf16x8 __attribute__((ext_vector_type(8)));
typedef short bf16x4 __attribute__((ext_vector_type(4)));
typedef LAS const unsigned char* lcp;
#define LDS_BARRIER() do { asm volatile("s_waitcnt lgkmcnt(0)" ::: "memory"); __builtin_amdgcn_s_barrier(); asm volatile("" ::: "memory"); } while (0)
constexpr int PREP_HALF = 79872, PL_QKT = 71680;
constexpr int PL_KB = 0, PL_QB = 17408, PL_VB = 34816, PL_AM = 52224, PL_TB = 69632;
__device__ __forceinline__ unsigned cvtpk(float lo, float hi) { unsigned r; asm volatile("v_cvt_pk_bf16_f32 %0, %1, %2" : "=v"(r) : "v"(lo), "v"(hi)); return r; }
__device__ __forceinline__ f32x4 bfx4lo(unsigned a, unsigned b) { return (f32x4){__uint_as_float(a << 16), __uint_as_float(a & 0xffff0000u), __uint_as_float(b << 16), __uint_as_float(b & 0xffff0000u)}; }

#ifndef PROF_BLK
#define PROF_BLK 0
#endif
#ifdef PROF_A
#define ISTAMP(cond, k) do { if (((k) == PROF_A || (k) == PROF_AE || (k) == PROF_B || (k) == PROF_BE) && (cond) && blockIdx.x == PROF_BLK && threadIdx.x == 0) ((unsigned long long*)(a->ws + WS_CTL + 2048))[(k)] = __builtin_amdgcn_s_memrealtime(); } while (0)
#else
#define ISTAMP(cond, k) do { } while (0)
#endif
__device__ __forceinline__ void dprep_loop(Frame& F, cargs_t a) {
    unsigned char* ws = a->ws;
    int tid_ = threadIdx.x; asm volatile("" : "+v"(tid_));
    const int tid = tid_, half = tid >> 8, t8 = tid & 255, lane = tid & 63, w4 = (tid >> 6) & 3;
    LAS unsigned char* L = F.lds + RING_OFF + half * PREP_HALF;
    const int tg = t8 >> 4, cg = t8 & 15;
    v4u raw[3][7]; float abv[2];
#define DP_LOAD(pair_) do { const int it_ = 2 * (pair_) + half, c_ = it_ & 31, h_ = (it_ >> 5) & 7, b_ = it_ >> 8; const size_t t0_ = (size_t)b_ * 2048 + (size_t)c_ * 64; \
        const bf16* Q_ = (const bf16*)(ws + WS_QKV); const bf16* H_ = (const bf16*)(ws + WS_HALO); \
        _Pragma("unroll") for (int p_ = 0; p_ < 3; ++p_) { const int cb_ = p_ * 1024 + h_ * 128 + 8 * cg; \
            _Pragma("unroll") for (int i_ = 0; i_ < 7; ++i_) { const int lr_ = 4 * tg - 3 + i_; \
                if (lr_ >= 0) raw[p_][i_] = *(const GAS v4u*)(Q_ + (t0_ + lr_) * 3072 + cb_); \
                else if (c_ > 0) raw[p_][i_] = *(const GAS v4u*)(H_ + ((size_t)(b_ * 32 + c_ - 1) * 3 + (lr_ + 3)) * 3072 + cb_); \
                else raw[p_][i_] = (v4u){0u, 0u, 0u, 0u}; } } \
        if (w4 == 0) { const float* ab_ = (const float*)(ws + WS_AB) + (t0_ + lane) * 16 + h_; abv[0] = ab_[0]; abv[1] = ab_[8]; } } while (0)
#pragma unroll 1
    for (int pair = blockIdx.x; pair < 2048; pair += F.G) {
    DP_LOAD(pair);
    const int item = 2 * pair + half, c = item & 31, h = (item >> 5) & 7, b = item >> 8;
    const size_t t0 = (size_t)b * 2048 + (size_t)c * 64; const int chunkg = b * 32 + c;
    LAS float* TB = (LAS float*)(L + PL_TB);
    LAS float* AM = (LAS float*)(L + PL_AM);
    LDS_BARRIER();
    ISTAMP(pair == 256, 32);
    {
#pragma unroll
        for (int p = 0; p < 3; ++p) {
            const int colbase = p * 1024 + h * 128 + 8 * cg;
            const float* cw = a->in[10] + colbase;
            f32x4 w[4][2];
#pragma unroll
            for (int k = 0; k < 4; ++k) { w[k][0] = *(const GAS f32x4*)(cw + k * 3072); w[k][1] = *(const GAS f32x4*)(cw + k * 3072 + 4); }
            f32x4 o[4][2];
#pragma unroll
            for (int tok = 0; tok < 4; ++tok) { o[tok][0] = (f32x4){0.f, 0.f, 0.f, 0.f}; o[tok][1] = o[tok][0]; }
#pragma unroll
            for (int i = 0; i < 7; ++i) {
                const f32x4 x0 = bfx4lo(raw[p][i].x, raw[p][i].y), x1 = bfx4lo(raw[p][i].z, raw[p][i].w);
#pragma unroll
                for (int tok = 0; tok < 4; ++tok) { const int k = i - tok; if (k >= 0 && k < 4) { o[tok][0] += x0 * w[k][0]; o[tok][1] += x1 * w[k][1]; } }
            }
            LAS unsigned char* dst = L + (p == 0 ? PL_QB : (p == 1 ? PL_KB : PL_VB));
#pragma unroll
            for (int tok = 0; tok < 4; ++tok) {
                float ss = 0.f;
#pragma unroll
                for (int e = 0; e < 4; ++e) { float x = o[tok][0][e]; x = x * sigmoidf_(x); o[tok][0][e] = x; ss += x * x; float y = o[tok][1][e]; y = y * sigmoidf_(y); o[tok][1][e] = y; ss += y * y; }
                if (p < 2) {
                    ss += __shfl_xor(ss, 1); ss += __shfl_xor(ss, 2); ss += __shfl_xor(ss, 4); ss += __shfl_xor(ss, 8);
                    const float rn = rsqrtf(ss + 1e-6f) * (p == 0 ? 0.08838834764831845f : 1.0f);
                    o[tok][0] = o[tok][0] * rn; o[tok][1] = o[tok][1] * rn;
                }
                v4u pk; pk.x = cvtpk(o[tok][0][0], o[tok][0][1]); pk.y = cvtpk(o[tok][0][2], o[tok][0][3]); pk.z = cvtpk(o[tok][1][0], o[tok][1][1]); pk.w = cvtpk(o[tok][1][2], o[tok][1][3]);
                *(LAS v4u*)(dst + (4 * tg + tok) * 272 + cg * 16) = pk;
            }
        }
    }
    ISTAMP(pair == 256, 33);
    if (w4 == 0) {
        const float av = abv[0], bv = abv[1];
        const float Aneg = -__expf(a->in[11][h]), dtb = a->in[12][h];
        const float beta = sigmoidf_(bv);
        const float spi = av + dtb; const float sp = (spi > 15.f) ? spi : log1pf(__expf(spi));
        float gc = Aneg * sp;
#pragma unroll
        for (int o = 1; o < 64; o <<= 1) { const float t = __shfl_up(gc, o); if (lane >= o) gc += t; }
        const float glast = __shfl(gc, 63);
        const float eg = __expf(gc), ek = __expf(glast - gc);
        TB[lane] = beta; TB[64 + lane] = gc; TB[128 + lane] = eg; TB[192 + lane] = ek; TB[256 + lane] = beta; TB[320 + lane] = beta * eg;
        float* scl = (float*)(ws + WS_SCL) + ((size_t)chunkg * 8 + h) * 128;
        scl[lane] = eg; scl[64 + lane] = ek;
    }
    LDS_BARRIER();
    ISTAMP(pair == 256, 34);
    {
        const int fr = lane & 15, fq = lane >> 4;
        f32x4 kk[4], qq[4];
#pragma unroll
        for (int nt = 0; nt < 4; ++nt) { kk[nt] = (f32x4){0.f, 0.f, 0.f, 0.f}; qq[nt] = kk[nt]; }
#pragma unroll
        for (int ks = 0; ks < 4; ++ks) {
            const bf16x8 ak = *(const LAS bf16x8*)(L + PL_KB + (16 * w4 + fr) * 272 + ks * 64 + fq * 16);
            const bf16x8 aq = *(const LAS bf16x8*)(L + PL_QB + (16 * w4 + fr) * 272 + ks * 64 + fq * 16);
#pragma unroll
            for (int nt = 0; nt < 4; ++nt) {
                const bf16x8 bk = *(const LAS bf16x8*)(L + PL_KB + (16 * nt + fr) * 272 + ks * 64 + fq * 16);
                kk[nt] = __builtin_amdgcn_mfma_f32_16x16x32_bf16(ak, bk, kk[nt], 0, 0, 0);
                qq[nt] = __builtin_amdgcn_mfma_f32_16x16x32_bf16(aq, bk, qq[nt], 0, 0, 0);
            }
        }
#pragma unroll
        for (int j = 0; j < 4; ++j) {
            const int i = 16 * w4 + 4 * fq + j; const float gi = TB[64 + i], bi = TB[i];
#pragma unroll
            for (int nt = 0; nt < 4; ++nt) {
                const int jj = 16 * nt + fr; const float d = __expf(fminf(gi - TB[64 + jj], 0.f));
                AM[i * 68 + jj] = (i > jj) ? bi * kk[nt][j] * d : 0.f;
                ((LAS bf16*)(L + PL_QKT))[i * 64 + jj] = (bf16)f2bf((i >= jj) ? qq[nt][j] * d : 0.f);
            }
        }
    }
    LDS_BARRIER();
    ISTAMP(pair == 256, 35);
    {
        const bool isv = t8 < 128; const int col = t8 & 127;
        LAS const bf16* src = (LAS const bf16*)(L + (isv ? PL_VB : PL_KB)) + col;
        LAS const float* coef = TB + (isv ? 256 : 320);
        float x[64];
#pragma unroll
        for (int i0 = 0; i0 < 64; i0 += 16) {
            unsigned short rv[16]; f32x4 cf[4];
#pragma unroll
            for (int r = 0; r < 16; ++r) rv[r] = src[(i0 + r) * 136];
#pragma unroll
            for (int r = 0; r < 4; ++r) cf[r] = *(LAS const f32x4*)(coef + i0 + 4 * r);
            __builtin_amdgcn_sched_barrier(0);
#pragma unroll
            for (int r = 0; r < 16; ++r) x[i0 + r] = bf2f(rv[r]) * cf[r >> 2][r & 3];
            __builtin_amdgcn_sched_barrier(0);
        }
#pragma unroll
        for (int jb = 0; jb < 16; ++jb) {
            const int j0 = 4 * jb;
            {
                const f32x4 a1 = *(LAS const f32x4*)(AM + (j0 + 1) * 68 + j0), a2 = *(LAS const f32x4*)(AM + (j0 + 2) * 68 + j0), a3 = *(LAS const f32x4*)(AM + (j0 + 3) * 68 + j0);
                x[j0 + 1] -= a1[0] * x[j0];
                x[j0 + 2] -= a2[0] * x[j0] + a2[1] * x[j0 + 1];
                x[j0 + 3] -= (a3[0] * x[j0] + a3[1] * x[j0 + 1]) + a3[2] * x[j0 + 2];
            }
            {
                f32x4 avA[6], avB[6];
#define SV_LOAD(dst, i0_) do { _Pragma("unroll") for (int r_ = 0; r_ < 6; ++r_) if ((i0_) + r_ < 64) dst[r_] = *(LAS const f32x4*)(AM + ((i0_) + r_) * 68 + j0); } while (0)
#define SV_FMA(src, i0_) do { _Pragma("unroll") for (int r_ = 0; r_ < 6; ++r_) if ((i0_) + r_ < 64) x[(i0_) + r_] -= (src[r_][0] * x[j0] + src[r_][1] * x[j0 + 1]) + (src[r_][2] * x[j0 + 2] + src[r_][3] * x[j0 + 3]); } while (0)
                if (j0 + 4 < 64) SV_LOAD(avA, j0 + 4);
#pragma unroll
                for (int i0 = j0 + 4; i0 < 64; i0 += 12) {
                    if (i0 + 6 < 64) SV_LOAD(avB, i0 + 6);
                    __builtin_amdgcn_sched_barrier(0);
                    SV_FMA(avA, i0);
                    __builtin_amdgcn_sched_barrier(0);
                    if (i0 + 12 < 64) SV_LOAD(avA, i0 + 12);
                    __builtin_amdgcn_sched_barrier(0);
                    if (i0 + 6 < 64) SV_FMA(avB, i0 + 6);
                    __builtin_amdgcn_sched_barrier(0);
                }
#undef SV_LOAD
#undef SV_FMA
            }
        }
        if (isv) {
            bf16* ut = (bf16*)(ws + WS_UTB) + (t0 + (col >> 1)) * 1024 + h * 128 + (col & 1) * 64;
#pragma unroll
            for (int g = 0; g < 8; ++g) { v4u pk; pk.x = cvtpk(x[8 * g], x[8 * g + 1]); pk.y = cvtpk(x[8 * g + 2], x[8 * g + 3]); pk.z = cvtpk(x[8 * g + 4], x[8 * g + 5]); pk.w = cvtpk(x[8 * g + 6], x[8 * g + 7]); *(GAS v4u*)(ut + 8 * g) = pk; }
        }
        LDS_BARRIER();
        if (!isv) {
            LAS bf16* nwt = (LAS bf16*)(L + PL_VB) + col;
#pragma unroll
            for (int i = 0; i < 64; ++i) nwt[i * 136] = (bf16)f2bf(-x[i]);
        }
    }
    LDS_BARRIER();
    ISTAMP(pair == 256, 36);
    {
        bf16* qd = (bf16*)(ws + WS_QKV) + t0 * 3072 + h * 128;
#pragma unroll
        for (int i = 0; i < 4; ++i) { const int ch = t8 + 256 * i, row = ch >> 4, cc = ch & 15; *(GAS v4u*)(qd + (size_t)row * 3072 + cc * 8) = *(const LAS v4u*)(L + PL_QB + row * 272 + cc * 16); }
        bf16* nd = (bf16*)(ws + WS_QKV) + t0 * 3072 + 2048 + h * 128;
#pragma unroll
        for (int i = 0; i < 4; ++i) { const int ch = t8 + 256 * i, row = ch >> 4, cc = ch & 15; *(GAS v4u*)(nd + (size_t)row * 3072 + cc * 8) = *(const LAS v4u*)(L + PL_VB + row * 272 + cc * 16); }
        bf16* qkd = (bf16*)(ws + WS_QKM) + t0 * 512 + h * 64;
#pragma unroll
        for (int i = 0; i < 2; ++i) { const int ch = t8 + 256 * i, row = ch >> 3, cc = ch & 7; *(GAS v4u*)(qkd + (size_t)row * 512 + cc * 8) = *(const LAS v4u*)(L + PL_QKT + row * 128 + cc * 16); }
        bf16* kd = (bf16*)(ws + WS_QKV) + t0 * 3072 + 1024 + h * 128;
        LAS const bf16* kb = (LAS const bf16*)(L + PL_KB);
#pragma unroll
        for (int i = 0; i < 4; ++i) {
            const int ch = t8 + 256 * i, k = ch >> 3, cgp = ch & 7;
            unsigned short e[8];
#pragma unroll
            for (int j = 0; j < 8; ++j) e[j] = kb[(8 * cgp + j) * 136 + k];
            v4u pk; pk.x = e[0] | ((unsigned)e[1] << 16); pk.y = e[2] | ((unsigned)e[3] << 16); pk.z = e[4] | ((unsigned)e[5] << 16); pk.w = e[6] | ((unsigned)e[7] << 16);
            *(GAS v4u*)(kd + (size_t)(k >> 1) * 3072 + (k & 1) * 64 + cgp * 8) = pk;
        }
    }
    ISTAMP(pair == 256, 37);
    }
#undef DP_LOAD
}

constexpr int SL_Q = 0, SL_W = 17408, SL_KT = 34816, SL_QK = 53248, SL_SC = 62464, SL_OT = 62976;
__device__ __forceinline__ bf16x8 frag2(LAS const unsigned char* p) {
    const bf16x4 lo = *(LAS const bf16x4*)p, hi = *(LAS const bf16x4*)(p + 32);
    return (bf16x8){lo[0], lo[1], lo[2], lo[3], hi[0], hi[1], hi[2], hi[3]};
}
__device__ __forceinline__ bf16x8 packB(const f32x4 lo, const f32x4 hi) {
    const unsigned a = cvtpk(lo[0], lo[1]), b = cvtpk(lo[2], lo[3]), c = cvtpk(hi[0], hi[1]), d = cvtpk(hi[2], hi[3]);
    return __builtin_bit_cast(bf16x8, (v4u){a, b, c, d});
}
__device__ __forceinline__ void dscan_item(Frame& F, cargs_t a, int item) {
    unsigned char* ws = a->ws;
    int tid_ = threadIdx.x; asm volatile("" : "+v"(tid_));
    const int tid = tid_, lane = tid & 63, w = F.wave, fr = lane & 15, fq = lane >> 4;
    const int b = item >> 3, h = item & 7;
    const size_t tb = (size_t)b * 2048;
    LAS unsigned char* L = F.lds + RING_OFF;
    const bf16* QKV = (const bf16*)(ws + WS_QKV); const bf16* QKM = (const bf16*)(ws + WS_QKM); const bf16* UTB = (const bf16*)(ws + WS_UTB);
    const bf16* Zb = (const bf16*)(ws + WS_Z); const float* SCL = (const float*)(ws + WS_SCL);
    bf16* OGp = (bf16*)(ws + WS_OG);
    f32x4 S[8];
#pragma unroll
    for (int st = 0; st < 8; ++st) S[st] = (f32x4){0.f, 0.f, 0.f, 0.f};
    const int r0 = tid >> 4, c0 = tid & 15;
    const int r1 = tid >> 3, c1 = tid & 7;
    const int grow = tid >> 3, gcg = tid & 7;
    v4u pq[2], pw[2], pk[2], pqk, psc, pz[2]; unsigned long long put[4];
    const float* og_gain = a->in[13] + 16 * gcg;
#define DS_LOAD(ci) do { const size_t t0_ = tb + (size_t)(ci) * 64; if ((ci) < 32) { \
        _Pragma("unroll") for (int i_ = 0; i_ < 2; ++i_) { const bf16* rp = QKV + (t0_ + r0 + 32 * i_) * 3072 + h * 128 + c0 * 8; pq[i_] = *(const GAS v4u*)rp; pk[i_] = *(const GAS v4u*)(rp + 1024); pw[i_] = *(const GAS v4u*)(rp + 2048); } \
        pqk = *(const GAS v4u*)(QKM + (t0_ + r1) * 512 + h * 64 + c1 * 8); \
        if (tid < 32) psc = *(const GAS v4u*)(SCL + ((size_t)(b * 32 + (ci)) * 8 + h) * 128 + tid * 4); \
        { const int v_ = 16 * w + fr; const bf16* up = UTB + (t0_ + (v_ >> 1)) * 1024 + h * 128 + (v_ & 1) * 64 + 4 * fq; \
          _Pragma("unroll") for (int mt_ = 0; mt_ < 4; ++mt_) put[mt_] = *(const GAS unsigned long long*)(up + 16 * mt_); } } \
        if ((ci) > 0) { _Pragma("unroll") for (int i_ = 0; i_ < 2; ++i_) pz[i_] = *(const GAS v4u*)(Zb + (t0_ - 64 + grow) * 1024 + h * 128 + gcg * 16 + i_ * 8); } } while (0)
    DS_LOAD(0);
    __syncthreads();
#pragma unroll 1
    for (int ci = 0; ci <= 32; ++ci) {
        LDS_BARRIER(); ISTAMP(ci == 10, 40); ISTAMP(ci == 11, 44);
        f32x4 u[4];
        if (ci < 32) {
#pragma unroll
            for (int i = 0; i < 2; ++i) {
                *(LAS v4u*)(L + SL_Q + (r0 + 32 * i) * 272 + c0 * 16) = pq[i];
                *(LAS v4u*)(L + SL_W + (r0 + 32 * i) * 272 + c0 * 16) = pw[i];
                { const int kr = 2 * (r0 + 32 * i) + (c0 >> 3); *(LAS v4u*)(L + SL_KT + kr * 144 + (c0 & 7) * 16) = pk[i]; }
            }
            *(LAS v4u*)(L + SL_QK + r1 * 144 + c1 * 16) = pqk;
            if (tid < 32) *(LAS v4u*)(L + SL_SC + tid * 16) = psc;
#pragma unroll
            for (int mt = 0; mt < 4; ++mt) u[mt] = bfx4lo((unsigned)put[mt], (unsigned)(put[mt] >> 32));
        }
        if (ci > 0) {
            const v4u o0 = *(const LAS v4u*)(L + SL_OT + grow * 272 + gcg * 32), o1 = *(const LAS v4u*)(L + SL_OT + grow * 272 + gcg * 32 + 16);
            f32x4 ov[4] = {bfx4lo(o0.x, o0.y), bfx4lo(o0.z, o0.w), bfx4lo(o1.x, o1.y), bfx4lo(o1.z, o1.w)};
            float ss = (dot4s(ov[0]) + dot4s(ov[1])) + (dot4s(ov[2]) + dot4s(ov[3]));
            ss += __shfl_xor(ss, 1); ss += __shfl_xor(ss, 2); ss += __shfl_xor(ss, 4);
            const float rn = rsqrtf(ss * (1.0f / 128.0f) + 1e-6f);
            const f32x4 zv[4] = {bfx4lo(pz[0].x, pz[0].y), bfx4lo(pz[0].z, pz[0].w), bfx4lo(pz[1].x, pz[1].y), bfx4lo(pz[1].z, pz[1].w)};
            unsigned pkd[8];
#pragma unroll
            for (int q4 = 0; q4 < 4; ++q4) {
                const f32x4 gn = *(const GAS f32x4*)(og_gain + 4 * q4); f32x4 r;
#pragma unroll
                for (int e = 0; e < 4; ++e) { const float z = zv[q4][e]; r[e] = ov[q4][e] * rn * gn[e] * (z * sigmoidf_(z)); }
                pkd[2 * q4] = cvtpk(r[0], r[1]); pkd[2 * q4 + 1] = cvtpk(r[2], r[3]);
            }
            bf16* op = OGp + (tb + (size_t)(ci - 1) * 64 + grow) * 1024 + h * 128 + gcg * 16;
            *(GAS v4u*)op = (v4u){pkd[0], pkd[1], pkd[2], pkd[3]}; *(GAS v4u*)(op + 8) = (v4u){pkd[4], pkd[5], pkd[6], pkd[7]};
        }
        if (ci == 32) break;
        if (ci + 1 <= 32) DS_LOAD(ci + 1);
        ISTAMP(ci == 10, 41); LDS_BARRIER(); ISTAMP(ci == 10, 42);
        f32x4 o[4];
        lcp wbase = (lcp)(L + SL_W + fr * 272 + fq * 8), qbase = (lcp)(L + SL_Q + fr * 272 + fq * 8);
        lcp kbase = (lcp)(L + SL_QK + fr * 144 + fq * 8), tbase = (lcp)(L + SL_KT + fr * 144 + fq * 8);
        bf16x8 fA[4];
#define DS_SB() __builtin_amdgcn_sched_barrier(0)
#pragma unroll
        for (int mt = 0; mt < 4; ++mt) o[mt] = (f32x4){0.f, 0.f, 0.f, 0.f};
#pragma unroll
        for (int ks = 0; ks < 4; ++ks) {
            const bf16x8 sbk = packB(S[2 * ks], S[2 * ks + 1]);
#pragma unroll
            for (int mt = 0; mt < 4; ++mt) fA[mt] = frag2(wbase + mt * 16 * 272 + ks * 64);
            DS_SB();
#pragma unroll
            for (int mt = 0; mt < 4; ++mt) u[mt] = __builtin_amdgcn_mfma_f32_16x16x32_bf16(fA[mt], sbk, u[mt], 0, 0, 0);
            DS_SB();
#pragma unroll
            for (int mt = 0; mt < 4; ++mt) fA[mt] = frag2(qbase + mt * 16 * 272 + ks * 64);
            DS_SB();
#pragma unroll
            for (int mt = 0; mt < 4; ++mt) o[mt] = __builtin_amdgcn_mfma_f32_16x16x32_bf16(fA[mt], sbk, o[mt], 0, 0, 0);
            DS_SB();
        }
        LAS const float* sc = (LAS const float*)(L + SL_SC);
        const float gl = sc[63];
        bf16x8 ub[2], ub2[2];
        {
#pragma unroll
            for (int mt = 0; mt < 4; ++mt) { const f32x4 eg = *(LAS const f32x4*)(sc + 16 * mt + 4 * fq); o[mt] = o[mt] * eg; }
            ub[0] = packB(u[0], u[1]); ub[1] = packB(u[2], u[3]);
#pragma unroll
            for (int mt = 0; mt < 4; ++mt) { const f32x4 ek = *(LAS const f32x4*)(sc + 64 + 16 * mt + 4 * fq); u[mt] = u[mt] * ek; }
            ub2[0] = packB(u[0], u[1]); ub2[1] = packB(u[2], u[3]);
        }
#pragma unroll
        for (int st = 0; st < 8; ++st) S[st] = S[st] * gl;
        DS_SB();
#pragma unroll
        for (int m2 = 0; m2 < 2; ++m2) {
#pragma unroll
            for (int mt = 0; mt < 2; ++mt) { fA[2 * mt] = frag2(kbase + (2 * m2 + mt) * 16 * 144); fA[2 * mt + 1] = frag2(kbase + (2 * m2 + mt) * 16 * 144 + 64); }
            DS_SB();
#pragma unroll
            for (int mt = 0; mt < 2; ++mt)
#pragma unroll
                for (int ks = 0; ks < 2; ++ks) o[2 * m2 + mt] = __builtin_amdgcn_mfma_f32_16x16x32_bf16(fA[2 * mt + ks], ub[ks], o[2 * m2 + mt], 0, 0, 0);
            DS_SB();
        }
#pragma unroll
        for (int s2 = 0; s2 < 4; ++s2) {
#pragma unroll
            for (int st = 0; st < 2; ++st) { fA[2 * st] = frag2(tbase + (2 * s2 + st) * 16 * 144); fA[2 * st + 1] = frag2(tbase + (2 * s2 + st) * 16 * 144 + 64); }
            DS_SB();
#pragma unroll
            for (int st = 0; st < 2; ++st)
#pragma unroll
                for (int ks = 0; ks < 2; ++ks) S[2 * s2 + st] = __builtin_amdgcn_mfma_f32_16x16x32_bf16(fA[2 * st + ks], ub2[ks], S[2 * s2 + st], 0, 0, 0);
            DS_SB();
        }
#undef LD_W
#undef LD_Q
#undef MM_U
#undef MM_O
#undef DS_SB
        ISTAMP(ci == 10, 43);
        LAS bf16* ot = (LAS bf16*)(L + SL_OT) + 16 * w + fr;
#pragma unroll
        for (int mt = 0; mt < 4; ++mt)
#pragma unroll
            for (int j = 0; j < 4; ++j) ot[(16 * mt + 4 * fq + j) * 136] = (bf16)f2bf(o[mt][j]);
    }
#undef DS_LOAD
    float* so = a->out + O_SDP + ((size_t)(b * 8 + h) * 128) * 128 + 16 * w + fr;
#pragma unroll
    for (int st = 0; st < 8; ++st)
#pragma unroll
        for (int j = 0; j < 4; ++j) so[(size_t)(16 * st + 4 * fq + j) * 128] = S[st][j];
}
constexpr int TH_KB = 0, TH_QB = 17408, TH_TB = 34816, TH_QKT = 36352, TH_HALF = 44544, TS_SLOT0 = 2 * TH_HALF, TS_SLOTB = 8448;
constexpr size_t QT_STRIDE = 1024;
__host__ __device__ constexpr int tri_off(int l) { return 4 * (2 * (l >> 2) * (l >> 2) + (l >> 2) + ((l & 3) ? (l >> 2) + ((l & 3) - 1) * ((l >> 2) + 1) : 0)); }
__device__ __forceinline__ int tri_off_rt(int l) { const int q = l >> 2, p = l & 3; return 4 * (2 * q * q + q + (p ? q + (p - 1) * (q + 1) : 0)); }

__device__ __forceinline__ void dprep_loop_t(Frame& F, cargs_t a) {
    unsigned char* ws = a->ws;
    int tid_ = threadIdx.x; asm volatile("" : "+v"(tid_));
    const int tid = tid_, half = tid >> 8, t8 = tid & 255, lane = tid & 63, w4 = (tid >> 6) & 3, w8 = tid >> 6;
    LAS unsigned char* L = F.lds + RING_OFF + half * TH_HALF;
    LAS unsigned char* L0 = F.lds + RING_OFF;
    bf16* QT = (bf16*)(a->out + O_Y);
    const int ngrp = ((2048 + F.G - 1) / F.G + 3) >> 2;
    v4u raw[3][7]; float abv[2] = {0.f, 0.f};
#pragma unroll 1
    for (int grp = 0; grp < ngrp; ++grp) {
    ISTAMP(grp == 0, 70);
#define DP_LOAD(pp_, plo_, phi_) do { int pr_ = (int)((blockIdx.x + 53u * (unsigned)(grp * 4 + (pp_))) % (unsigned)F.G) + (grp * 4 + (pp_)) * F.G; pr_ = pr_ < 2048 ? pr_ : 2047; \
        const int it_ = 2 * pr_ + half, c_ = it_ & 31, h_ = (it_ >> 5) & 7, b_ = it_ >> 8; const size_t t0_ = (size_t)b_ * 2048 + (size_t)c_ * 64; const int cgk_ = b_ * 32 + c_; \
        int t8p_ = t8; asm volatile("" : "+v"(t8p_)); const int tg_ = t8p_ >> 4, cg_ = t8p_ & 15; \
        const bf16* Q_ = (const bf16*)(ws + WS_QKV); const bf16* H_ = (const bf16*)(ws + WS_HALO); \
        _Pragma("unroll") for (int p = (plo_); p < (phi_); ++p) { const int cb = p * 1024 + h_ * 128 + 8 * cg_; \
            _Pragma("unroll") for (int i = 0; i < 7; ++i) { const int lr = 4 * tg_ - 3 + i; \
                if (lr >= 0) raw[p][i] = *(const GAS v4u*)(Q_ + (t0_ + lr) * 3072 + cb); \
                else if (c_ > 0) raw[p][i] = *(const GAS v4u*)(H_ + ((size_t)(cgk_ - 1) * 3 + (lr + 3)) * 3072 + cb); \
                else raw[p][i] = (v4u){0u, 0u, 0u, 0u}; } } \
        if ((phi_) == 3 && w4 == 0) { const float* ab_ = (const float*)(ws + WS_AB) + (t0_ + lane) * 16 + h_; abv[0] = ab_[0]; abv[1] = ab_[8]; } } while (0)
    if (grp == 0) DP_LOAD(0, 0, 2);
#pragma unroll 1
    for (int pp = 0; pp < 4; ++pp) {
        ISTAMP(grp == 0 && pp == 1, 73);
        int pair = (int)((blockIdx.x + 53u * (unsigned)(grp * 4 + pp)) % (unsigned)F.G) + (grp * 4 + pp) * F.G; pair = pair < 2048 ? pair : 2047;
        const int item = 2 * pair + half, c = item & 31, h = (item >> 5) & 7, b = item >> 8;
        const size_t t0 = (size_t)b * 2048 + (size_t)c * 64; const int chunkg = b * 32 + c;
        int t8o = t8; asm volatile("" : "+v"(t8o));
        const int tg = t8o >> 4, cg = t8o & 15;
        LAS float* TB = (LAS float*)(L + TH_TB);
        DP_LOAD(pp, 2, 3);
        LDS_BARRIER();
        ISTAMP(grp == 0 && pp == 1, 74);
#pragma unroll
        for (int p = 0; p < 3; ++p) {
            const int colbase = p * 1024 + h * 128 + 8 * cg;
            const float* cw = a->in[10] + colbase;
            f32x4 w[4][2];
#pragma unroll
            for (int k = 0; k < 4; ++k) { w[k][0] = *(const GAS f32x4*)(cw + k * 3072); w[k][1] = *(const GAS f32x4*)(cw + k * 3072 + 4); }
            f32x4 o[4][2];
#pragma unroll
            for (int tok = 0; tok < 4; ++tok) { o[tok][0] = (f32x4){0.f, 0.f, 0.f, 0.f}; o[tok][1] = o[tok][0]; }
#pragma unroll
            for (int i = 0; i < 7; ++i) {
                const f32x4 x0 = bfx4lo(raw[p][i].x, raw[p][i].y), x1 = bfx4lo(raw[p][i].z, raw[p][i].w);
#pragma unroll
                for (int tok = 0; tok < 4; ++tok) { const int k = i - tok; if (k >= 0 && k < 4) { o[tok][0] += x0 * w[k][0]; o[tok][1] += x1 * w[k][1]; } }
            }
#pragma unroll
            for (int tok = 0; tok < 4; ++tok) {
                float ss = 0.f;
#pragma unroll
                for (int e = 0; e < 4; ++e) { float x = o[tok][0][e]; x = x * sigmoidf_(x); o[tok][0][e] = x; ss += x * x; float y = o[tok][1][e]; y = y * sigmoidf_(y); o[tok][1][e] = y; ss += y * y; }
                if (p < 2) {
                    ss += __shfl_xor(ss, 1); ss += __shfl_xor(ss, 2); ss += __shfl_xor(ss, 4); ss += __shfl_xor(ss, 8);
                    const float rn = rsqrtf(ss + 1e-6f) * (p == 0 ? 0.08838834764831845f : 1.0f);
                    o[tok][0] = o[tok][0] * rn; o[tok][1] = o[tok][1] * rn;
                    v4u pk; pk.x = cvtpk(o[tok][0][0], o[tok][0][1]); pk.y = cvtpk(o[tok][0][2], o[tok][0][3]); pk.z = cvtpk(o[tok][1][0], o[tok][1][1]); pk.w = cvtpk(o[tok][1][2], o[tok][1][3]);
                    *(LAS v4u*)(L + (p == 0 ? TH_QB : TH_KB) + (4 * tg + tok) * 272 + cg * 16) = pk;
                }
            }
            if (p == 2) {
#pragma unroll
                for (int e = 0; e < 8; ++e) {
                    const int v = 8 * cg + e;
                    const unsigned lo = cvtpk(o[0][e >> 2][e & 3], o[1][e >> 2][e & 3]), hi = cvtpk(o[2][e >> 2][e & 3], o[3][e >> 2][e & 3]);
                    *(GAS unsigned long long*)((bf16*)(ws + WS_UTB) + (t0 + (v >> 1)) * 1024 + h * 128 + (v & 1) * 64 + 4 * tg) = (unsigned long long)lo | ((unsigned long long)hi << 32);
                }
            }
        }
        ISTAMP(grp == 0 && pp == 1, 75);
        if (w4 == 0) {
            const float av = abv[0], bv = abv[1];
            const float Aneg = -__expf(a->in[11][h]), dtb = a->in[12][h];
            const float beta = sigmoidf_(bv);
            const float spi = av + dtb; const float sp = (spi > 15.f) ? spi : log1pf(__expf(spi));
            float gc = Aneg * sp;
#pragma unroll
            for (int o = 1; o < 64; o <<= 1) { const float t = __shfl_up(gc, o); if (lane >= o) gc += t; }
            const float glast = __shfl(gc, 63);
            TB[lane] = beta; TB[64 + lane] = gc;
            float* scl = (float*)(ws + WS_SCL) + ((size_t)chunkg * 8 + h) * 192;
            scl[lane] = __expf(gc); scl[64 + lane] = __expf(glast - gc); scl[128 + lane] = beta;
        }
        LDS_BARRIER();
        {
            int lane_o = lane; asm volatile("" : "+v"(lane_o));
            const int fr = lane_o & 15, fq = lane_o >> 4;
            f32x4 kk[4], qq[4];
#pragma unroll
            for (int nt = 0; nt < 4; ++nt) { kk[nt] = (f32x4){0.f, 0.f, 0.f, 0.f}; qq[nt] = kk[nt]; }
#pragma unroll
            for (int ks = 0; ks < 4; ++ks) {
                const bf16x8 ak = *(const LAS bf16x8*)(L + TH_KB + (16 * w4 + fr) * 272 + ks * 64 + fq * 16);
                const bf16x8 aq = *(const LAS bf16x8*)(L + TH_QB + (16 * w4 + fr) * 272 + ks * 64 + fq * 16);
#pragma unroll
                for (int nt = 0; nt < 4; ++nt) {
                    const bf16x8 bk = *(const LAS bf16x8*)(L + TH_KB + (16 * nt + fr) * 272 + ks * 64 + fq * 16);
                    __builtin_amdgcn_s_setprio(1);
                    kk[nt] = __builtin_amdgcn_mfma_f32_16x16x32_bf16(ak, bk, kk[nt], 0, 0, 0);
                    qq[nt] = __builtin_amdgcn_mfma_f32_16x16x32_bf16(aq, bk, qq[nt], 0, 0, 0);
                    __builtin_amdgcn_s_setprio(0);
                }
            }
            LAS float* slot = (LAS float*)(L0 + TS_SLOT0 + (2 * pp + half) * TS_SLOTB);
#pragma unroll
            for (int j = 0; j < 4; ++j) {
                const int i = 16 * w4 + 4 * fq + j; const float gi = TB[64 + i], bi = TB[i];
                const int ro = tri_off_rt(i), rl = (i + 3) & ~3;
#pragma unroll
                for (int nt = 0; nt < 4; ++nt) {
                    const int jj = 16 * nt + fr; const float d = __expf(fminf(gi - TB[64 + jj], 0.f));
                    if (jj < rl) slot[ro + jj] = (i > jj) ? bi * kk[nt][j] * d : 0.f;
                    ((LAS bf16*)(L + TH_QKT))[i * 64 + jj] = (bf16)f2bf((i >= jj) ? qq[nt][j] * d : 0.f);
                }
            }
        }
        ISTAMP(grp == 0 && pp == 1, 76);
        if (pp < 3 || grp + 1 < ngrp) DP_LOAD(pp + 1, 0, 2);
        LDS_BARRIER();
        {
            int t8c = t8; asm volatile("" : "+v"(t8c));
            bf16* qd = (bf16*)(ws + WS_QKV) + t0 * 3072 + h * 128;
#pragma unroll
            for (int i = 0; i < 4; ++i) { const int ch = t8c + 256 * i, row = ch >> 4, cc = ch & 15;
                *(GAS v4u*)(qd + (size_t)row * 3072 + cc * 8) = *(const LAS v4u*)(L + TH_QB + row * 272 + cc * 16);
                *(GAS v4u*)(qd + 1024 + (size_t)row * 3072 + cc * 8) = *(const LAS v4u*)(L + TH_KB + row * 272 + cc * 16); }
            bf16* qkd = QT + t0 * QT_STRIDE + h * 128;
#pragma unroll
            for (int i = 0; i < 2; ++i) { const int ch = t8c + 256 * i, row = ch >> 3, cc = ch & 7; *(GAS v4u*)(qkd + (size_t)row * QT_STRIDE + cc * 8) = *(const LAS v4u*)(L + TH_QKT + row * 128 + cc * 16); }
            bf16* kd = (bf16*)(ws + WS_QKV) + t0 * 3072 + 2048 + h * 128;
            LAS const bf16* kb = (LAS const bf16*)(L + TH_KB);
#pragma unroll
            for (int i = 0; i < 4; ++i) {
                const int ch = t8c + 256 * i, k = ch >> 3, cgp = ch & 7;
                unsigned short e[8];
#pragma unroll
                for (int j = 0; j < 8; ++j) e[j] = kb[(8 * cgp + j) * 136 + k];
                v4u pk; pk.x = e[0] | ((unsigned)e[1] << 16); pk.y = e[2] | ((unsigned)e[3] << 16); pk.z = e[4] | ((unsigned)e[5] << 16); pk.w = e[6] | ((unsigned)e[7] << 16);
                *(GAS v4u*)(kd + (size_t)(k >> 1) * 3072 + (k & 1) * 64 + cgp * 8) = pk;
            }
        }
    }
#undef DP_LOAD
    ISTAMP(grp == 0, 71);
    LDS_BARRIER();
    {
        const int pp = w8 >> 1, hh = w8 & 1;
        int pair = (int)((blockIdx.x + 53u * (unsigned)(grp * 4 + pp)) % (unsigned)F.G) + (grp * 4 + pp) * F.G; pair = pair < 2048 ? pair : 2047;
        const int item = 2 * pair + hh, c = item & 31, h = (item >> 5) & 7, b = item >> 8;
        const size_t t0 = (size_t)b * 2048 + (size_t)c * 64;
        LAS const float* A = (LAS const float*)(L0 + TS_SLOT0 + w8 * TS_SLOTB);
        f32x4 xv[16];
        int lane_s = lane; asm volatile("" : "+v"(lane_s));
#pragma unroll
        for (int g = 0; g < 16; ++g) xv[g] = (f32x4){(4 * g == lane_s) ? 1.f : 0.f, (4 * g + 1 == lane_s) ? 1.f : 0.f, (4 * g + 2 == lane_s) ? 1.f : 0.f, (4 * g + 3 == lane_s) ? 1.f : 0.f};
#pragma unroll
        for (int lbr = 0; lbr < 16; ++lbr) {
            const int lb = 15 - lbr, l0 = 4 * lb;
            {
                const f32x4 a1 = *(LAS const f32x4*)(A + tri_off(l0 + 1) + l0), a2 = *(LAS const f32x4*)(A + tri_off(l0 + 2) + l0), a3 = *(LAS const f32x4*)(A + tri_off(l0 + 3) + l0);
                f32x4 t = xv[lb];
                t[2] -= t[3] * a3[2];
                t[1] -= t[3] * a3[1] + t[2] * a2[1];
                t[0] -= (t[3] * a3[0] + t[2] * a2[0]) + t[1] * a1[0];
                xv[lb] = t;
            }
            const float x0 = xv[lb][0], x1 = xv[lb][1], x2 = xv[lb][2], x3 = xv[lb][3];
#pragma unroll
            for (int ig = 0; ig < lb; ig += 4) {
                f32x4 av[4][4];
#pragma unroll
                for (int g2 = 0; g2 < 4; ++g2) if (ig + g2 < lb) {
#pragma unroll
                    for (int q = 0; q < 4; ++q) av[g2][q] = *(LAS const f32x4*)(A + tri_off(l0 + q) + 4 * (ig + g2));
                }
                __builtin_amdgcn_sched_barrier(0);
#pragma unroll
                for (int g2 = 0; g2 < 4; ++g2) if (ig + g2 < lb) xv[ig + g2] = xv[ig + g2] - ((av[g2][0] * x0 + av[g2][1] * x1) + (av[g2][2] * x2 + av[g2][3] * x3));
                __builtin_amdgcn_sched_barrier(0);
            }
        }
        float x[64];
#pragma unroll
        for (int i = 0; i < 64; ++i) x[i] = xv[i >> 2][i & 3];
        bf16* td = QT + (t0 + lane) * QT_STRIDE + h * 128 + 64;
#pragma unroll
        for (int g = 0; g < 8; ++g) { v4u pk; pk.x = cvtpk(x[8 * g], x[8 * g + 1]); pk.y = cvtpk(x[8 * g + 2], x[8 * g + 3]); pk.z = cvtpk(x[8 * g + 4], x[8 * g + 5]); pk.w = cvtpk(x[8 * g + 6], x[8 * g + 7]); *(GAS v4u*)(td + 8 * g) = pk; }
    }
    ISTAMP(grp == 0, 72); ISTAMP(grp == 1, 78);
#if defined(PROF_A) && defined(PROF_FIN2)
    if (grp == 1 && threadIdx.x == 0) ((unsigned long long*)(a->ws + WS_CTL + 2048))[256 + blockIdx.x] = __builtin_amdgcn_s_memrealtime();
#endif
    }
}

constexpr int TL_Q = 0, TL_K = 17408, TL_KT = 34816, TL_QT = 53248, TL_SC = 70656, TL_OT = 71680;
__device__ __forceinline__ void dscan_item_t(Frame& F, cargs_t a, int item) {
    unsigned char* ws = a->ws;
    int tid_ = threadIdx.x; asm volatile("" : "+v"(tid_));
    const int tid = tid_, lane = tid & 63, w = F.wave, fr = lane & 15, fq = lane >> 4;
    const int b = item >> 3, h = item & 7;
    const size_t tb = (size_t)b * 2048;
    LAS unsigned char* L = F.lds + RING_OFF;
    const bf16* QKV = (const bf16*)(ws + WS_QKV); const bf16* QT = (const bf16*)(a->out + O_Y); const bf16* VTB = (const bf16*)(ws + WS_UTB);
    const bf16* Zb = (const bf16*)(ws + WS_Z); const float* SCL = (const float*)(ws + WS_SCL);
    bf16* OGp = (bf16*)(ws + WS_OG);
    f32x4 S[8];
#pragma unroll
    for (int st = 0; st < 8; ++st) S[st] = (f32x4){0.f, 0.f, 0.f, 0.f};
    const int r0 = tid >> 4, c0 = tid & 15;
    const int grow = tid >> 3, gcg = tid & 7;
    v4u pq[2], pw[2], pk[2], pt[2], psc, pz[2]; unsigned long long pvt[4];
    const float* og_gain = a->in[13] + 16 * gcg;
#define DT_ROW(cn, i_) (QKV + (tb + (size_t)(cn) * 64 + r0 + 32 * (i_)) * 3072 + h * 128 + c0 * 8)
#define DT_L(n, cn, cz) do { \
        if ((n) == 0) pq[0] = *(const GAS v4u*)DT_ROW(cn, 0); else if ((n) == 1) pw[0] = *(const GAS v4u*)(DT_ROW(cn, 0) + 1024); else if ((n) == 2) pk[0] = *(const GAS v4u*)(DT_ROW(cn, 0) + 2048); \
        else if ((n) == 3) pt[0] = *(const GAS v4u*)(QT + (tb + (size_t)(cn) * 64 + r0) * QT_STRIDE + h * 128 + c0 * 8); \
        else if ((n) == 4) pq[1] = *(const GAS v4u*)DT_ROW(cn, 1); else if ((n) == 5) pw[1] = *(const GAS v4u*)(DT_ROW(cn, 1) + 1024); else if ((n) == 6) pk[1] = *(const GAS v4u*)(DT_ROW(cn, 1) + 2048); \
        else if ((n) == 7) pt[1] = *(const GAS v4u*)(QT + (tb + (size_t)(cn) * 64 + r0 + 32) * QT_STRIDE + h * 128 + c0 * 8); \
        else if ((n) == 8) { if (tid < 48) psc = *(const GAS v4u*)(SCL + ((size_t)(b * 32 + (cn)) * 8 + h) * 192 + tid * 4); } \
        else if ((n) < 13) { const int v_ = 16 * w + fr; pvt[(n) - 9] = *(const GAS unsigned long long*)(VTB + (tb + (size_t)(cn) * 64 + (v_ >> 1)) * 1024 + h * 128 + (v_ & 1) * 64 + 4 * fq + 16 * ((n) - 9)); } \
        else pz[(n) - 13] = *(const GAS v4u*)(Zb + (tb + (size_t)(cz) * 64 + grow) * 1024 + h * 128 + gcg * 16 + ((n) - 13) * 8); } while (0)
#pragma unroll
    for (int n = 0; n < 13; ++n) DT_L(n, 0, 0);
    __syncthreads();
#pragma unroll 1
    for (int ci = 0; ci <= 32; ++ci) {
        LDS_BARRIER();
        ISTAMP(ci == 16, 60); ISTAMP(ci == 17, 69);
        f32x4 vt[4];
        if (ci < 32) {
#pragma unroll
            for (int i = 0; i < 2; ++i) {
                *(LAS v4u*)(L + TL_Q + (r0 + 32 * i) * 272 + c0 * 16) = pq[i];
                *(LAS v4u*)(L + TL_K + (r0 + 32 * i) * 272 + c0 * 16) = pw[i];
                { const int kr = 2 * (r0 + 32 * i) + (c0 >> 3); *(LAS v4u*)(L + TL_KT + kr * 144 + (c0 & 7) * 16) = pk[i]; }
                *(LAS v4u*)(L + TL_QT + (r0 + 32 * i) * 272 + c0 * 16) = pt[i];
            }
            if (tid < 48) *(LAS v4u*)(L + TL_SC + tid * 16) = psc;
#pragma unroll
            for (int mt = 0; mt < 4; ++mt) vt[mt] = bfx4lo((unsigned)pvt[mt], (unsigned)(pvt[mt] >> 32));
        }
        ISTAMP(ci == 16, 61);
        if (ci > 0) {
            const v4u o0 = *(const LAS v4u*)(L + TL_OT + grow * 272 + gcg * 32), o1 = *(const LAS v4u*)(L + TL_OT + grow * 272 + gcg * 32 + 16);
            f32x4 ov[4] = {bfx4lo(o0.x, o0.y), bfx4lo(o0.z, o0.w), bfx4lo(o1.x, o1.y), bfx4lo(o1.z, o1.w)};
            float ss = (dot4s(ov[0]) + dot4s(ov[1])) + (dot4s(ov[2]) + dot4s(ov[3]));
            ss += __shfl_xor(ss, 1); ss += __shfl_xor(ss, 2); ss += __shfl_xor(ss, 4);
            const float rn = rsqrtf(ss * (1.0f / 128.0f) + 1e-6f);
            const f32x4 zv[4] = {bfx4lo(pz[0].x, pz[0].y), bfx4lo(pz[0].z, pz[0].w), bfx4lo(pz[1].x, pz[1].y), bfx4lo(pz[1].z, pz[1].w)};
            unsigned pkd[8];
#pragma unroll
            for (int q4 = 0; q4 < 4; ++q4) {
                const f32x4 gn = *(const GAS f32x4*)(og_gain + 4 * q4); f32x4 r;
#pragma unroll
                for (int e = 0; e < 4; ++e) { const float z = zv[q4][e]; r[e] = ov[q4][e] * rn * gn[e] * (z * sigmoidf_(z)); }
                pkd[2 * q4] = cvtpk(r[0], r[1]); pkd[2 * q4 + 1] = cvtpk(r[2], r[3]);
            }
            bf16* op = OGp + (tb + (size_t)(ci - 1) * 64 + grow) * 1024 + h * 128 + gcg * 16;
            *(GAS v4u*)op = (v4u){pkd[0], pkd[1], pkd[2], pkd[3]}; *(GAS v4u*)(op + 8) = (v4u){pkd[4], pkd[5], pkd[6], pkd[7]};
        }
        if (ci == 32) break;
        ISTAMP(ci == 16, 62);
        const int cn = (ci + 1 < 32) ? ci + 1 : 31;
        ISTAMP(ci == 16, 63);
        LDS_BARRIER();
        ISTAMP(ci == 16, 64);
        f32x4 o[4], u[4];
        lcp kb_ = (lcp)(L + TL_K + fr * 272 + fq * 8), qb_ = (lcp)(L + TL_Q + fr * 272 + fq * 8);
        lcp tq_ = (lcp)(L + TL_QT + fr * 272 + fq * 8), kt_ = (lcp)(L + TL_KT + fr * 144 + fq * 8);
        bf16x8 fA[4];
#define DS_SB() __builtin_amdgcn_sched_barrier(0)
#define MF_HI() __builtin_amdgcn_s_setprio(1)
#define MF_LO() __builtin_amdgcn_s_setprio(0)
#pragma unroll
        for (int mt = 0; mt < 4; ++mt) { o[mt] = (f32x4){0.f, 0.f, 0.f, 0.f}; u[mt] = (f32x4){0.f, 0.f, 0.f, 0.f}; }
#pragma unroll
        for (int ks = 0; ks < 4; ++ks) {
            const bf16x8 sbk = packB(S[2 * ks], S[2 * ks + 1]);
#pragma unroll
            for (int mt = 0; mt < 4; ++mt) fA[mt] = frag2(kb_ + mt * 16 * 272 + ks * 64);
            DS_SB();
            MF_HI();
#pragma unroll
            for (int mt = 0; mt < 4; ++mt) u[mt] = __builtin_amdgcn_mfma_f32_16x16x32_bf16(fA[mt], sbk, u[mt], 0, 0, 0);
            MF_LO();
            DT_L(2 * ks, cn, ci);
            DS_SB();
#pragma unroll
            for (int mt = 0; mt < 4; ++mt) fA[mt] = frag2(qb_ + mt * 16 * 272 + ks * 64);
            DS_SB();
            MF_HI();
#pragma unroll
            for (int mt = 0; mt < 4; ++mt) o[mt] = __builtin_amdgcn_mfma_f32_16x16x32_bf16(fA[mt], sbk, o[mt], 0, 0, 0);
            MF_LO();
            DT_L(2 * ks + 1, cn, ci);
            DS_SB();
        }
        ISTAMP(ci == 16, 65);
        LAS const float* sc = (LAS const float*)(L + TL_SC);
        const float gl = sc[63];
        bf16x8 rb[2];
        {
            f32x4 r[4];
#pragma unroll
            for (int mt = 0; mt < 4; ++mt) { const f32x4 eg = *(LAS const f32x4*)(sc + 16 * mt + 4 * fq), be = *(LAS const f32x4*)(sc + 128 + 16 * mt + 4 * fq); r[mt] = be * (vt[mt] - eg * u[mt]); o[mt] = o[mt] * eg; }
            rb[0] = packB(r[0], r[1]); rb[1] = packB(r[2], r[3]);
        }
#pragma unroll
        for (int m2 = 0; m2 < 2; ++m2) {
#pragma unroll
            for (int mt = 0; mt < 2; ++mt) { fA[2 * mt] = frag2(tq_ + (2 * m2 + mt) * 16 * 272 + 128); fA[2 * mt + 1] = frag2(tq_ + (2 * m2 + mt) * 16 * 272 + 128 + 64); }
            DS_SB();
#pragma unroll
            for (int mt = 0; mt < 2; ++mt) {
                u[2 * m2 + mt] = __builtin_amdgcn_mfma_f32_16x16x32_bf16(fA[2 * mt], rb[0], (f32x4){0.f, 0.f, 0.f, 0.f}, 0, 0, 0);
                u[2 * m2 + mt] = __builtin_amdgcn_mfma_f32_16x16x32_bf16(fA[2 * mt + 1], rb[1], u[2 * m2 + mt], 0, 0, 0);
            }
            if (m2 == 0) DT_L(8, cn, ci); else { DT_L(9, cn, ci); DT_L(10, cn, ci); }
            DS_SB();
        }
        ISTAMP(ci == 16, 66);
        bf16x8 ub[2], ub2[2];
        {
            ub[0] = packB(u[0], u[1]); ub[1] = packB(u[2], u[3]);
#pragma unroll
            for (int mt = 0; mt < 4; ++mt) { const f32x4 ek = *(LAS const f32x4*)(sc + 64 + 16 * mt + 4 * fq); u[mt] = u[mt] * ek; }
            ub2[0] = packB(u[0], u[1]); ub2[1] = packB(u[2], u[3]);
        }
#pragma unroll
        for (int st = 0; st < 8; ++st) S[st] = S[st] * gl;
        DS_SB();
#pragma unroll
        for (int m2 = 0; m2 < 2; ++m2) {
#pragma unroll
            for (int mt = 0; mt < 2; ++mt) { fA[2 * mt] = frag2(tq_ + (2 * m2 + mt) * 16 * 272); fA[2 * mt + 1] = frag2(tq_ + (2 * m2 + mt) * 16 * 272 + 64); }
            DS_SB();
#pragma unroll
            for (int mt = 0; mt < 2; ++mt)
#pragma unroll
                for (int ks = 0; ks < 2; ++ks) o[2 * m2 + mt] = __builtin_amdgcn_mfma_f32_16x16x32_bf16(fA[2 * mt + ks], ub[ks], o[2 * m2 + mt], 0, 0, 0);
            if (m2 == 0) { DT_L(11, cn, ci); DT_L(12, cn, ci); } else DT_L(13, cn, ci);
            DS_SB();
        }
#pragma unroll
        for (int s2 = 0; s2 < 4; ++s2) {
#pragma unroll
            for (int st = 0; st < 2; ++st) { fA[2 * st] = frag2(kt_ + (2 * s2 + st) * 16 * 144); fA[2 * st + 1] = frag2(kt_ + (2 * s2 + st) * 16 * 144 + 64); }
            DS_SB();
#pragma unroll
            for (int st = 0; st < 2; ++st)
#pragma unroll
                for (int ks = 0; ks < 2; ++ks) S[2 * s2 + st] = __builtin_amdgcn_mfma_f32_16x16x32_bf16(fA[2 * st + ks], ub2[ks], S[2 * s2 + st], 0, 0, 0);
            if (s2 == 0) DT_L(14, cn, ci);
            DS_SB();
        }
#undef DS_SB
#undef MF_HI
#undef MF_LO
        ISTAMP(ci == 16, 67);
        LAS bf16* ot = (LAS bf16*)(L + TL_OT) + 16 * w + fr;
#pragma unroll
        for (int mt = 0; mt < 4; ++mt)
#pragma unroll
            for (int j = 0; j < 4; ++j) ot[(16 * mt + 4 * fq + j) * 136] = (bf16)f2bf(o[mt][j]);
    }
#undef DT_L
#undef DT_ROW
    float* so = a->out + O_SDP + ((size_t)(b * 8 + h) * 128) * 128 + 16 * w + fr;
#pragma unroll
    for (int st = 0; st < 8; ++st)
#pragma unroll
        for (int j = 0; j < 4; ++j) so[(size_t)(16 * st + 4 * fq + j) * 128] = S[st][j];
}
constexpr int DB_Q = 0, DB_K = 16384, DB_KT = 32768, DB_QT = 49152, DB_SC = 65536, DB_SIZE = 66560, DL_OT = 2 * DB_SIZE;
__device__ __forceinline__ bf16x8 frag2s(LAS const unsigned char* base, int off0, int off1) {
    const bf16x4 lo = *(LAS const bf16x4*)(base + off0), hi = *(LAS const bf16x4*)(base + off1);
    return (bf16x8){lo[0], lo[1], lo[2], lo[3], hi[0], hi[1], hi[2], hi[3]};
}
__device__ __forceinline__ void dscan_item_t2(Frame& F, cargs_t a, int item) {
    unsigned char* ws = a->ws;
    int tid_ = threadIdx.x; asm volatile("" : "+v"(tid_));
    const int tid = tid_, lane = tid & 63, w = F.wave, fr = lane & 15, fq = lane >> 4;
    const int b = item >> 3, h = item & 7;
    const size_t tb = (size_t)b * 2048;
    LAS unsigned char* L = F.lds + RING_OFF;
    const bf16* QKV = (const bf16*)(ws + WS_QKV); const bf16* QT = (const bf16*)(a->out + O_Y); const bf16* VTB = (const bf16*)(ws + WS_UTB);
    const bf16* Zb = (const bf16*)(ws + WS_Z); const float* SCL = (const float*)(ws + WS_SCL);
    bf16* OGp = (bf16*)(ws + WS_OG);
    f32x4 S[8];
#pragma unroll
    for (int st = 0; st < 8; ++st) S[st] = (f32x4){0.f, 0.f, 0.f, 0.f};
    const int grow = tid >> 3, gcg = tid & 7;
    v4u pz[2]; unsigned long long pvt[4];
    const float* og_gain = a->in[13] + 16 * gcg;
    int offA[4][2], offT[2][2];
#pragma unroll
    for (int ks = 0; ks < 4; ++ks)
#pragma unroll
        for (int hf = 0; hf < 2; ++hf) offA[ks][hf] = fr * 256 + ((((4 * ks + (fq >> 1) + 2 * hf) ^ fr) & 15) << 4) + 8 * (fq & 1);
#pragma unroll
    for (int ks = 0; ks < 2; ++ks)
#pragma unroll
        for (int hf = 0; hf < 2; ++hf) offT[ks][hf] = fr * 128 + ((((4 * ks + (fq >> 1) + 2 * hf) ^ (fr >> 1)) & 7) << 4) + 8 * (fq & 1);
#define DM_ISSUE(ci, bufo) do { const size_t t0_ = tb + (size_t)(ci) * 64; \
        _Pragma("unroll") for (int i_ = 0; i_ < 2; ++i_) { const int n_ = 2 * w + i_; \
            const int row_ = 4 * n_ + (lane >> 4), ls_ = (lane & 15) ^ (row_ & 15); \
            const bf16* rp_ = QKV + (t0_ + row_) * 3072 + h * 128 + ls_ * 8; \
            __builtin_amdgcn_global_load_lds((const GAS unsigned*)rp_, (LAS unsigned*)(L + (bufo) + DB_Q + n_ * 1024), 16, 0, 0); \
            __builtin_amdgcn_global_load_lds((const GAS unsigned*)(rp_ + 1024), (LAS unsigned*)(L + (bufo) + DB_K + n_ * 1024), 16, 0, 0); \
            __builtin_amdgcn_global_load_lds((const GAS unsigned*)(QT + (t0_ + row_) * QT_STRIDE + h * 128 + ls_ * 8), (LAS unsigned*)(L + (bufo) + DB_QT + n_ * 1024), 16, 0, 0); \
            const int kr_ = 8 * n_ + (lane >> 3), kls_ = (lane & 7) ^ ((kr_ >> 1) & 7); \
            __builtin_amdgcn_global_load_lds((const GAS unsigned*)(QKV + (t0_ + (kr_ >> 1)) * 3072 + 2048 + h * 128 + (kr_ & 1) * 64 + kls_ * 8), (LAS unsigned*)(L + (bufo) + DB_KT + n_ * 1024), 16, 0, 0); } \
        if (w == 0) __builtin_amdgcn_global_load_lds((const GAS unsigned*)(SCL + ((size_t)(b * 32 + (ci)) * 8 + h) * 192 + (lane < 48 ? lane : 47) * 4), (LAS unsigned*)(L + (bufo) + DB_SC), 16, 0, 0); } while (0)
#define DM_VT(ci) do { const size_t t0_ = tb + (size_t)(ci) * 64; const int v_ = 16 * w + fr; const bf16* up = VTB + (t0_ + (v_ >> 1)) * 1024 + h * 128 + (v_ & 1) * 64 + 4 * fq; \
        _Pragma("unroll") for (int mt_ = 0; mt_ < 4; ++mt_) pvt[mt_] = *(const GAS unsigned long long*)(up + 16 * mt_); } while (0)
    __syncthreads();
    DM_ISSUE(0, 0);
    DM_VT(0);
#pragma unroll 1
    for (int ci = 0; ci <= 32; ++ci) {
        const int bufo = (ci & 1) * DB_SIZE;
        asm volatile("s_waitcnt vmcnt(0)" ::: "memory");
        LDS_BARRIER();
        if (ci + 1 < 32) DM_ISSUE(ci + 1, DB_SIZE - bufo);
        f32x4 vt[4];
#pragma unroll
        for (int mt = 0; mt < 4; ++mt) vt[mt] = bfx4lo((unsigned)pvt[mt], (unsigned)(pvt[mt] >> 32));
        if (ci > 0) {
            const v4u o0 = *(const LAS v4u*)(L + DL_OT + grow * 272 + gcg * 32), o1 = *(const LAS v4u*)(L + DL_OT + grow * 272 + gcg * 32 + 16);
            f32x4 ov[4] = {bfx4lo(o0.x, o0.y), bfx4lo(o0.z, o0.w), bfx4lo(o1.x, o1.y), bfx4lo(o1.z, o1.w)};
            float ss = (dot4s(ov[0]) + dot4s(ov[1])) + (dot4s(ov[2]) + dot4s(ov[3]));
            ss += __shfl_xor(ss, 1); ss += __shfl_xor(ss, 2); ss += __shfl_xor(ss, 4);
            const float rn = rsqrtf(ss * (1.0f / 128.0f) + 1e-6f);
            const f32x4 zv[4] = {bfx4lo(pz[0].x, pz[0].y), bfx4lo(pz[0].z, pz[0].w), bfx4lo(pz[1].x, pz[1].y), bfx4lo(pz[1].z, pz[1].w)};
            unsigned pkd[8];
#pragma unroll
            for (int q4 = 0; q4 < 4; ++q4) {
                const f32x4 gn = *(const GAS f32x4*)(og_gain + 4 * q4); f32x4 r;
#pragma unroll
                for (int e = 0; e < 4; ++e) { const float z = zv[q4][e]; r[e] = ov[q4][e] * rn * gn[e] * (z * sigmoidf_(z)); }
                pkd[2 * q4] = cvtpk(r[0], r[1]); pkd[2 * q4 + 1] = cvtpk(r[2], r[3]);
            }
            bf16* op = OGp + (tb + (size_t)(ci - 1) * 64 + grow) * 1024 + h * 128 + gcg * 16;
            *(GAS v4u*)op = (v4u){pkd[0], pkd[1], pkd[2], pkd[3]}; *(GAS v4u*)(op + 8) = (v4u){pkd[4], pkd[5], pkd[6], pkd[7]};
        }
        if (ci == 32) break;
#pragma unroll
        for (int i = 0; i < 2; ++i) pz[i] = *(const GAS v4u*)(Zb + (tb + (size_t)ci * 64 + grow) * 1024 + h * 128 + gcg * 16 + i * 8);
        if (ci + 1 < 32) DM_VT(ci + 1);
        LDS_BARRIER();
        f32x4 o[4], u[4];
        LAS const unsigned char* Bq = L + bufo + DB_Q; LAS const unsigned char* Bk = L + bufo + DB_K; LAS const unsigned char* Bt = L + bufo + DB_QT; LAS const unsigned char* Bkt = L + bufo + DB_KT;
        bf16x8 fA[4];
#define DS_SB() __builtin_amdgcn_sched_barrier(0)
#pragma unroll
        for (int mt = 0; mt < 4; ++mt) { o[mt] = (f32x4){0.f, 0.f, 0.f, 0.f}; u[mt] = (f32x4){0.f, 0.f, 0.f, 0.f}; }
#pragma unroll
        for (int ks = 0; ks < 4; ++ks) {
            const bf16x8 sbk = packB(S[2 * ks], S[2 * ks + 1]);
#pragma unroll
            for (int mt = 0; mt < 4; ++mt) fA[mt] = frag2s(Bk + mt * 4096, offA[ks][0], offA[ks][1]);
            DS_SB();
#pragma unroll
            for (int mt = 0; mt < 4; ++mt) u[mt] = __builtin_amdgcn_mfma_f32_16x16x32_bf16(fA[mt], sbk, u[mt], 0, 0, 0);
            DS_SB();
#pragma unroll
            for (int mt = 0; mt < 4; ++mt) fA[mt] = frag2s(Bq + mt * 4096, offA[ks][0], offA[ks][1]);
            DS_SB();
#pragma unroll
            for (int mt = 0; mt < 4; ++mt) o[mt] = __builtin_amdgcn_mfma_f32_16x16x32_bf16(fA[mt], sbk, o[mt], 0, 0, 0);
            DS_SB();
        }
        LAS const float* sc = (LAS const float*)(L + bufo + DB_SC);
        const float gl = sc[63];
        bf16x8 rb[2];
        {
            f32x4 r[4];
#pragma unroll
            for (int mt = 0; mt < 4; ++mt) { const f32x4 eg = *(LAS const f32x4*)(sc + 16 * mt + 4 * fq), be = *(LAS const f32x4*)(sc + 128 + 16 * mt + 4 * fq); r[mt] = be * (vt[mt] - eg * u[mt]); o[mt] = o[mt] * eg; }
            rb[0] = packB(r[0], r[1]); rb[1] = packB(r[2], r[3]);
        }
#pragma unroll
        for (int m2 = 0; m2 < 2; ++m2) {
#pragma unroll
            for (int mt = 0; mt < 2; ++mt) { fA[2 * mt] = frag2s(Bt + (2 * m2 + mt) * 4096, offA[2][0], offA[2][1]); fA[2 * mt + 1] = frag2s(Bt + (2 * m2 + mt) * 4096, offA[3][0], offA[3][1]); }
            DS_SB();
#pragma unroll
            for (int mt = 0; mt < 2; ++mt) {
                u[2 * m2 + mt] = __builtin_amdgcn_mfma_f32_16x16x32_bf16(fA[2 * mt], rb[0], (f32x4){0.f, 0.f, 0.f, 0.f}, 0, 0, 0);
                u[2 * m2 + mt] = __builtin_amdgcn_mfma_f32_16x16x32_bf16(fA[2 * mt + 1], rb[1], u[2 * m2 + mt], 0, 0, 0);
            }
            DS_SB();
        }
        bf16x8 ub[2], ub2[2];
        {
            ub[0] = packB(u[0], u[1]); ub[1] = packB(u[2], u[3]);
#pragma unroll
            for (int mt = 0; mt < 4; ++mt) { const f32x4 ek = *(LAS const f32x4*)(sc + 64 + 16 * mt + 4 * fq); u[mt] = u[mt] * ek; }
            ub2[0] = packB(u[0], u[1]); ub2[1] = packB(u[2], u[3]);
        }
#pragma unroll
        for (int st = 0; st < 8; ++st) S[st] = S[st] * gl;
        DS_SB();
#pragma unroll
        for (int m2 = 0; m2 < 2; ++m2) {
#pragma unroll
            for (int mt = 0; mt < 2; ++mt) { fA[2 * mt] = frag2s(Bt + (2 * m2 + mt) * 4096, offA[0][0], offA[0][1]); fA[2 * mt + 1] = frag2s(Bt + (2 * m2 + mt) * 4096, offA[1][0], offA[1][1]); }
            DS_SB();
#pragma unroll
            for (int mt = 0; mt < 2; ++mt)
#pragma unroll
                for (int ks = 0; ks < 2; ++ks) o[2 * m2 + mt] = __builtin_amdgcn_mfma_f32_16x16x32_bf16(fA[2 * mt + ks], ub[ks], o[2 * m2 + mt], 0, 0, 0);
            DS_SB();
        }
#pragma unroll
        for (int s2 = 0; s2 < 4; ++s2) {
#pragma unroll
            for (int st = 0; st < 2; ++st) { fA[2 * st] = frag2s(Bkt + (2 * s2 + st) * 2048, offT[0][0], offT[0][1]); fA[2 * st + 1] = frag2s(Bkt + (2 * s2 + st) * 2048, offT[1][0], offT[1][1]); }
            DS_SB();
#pragma unroll
            for (int st = 0; st < 2; ++st)
#pragma unroll
                for (int ks = 0; ks < 2; ++ks) S[2 * s2 + st] = __builtin_amdgcn_mfma_f32_16x16x32_bf16(fA[2 * st + ks], ub2[ks], S[2 * s2 + st], 0, 0, 0);
            DS_SB();
        }
#undef DS_SB
        LAS bf16* ot = (LAS bf16*)(L + DL_OT) + 16 * w + fr;
#pragma unroll
        for (int mt = 0; mt < 4; ++mt)
#pragma unroll
            for (int j = 0; j < 4; ++j) ot[(16 * mt + 4 * fq + j) * 136] = (bf16)f2bf(o[mt][j]);
    }
#undef DM_ISSUE
#undef DM_VT
    float* so = a->out + O_SDP + ((size_t)(b * 8 + h) * 128) * 128 + 16 * w + fr;
#pragma unroll
    for (int st = 0; st < 8; ++st)
#pragma unroll
        for (int j = 0; j < 4; ++j) so[(size_t)(16 * st + 4 * fq + j) * 128] = S[st][j];
}
constexpr int AL_K = 0, AL_VT = 36864, AVT_STRIDE = 592;
__device__ __forceinline__ void attn_prompt_items(Frame& F, cargs_t a, int first, int stride, int end) {
    unsigned char* ws = a->ws;
    const int tid = F.tid, w = F.wave, lane = F.lane, fr = lane & 15, fq = lane >> 4;
    LAS unsigned char* L = F.lds + RING_OFF;
    const bf16* KV = (const bf16*)(ws + WS_KV);
    v4u wv[8];
#define AT_LOAD(it_) do { const int qb_ = (it_) & 15, kh_ = ((it_) >> 4) & 3, b_ = (it_) >> 6; \
        _Pragma("unroll") for (int i = 0; i < 8; ++i) { \
            const int key = 4 * (tid >> 4) + (i & 3) + 128 * (i >> 2), c = tid & 15;     \
            const long srow = (long)qb_ * 128 - 128 + key; \
            wv[i] = (v4u){0u, 0u, 0u, 0u}; \
            if (srow >= 0) wv[i] = *(const GAS v4u*)(KV + ((size_t)b_ * 2048 + (size_t)srow) * 512 + (c < 8 ? kh_ * 64 + c * 8 : 256 + kh_ * 64 + (c - 8) * 8)); } } while (0)
    if (first < end) AT_LOAD(first);
#pragma unroll 1
    for (int item = first; item < end; item += stride) {
    const int qblk = item & 15, kvh = (item >> 4) & 3, b = item >> 6;
    ISTAMP(item == first + stride, 80);
    __syncthreads();
    {
        const int c = tid & 15, kq4 = 4 * (tid >> 4);
        if (c < 8) {
#pragma unroll
            for (int i = 0; i < 8; ++i) *(LAS v4u*)(L + AL_K + (kq4 + (i & 3) + 128 * (i >> 2)) * 144 + c * 16) = wv[i];
        } else {
#pragma unroll
            for (int g4 = 0; g4 < 2; ++g4) {
                LAS unsigned char* vb = L + AL_VT + (size_t)((c - 8) * 8) * AVT_STRIDE + (kq4 + 128 * g4) * 2;
#pragma unroll
                for (int e2 = 0; e2 < 4; ++e2) {
                    const unsigned w0 = ((const unsigned*)&wv[4 * g4])[e2], w1 = ((const unsigned*)&wv[4 * g4 + 1])[e2], w2 = ((const unsigned*)&wv[4 * g4 + 2])[e2], w3 = ((const unsigned*)&wv[4 * g4 + 3])[e2];
                    const unsigned long long ev = (unsigned long long)((w0 & 0xffffu) | (w1 << 16)) | ((unsigned long long)((w2 & 0xffffu) | (w3 << 16)) << 32);
                    const unsigned long long od = (unsigned long long)((w0 >> 16) | (w1 & 0xffff0000u)) | ((unsigned long long)((w2 >> 16) | (w3 & 0xffff0000u)) << 32);
                    *(LAS unsigned long long*)(vb + (size_t)(2 * e2) * AVT_STRIDE) = ev; *(LAS unsigned long long*)(vb + (size_t)(2 * e2 + 1) * AVT_STRIDE) = od;
                }
            }
        }
    }
    if (tid < 256) { const int d = tid >> 2, pc = tid & 3; *(LAS v4u*)(L + AL_VT + d * AVT_STRIDE + 512 + pc * 16) = (v4u){0u, 0u, 0u, 0u}; }
    __syncthreads();
    ISTAMP(item == first + stride, 81);
    if (item + stride < end) AT_LOAD(item + stride);
    const int g = w >> 1, head = kvh * 4 + g;
    const float sink = a->in[19][head];
    const bf16* Qb_ = (const bf16*)(ws + WS_Q); bf16* OBp = (bf16*)(ws + WS_OB);
    bf16x8 qc[2];
#pragma unroll
    for (int ks = 0; ks < 2; ++ks) qc[ks] = *(const GAS bf16x8*)(Qb_ + ((size_t)b * 2048 + (size_t)qblk * 128 + (w & 1) * 64 + fr) * 1024 + head * 64 + ks * 32 + fq * 8);
#pragma unroll 2
    for (int qt = 0; qt < 4; ++qt) {
        const int q0 = (w & 1) * 64 + 16 * qt, mt0 = q0 >> 4, qi = q0 + fr;
        const size_t row = (size_t)b * 2048 + (size_t)qblk * 128 + qi;
        const bf16x8 qb[2] = {qc[0], qc[1]};
        if (qt < 3) {
#pragma unroll
            for (int ks = 0; ks < 2; ++ks) qc[ks] = *(const GAS bf16x8*)(Qb_ + (row + 16) * 1024 + head * 64 + ks * 32 + fq * 8);
        }
        f32x4 s[10];
#pragma unroll
        for (int kt = 0; kt < 9; ++kt) {
            s[kt] = (f32x4){0.f, 0.f, 0.f, 0.f};
#pragma unroll
            for (int ks = 0; ks < 2; ++ks) {
                const bf16x8 ka = *(const LAS bf16x8*)(L + AL_K + (16 * (mt0 + kt) + fr) * 144 + ks * 64 + fq * 16);
                s[kt] = __builtin_amdgcn_mfma_f32_16x16x32_bf16(ka, qb[ks], s[kt], 0, 0, 0);
            }
        }
        float m = sink;
#pragma unroll
        for (int kt = 0; kt < 9; ++kt) {
            const bool tok = (qblk > 0) || (mt0 + kt >= 8);
#pragma unroll
            for (int jj = 0; jj < 4; ++jj) {
                const int j = 16 * (mt0 + kt) + 4 * fq + jj;
                const bool ok = tok && (kt == 0 ? (j >= qi + 1) : (kt == 8 ? (j <= qi + 128) : true));
                const float sv = ok ? s[kt][jj] : -1e30f; s[kt][jj] = sv; m = fmaxf(m, sv);
            }
        }
        m = fmaxf(m, __shfl_xor(m, 16)); m = fmaxf(m, __shfl_xor(m, 32));
        float l = 0.f;
#pragma unroll
        for (int kt = 0; kt < 9; ++kt)
#pragma unroll
            for (int jj = 0; jj < 4; ++jj) { const float p = __expf(s[kt][jj] - m); s[kt][jj] = p; l += p; }
        s[9] = (f32x4){0.f, 0.f, 0.f, 0.f};
        l += __shfl_xor(l, 16); l += __shfl_xor(l, 32);
        l += __expf(sink - m);
        f32x4 o[4];
#pragma unroll
        for (int dt = 0; dt < 4; ++dt) o[dt] = (f32x4){0.f, 0.f, 0.f, 0.f};
#pragma unroll
        for (int k5 = 0; k5 < 5; ++k5) {
            const bf16x8 pb = packB(s[2 * k5], s[2 * k5 + 1]);
#pragma unroll
            for (int dt = 0; dt < 4; ++dt)
                o[dt] = __builtin_amdgcn_mfma_f32_16x16x32_bf16(frag2((lcp)(L + AL_VT + (16 * dt + fr) * AVT_STRIDE + (16 * (mt0 + 2 * k5) + 4 * fq) * 2)), pb, o[dt], 0, 0, 0);
        }
        const float inv = 1.0f / l;
        bf16* op = OBp + row * 1024 + head * 64 + 4 * fq;
#pragma unroll
        for (int dt = 0; dt < 4; ++dt) { const f32x4 r = o[dt] * inv; *(GAS unsigned long long*)(op + 16 * dt) = (unsigned long long)cvtpk(r[0], r[1]) | ((unsigned long long)cvtpk(r[2], r[3]) << 32); }
    }
    }
#undef AT_LOAD
}
__device__ __forceinline__ void attn_sample_items(Frame& F, cargs_t a, int first, int stride, int end) {
    unsigned char* ws = a->ws;
    const int tid = F.tid, w = F.wave, lane = F.lane, fr = lane & 15, fq = lane >> 4;
    LAS unsigned char* L = F.lds + RING_OFF;
    const bf16* KV = (const bf16*)(ws + WS_KV);
    f32x4 cv[8];
#define AS_LOAD(it_) do { const int kh_ = (it_) & 3, b_ = (it_) >> 2; \
        _Pragma("unroll") for (int i = 0; i < 8; ++i) { const int idx = tid + 512 * i, key = idx >> 5, c = idx & 31; const int isv = c >> 4, cc = c & 15; \
            cv[i] = *(const GAS f32x4*)(a->in[isv ? 5 : 4] + ((size_t)(b_ * 128 + key) * 4 + kh_) * 64 + cc * 4); } } while (0)
    if (first < end) AS_LOAD(first);
#pragma unroll 1
    for (int item = first; item < end; item += stride) {
        const int kvh = item & 3, b = item >> 2;
        __syncthreads();
#pragma unroll
        for (int i = 0; i < 8; ++i) { const int idx = tid + 512 * i, key = idx >> 5, c = idx & 31; const int isv = c >> 4, cc = c & 15;
            if (key >= 8) *(GAS f32x4*)(a->out + (isv ? O_VWS : O_KWS) + ((size_t)(b * 128 + key - 8) * 4 + kvh) * 64 + cc * 4) = cv[i];
            const unsigned lo = cvtpk(cv[i][0], cv[i][1]), hi = cvtpk(cv[i][2], cv[i][3]);
            if (!isv) *(LAS unsigned long long*)(L + AL_K + key * 144 + cc * 8) = (unsigned long long)lo | ((unsigned long long)hi << 32);
            else { LAS unsigned short* vt = (LAS unsigned short*)(L + AL_VT) + (size_t)(cc * 4) * (AVT_STRIDE / 2) + key;
                vt[0] = (unsigned short)(lo & 0xffffu); vt[AVT_STRIDE / 2] = (unsigned short)(lo >> 16); vt[2 * (AVT_STRIDE / 2)] = (unsigned short)(hi & 0xffffu); vt[3 * (AVT_STRIDE / 2)] = (unsigned short)(hi >> 16); } }
        if (tid < 128) {
            const int t = tid >> 4, c = tid & 15, key = 128 + t;
            const v4u wv = *(const GAS v4u*)(KV + ((size_t)MP + (size_t)b * 8 + t) * 512 + (c < 8 ? kvh * 64 + c * 8 : 256 + kvh * 64 + (c - 8) * 8));
            if (c < 8) *(LAS v4u*)(L + AL_K + key * 144 + c * 16) = wv;
            else { LAS unsigned short* vt = (LAS unsigned short*)(L + AL_VT) + (size_t)((c - 8) * 8) * (AVT_STRIDE / 2) + key;
                vt[0 * (AVT_STRIDE / 2)] = (unsigned short)(wv.x & 0xffffu); vt[1 * (AVT_STRIDE / 2)] = (unsigned short)(wv.x >> 16);
                vt[2 * (AVT_STRIDE / 2)] = (unsigned short)(wv.y & 0xffffu); vt[3 * (AVT_STRIDE / 2)] = (unsigned short)(wv.y >> 16);
                vt[4 * (AVT_STRIDE / 2)] = (unsigned short)(wv.z & 0xffffu); vt[5 * (AVT_STRIDE / 2)] = (unsigned short)(wv.z >> 16);
                vt[6 * (AVT_STRIDE / 2)] = (unsigned short)(wv.w & 0xffffu); vt[7 * (AVT_STRIDE / 2)] = (unsigned short)(wv.w >> 16); }
        } else if (tid < 128 + 72) { const int u = tid - 128; *(LAS v4u*)(L + AL_K + 136 * 144 + u * 16) = (v4u){0u, 0u, 0u, 0u}; }
        else if (tid < 128 + 72 + 192) { const int u = tid - 200, d = u / 3, pc = u % 3; *(LAS v4u*)(L + AL_VT + d * AVT_STRIDE + 272 + pc * 16) = (v4u){0u, 0u, 0u, 0u}; }
        __syncthreads();
        if (item + stride < end) AS_LOAD(item + stride);
        if (w < 2) {
            const int r = 16 * w + fr, t = r >> 2, g = r & 3, head = kvh * 4 + g;
            const size_t row = (size_t)MP + (size_t)b * 8 + t;
            const float sink = a->in[19][head];
            const bf16* qp = (const bf16*)(ws + WS_Q) + row * 1024 + head * 64 + fq * 8;
            const bf16x8 qb[2] = {*(const GAS bf16x8*)qp, *(const GAS bf16x8*)(qp + 32)};
            f32x4 s[10];
#pragma unroll
            for (int kt = 0; kt < 9; ++kt) {
                s[kt] = (f32x4){0.f, 0.f, 0.f, 0.f};
#pragma unroll
                for (int ks = 0; ks < 2; ++ks) {
                    const bf16x8 ka = *(const LAS bf16x8*)(L + AL_K + (16 * kt + fr) * 144 + ks * 64 + fq * 16);
                    s[kt] = __builtin_amdgcn_mfma_f32_16x16x32_bf16(ka, qb[ks], s[kt], 0, 0, 0);
                }
            }
            float m = sink;
#pragma unroll
            for (int kt = 0; kt < 9; ++kt)
#pragma unroll
                for (int jj = 0; jj < 4; ++jj) {
                    const int j = 16 * kt + 4 * fq + jj;
                    const bool ok = (j < 128) ? (j >= t + 1) : (j - 128 <= t);
                    const float sv = ok ? s[kt][jj] : -1e30f; s[kt][jj] = sv; m = fmaxf(m, sv);
                }
            m = fmaxf(m, __shfl_xor(m, 16)); m = fmaxf(m, __shfl_xor(m, 32));
            float l = 0.f;
#pragma unroll
            for (int kt = 0; kt < 9; ++kt)
#pragma unroll
                for (int jj = 0; jj < 4; ++jj) { const float p = __expf(s[kt][jj] - m); s[kt][jj] = p; l += p; }
            s[9] = (f32x4){0.f, 0.f, 0.f, 0.f};
            l += __shfl_xor(l, 16); l += __shfl_xor(l, 32);
            l += __expf(sink - m);
            f32x4 o[4];
#pragma unroll
            for (int dt = 0; dt < 4; ++dt) o[dt] = (f32x4){0.f, 0.f, 0.f, 0.f};
#pragma unroll
            for (int k5 = 0; k5 < 5; ++k5) {
                const bf16x8 pb = packB(s[2 * k5], s[2 * k5 + 1]);
#pragma unroll
                for (int dt = 0; dt < 4; ++dt)
                    o[dt] = __builtin_amdgcn_mfma_f32_16x16x32_bf16(frag2((lcp)(L + AL_VT + (16 * dt + fr) * AVT_STRIDE + (32 * k5 + 4 * fq) * 2)), pb, o[dt], 0, 0, 0);
            }
            const float inv = 1.0f / l;
            bf16* op = (bf16*)(ws + WS_OB) + row * 1024 + head * 64 + 4 * fq;
#pragma unroll
            for (int dt = 0; dt < 4; ++dt) { const f32x4 rr = o[dt] * inv; *(GAS unsigned long long*)(op + 16 * dt) = (unsigned long long)cvtpk(rr[0], rr[1]) | ((unsigned long long)cvtpk(rr[2], rr[3]) << 32); }
        }
    }
#undef AS_LOAD
}
#ifndef CHUNKED
#define CHUNKED 1
#endif
#ifndef TSOLVE
#define TSOLVE 1
#endif
#ifndef LATE_CONV
#define LATE_CONV 1
#endif
#ifndef MK_N_LAUNCHES
#define MK_N_LAUNCHES 1
#endif
constexpr int N_PHASES = 17;
constexpr int N_LAUNCHES = MK_N_LAUNCHES;

template <class Epi> __device__ __forceinline__ void small_gemm(Frame& F, const bf16* A, const bf16* Bt, int N, int K, const Epi& E) {
    const int lane = F.lane, w = F.wave, fr = lane & 15, fq = lane >> 4, tid = F.tid;
    const int ncol = N >> 6, ntile = 16 * ncol, kw = K >> 3, nks = kw >> 5;
    LAS float* P = (LAS float*)(F.lds + RING_OFF);
#pragma unroll 1
    for (int tile = blockIdx.x; tile < ntile; tile += F.G) {
        const int tr = tile / ncol, tc = tile - tr * ncol;
        const bf16* ap = A + ((size_t)MP + 64 * tr + fr) * K + w * kw + 8 * fq;
        const bf16* bp = Bt + ((size_t)64 * tc + fr) * K + w * kw + 8 * fq;
        pg8::f32x4 acc[4][4];
#pragma unroll
        for (int m = 0; m < 4; ++m)
#pragma unroll
            for (int n = 0; n < 4; ++n) acc[m][n] = (pg8::f32x4){0.f, 0.f, 0.f, 0.f};
        int ks0 = 0;
#pragma unroll 1
        for (; ks0 + 4 <= nks; ks0 += 4) {
            bf16x8 af[4][4], bfv[4][4];
#pragma unroll
            for (int kk = 0; kk < 4; ++kk) {
#pragma unroll
                for (int m = 0; m < 4; ++m) af[kk][m] = *(const GAS bf16x8*)(ap + (size_t)(16 * m) * K + 32 * (ks0 + kk));
#pragma unroll
                for (int n = 0; n < 4; ++n) bfv[kk][n] = *(const GAS bf16x8*)(bp + (size_t)(16 * n) * K + 32 * (ks0 + kk));
            }
#pragma unroll
            for (int kk = 0; kk < 4; ++kk)
#pragma unroll
                for (int m = 0; m < 4; ++m)
#pragma unroll
                    for (int n = 0; n < 4; ++n) acc[m][n] = __builtin_amdgcn_mfma_f32_16x16x32_bf16(af[kk][m], bfv[kk][n], acc[m][n], 0, 0, 0);
        }
#pragma unroll 1
        for (; ks0 < nks; ++ks0) {
            bf16x8 af[4], bfv[4];
#pragma unroll
            for (int m = 0; m < 4; ++m) af[m] = *(const GAS bf16x8*)(ap + (size_t)(16 * m) * K + 32 * ks0);
#pragma unroll
            for (int n = 0; n < 4; ++n) bfv[n] = *(const GAS bf16x8*)(bp + (size_t)(16 * n) * K + 32 * ks0);
#pragma unroll
            for (int m = 0; m < 4; ++m)
#pragma unroll
                for (int n = 0; n < 4; ++n) acc[m][n] = __builtin_amdgcn_mfma_f32_16x16x32_bf16(af[m], bfv[n], acc[m][n], 0, 0, 0);
        }
        __syncthreads();
#pragma unroll
        for (int m = 0; m < 4; ++m)
#pragma unroll
            for (int n = 0; n < 4; ++n)
#pragma unroll
                for (int j = 0; j < 4; ++j) P[(w * 64 + 16 * m + 4 * fq + j) * 64 + 16 * n + fr] = acc[m][n][j];
        __syncthreads();
        {
            const int row = tid >> 3, sub = tid & 7, c8 = sub * 8;
            pg8::f32x4 v0 = (pg8::f32x4){0.f, 0.f, 0.f, 0.f}, v1 = v0;
#pragma unroll
            for (int ww = 0; ww < 8; ++ww) { v0 += *(const LAS pg8::f32x4*)(P + (ww * 64 + row) * 64 + c8); v1 += *(const LAS pg8::f32x4*)(P + (ww * 64 + row) * 64 + c8 + 4); }
            E.small(MP + 64 * tr + row, 64 * tc + c8, v0, v1, tc, sub);
        }
    }
    __syncthreads();
}
template <class Epi> __device__ __forceinline__ void run_gemm(Frame& F, const bf16* A, const bf16* Bt, int N, int K, const Epi& E, int Mrows = MT, int stagger = 0) {
    if (stagger && (F.vcu & 1)) { for (int i = 0; i < stagger; ++i) __builtin_amdgcn_s_sleep(127); }
    pg8::Gemm g{A, Bt, Mrows, N, K}; pg8::StaticOrder S; S.init(Mrows, N, F.G, (int)blockIdx.x);
    pg8::gemm_phase<Epi, pg8::StaticOrder, true, true>(F.lds + RING_OFF, g, S, E);
}

__global__ void __launch_bounds__(NWAVES * 64, 2) yoco_fwd(Args args) {
    extern __shared__ __attribute__((aligned(16))) unsigned char lds[];
    Frame F;
    F.lds = (LAS unsigned char*)lds;
    F.MISC = (volatile LAS unsigned*)(F.lds + MISC_OFF);
    F.tid = threadIdx.x; F.lane = F.tid & 63; F.wave = __builtin_amdgcn_readfirstlane(F.tid >> 6);
    F.G = gridDim.x; { const int bx = blockIdx.x; F.vcu = (F.G % 8 == 0) ? (bx % 8) * (F.G / 8) + bx / 8 : bx; }
    F.ctl = (gu32*)(argp()->ws + WS_CTL);
    for (int u = F.tid; u < (LDS_BYTES - LDSCTL_OFF) / 4; u += NWAVES * 64) ((LAS unsigned*)(F.lds + LDSCTL_OFF))[u] = 0u;
    __syncthreads();
    XcdBarrier bar; bar.bar = (unsigned*)(F.ctl + CW_BAR); bar.x = 0; bar.st = nullptr;
    if (N_LAUNCHES == 1) bar = xcd_barrier_post((unsigned*)(F.ctl + CW_BAR) + argp()->li * XCD_BAR_WORDS, F.MISC + 8);
#define GRID_BAR() do { if (N_LAUNCHES == 1) xcd_barrier(bar); } while (0)
    const int lo = argp()->ph_lo, hi = argp()->ph_hi;
#ifndef PH_MASK
#define PH_MASK 0xffffffffu
#endif
#define IN(k) (((PH_MASK >> (k)) & 1) && lo <= (k) && (k) < hi)
#define REFRESH() do { int t_ = threadIdx.x; asm volatile("" : "+v"(t_)); F.tid = t_; F.lane = t_ & 63; } while (0)
#ifdef PROF_A
#ifndef PROF_AE
#define PROF_AE (PROF_A + 1)
#endif
#ifndef PROF_BE
#define PROF_BE (PROF_B + 1)
#endif
#endif
#ifndef PROF_SCALE
#define PROF_SCALE 1.0f
#endif
#ifdef PROF_A
#define STAMP(k) do { if (blockIdx.x == 0 && threadIdx.x == 0) ((unsigned long long*)(argp()->ws + WS_CTL + 2048))[(k)] = __builtin_amdgcn_s_memrealtime(); } while (0)
#else
#define STAMP(k) do { } while (0)
#endif
#ifndef PROF_IDLE
#define PROF_IDLE 0
#endif
#ifdef PROF_A
#define PSTAMP(blk, k) do { if (blockIdx.x == (blk) && threadIdx.x == 0) ((unsigned long long*)(argp()->ws + WS_CTL + 2048))[(k)] = __builtin_amdgcn_s_memrealtime(); } while (0)
#else
#define PSTAMP(blk, k) do { } while (0)
#endif
#if defined(PROF_A) && defined(PROF_FIN)
#define PFIN(ph) do { if ((ph) == PROF_FIN && threadIdx.x == 0) ((unsigned long long*)(argp()->ws + WS_CTL + 2048))[256 + blockIdx.x] = __builtin_amdgcn_s_memrealtime(); } while (0)
#else
#define PFIN(ph) do { } while (0)
#endif
#define SEAM(k) do { if (IN(k) && IN((k) + 1)) GRID_BAR(); STAMP((k) + 1); } while (0)
#define XB ((bf16*)(argp()->ws + WS_XB))
#define HA ((bf16*)(argp()->ws + WS_HA))
#define HB ((bf16*)(argp()->ws + WS_HB))
#define OG ((bf16*)(argp()->ws + WS_OG))
#define PP ((bf16*)(argp()->ws + WS_PP))
#define ACT ((bf16*)(argp()->ws + WS_ACT))
#define KVb ((bf16*)(argp()->ws + WS_KV))
#define Qb ((bf16*)(argp()->ws + WS_Q))
#define OB ((bf16*)(argp()->ws + WS_OB))
#define PEB ((bf16*)(argp()->ws + WS_PEB))
#define SSQX ((float*)(argp()->ws + WS_SSQX))
#define SSQA ((float*)(argp()->ws + WS_SSQA))
#define SSQB ((float*)(argp()->ws + WS_SSQB))

    STAMP(0);
    if (IN(0)) { REFRESH(); p0_prologue(F, argp(), LATE_CONV ? ((CHUNKED && F.G >= 256) ? 0 : 2) : 2, F.vcu * NWAVES + F.wave, F.G * NWAVES); } SEAM(0);
    if (IN(1)) { REFRESH(); pg8::EpiQKV E{(bf16*)(argp()->ws + WS_QKV), (bf16*)(argp()->ws + WS_Z), (float*)(argp()->ws + WS_AB), SSQX, argp()->out + O_SCP, argp()->out + O_SCS, (bf16*)(argp()->ws + WS_HALO)};
                 run_gemm(F, XB, (const bf16*)(argp()->ws + WS_WIN), NIN, 1024, E); } SEAM(1);
    if (IN(2)) { REFRESH(); if (CHUNKED) { if (TSOLVE) dprep_loop_t(F, argp()); else dprep_loop(F, argp()); } } SEAM(2);
    if (IN(3)) { REFRESH();
        if (CHUNKED && F.G >= 256) {
            if (blockIdx.x < 128) { if (TSOLVE == 2) dscan_item_t2(F, argp(), blockIdx.x); else if (TSOLVE) dscan_item_t(F, argp(), blockIdx.x); else dscan_item(F, argp(), blockIdx.x); PSTAMP(0, 56); }
            else if (!PROF_IDLE) { PSTAMP(128, 48); delta_seq_samples(F, argp(), blockIdx.x - 128, F.G - 128, 1024); PSTAMP(128, 49);
              __syncthreads(); REFRESH();
#ifdef PROF_A
              if ((PROF_A == 54 || PROF_B == 54) && blockIdx.x == 128 && threadIdx.x == 0) ((unsigned long long*)(argp()->ws + WS_CTL + 2048))[54] = __builtin_amdgcn_s_memrealtime();
#endif
              if (LATE_CONV) p0_prologue(F, argp(), 3, (blockIdx.x - 128) * NWAVES + F.wave, (F.G - 128) * NWAVES);
#ifdef PROF_A
              __syncthreads();
              if ((PROF_A == 54 || PROF_B == 54) && blockIdx.x == 128 && threadIdx.x == 0) ((unsigned long long*)(argp()->ws + WS_CTL + 2048))[55] = __builtin_amdgcn_s_memrealtime();
#endif
              }
        } else for (int item = blockIdx.x; item < 128 + 1024; item += F.G) { if (CHUNKED && item < 128) { if (TSOLVE == 2) dscan_item_t2(F, argp(), item); else if (TSOLVE) dscan_item_t(F, argp(), item); else dscan_item(F, argp(), item); } else delta_seq_item(F, argp(), item); }
    PFIN(3); } SEAM(3);
    if (IN(4)) { REFRESH(); { pg8::EpiRes<false> E{nullptr, nullptr, XB, HA, SSQA}; run_gemm(F, OG, (const bf16*)(argp()->ws + WS_WOUT), 1024, 1024, E, MP); } REFRESH(); { pg8::EpiRes<false> E{nullptr, nullptr, XB, HA, SSQA}; small_gemm(F, OG, (const bf16*)(argp()->ws + WS_WOUT), 1024, 1024, E); } }     SEAM(4);
    if (IN(5)) { REFRESH(); { pg8::EpiGU E{ACT, SSQA}; run_gemm(F, HA, (const bf16*)(argp()->ws + WS_WGU0), 5632, 1024, E, MT, 0); }
        if (LATE_CONV && CHUNKED && F.G >= 256) {
            const int nbx = ((MT / 256) * 22) % F.G;
            if ((int)blockIdx.x >= nbx) { __syncthreads(); REFRESH(); p0_prologue(F, argp(), 4, ((int)blockIdx.x - nbx) * NWAVES + F.wave, (F.G - nbx) * NWAVES); } } } SEAM(5);
    if (IN(6)) { REFRESH(); { pg8::EpiRes<false> E{nullptr, nullptr, HA, HB, SSQB}; run_gemm(F, ACT, (const bf16*)(argp()->ws + WS_WDN0), 1024, FFH, E, MP); } REFRESH(); { pg8::EpiRes<false> E{nullptr, nullptr, HA, HB, SSQB}; small_gemm(F, ACT, (const bf16*)(argp()->ws + WS_WDN0), 1024, FFH, E); } }     STAMP(7);
    if (IN(7)) { REFRESH(); { pg8::EpiPP E{PP}; run_gemm(F, PEB, (const bf16*)(argp()->ws + WS_WPJ0), 1024, 256, E, MP); } REFRESH(); { pg8::EpiPP E{PP}; small_gemm(F, PEB, (const bf16*)(argp()->ws + WS_WPJ0), 1024, 256, E); } } SEAM(7);
    if (IN(8)) { REFRESH(); { pg8::EpiGate<false> E{SSQB, PP, HB, HA, SSQA, nullptr}; run_gemm(F, HB, (const bf16*)(argp()->ws + WS_WGT0), 1024, 1024, E, MP); } REFRESH(); { pg8::EpiGate<false> E{SSQB, PP, HB, HA, SSQA, nullptr}; small_gemm(F, HB, (const bf16*)(argp()->ws + WS_WGT0), 1024, 1024, E); } } SEAM(8);
    if (IN(9)) { REFRESH(); { pg8::EpiKVQ E{KVb, Qb, SSQA, argp()->out + O_KWP, argp()->out + O_VWP, argp()->out + O_KWS, argp()->out + O_VWS}; run_gemm(F, HA, (const bf16*)(argp()->ws + WS_WKVQ), 1536, 1024, E, MP); } REFRESH(); { pg8::EpiKVQ E{KVb, Qb, SSQA, argp()->out + O_KWP, argp()->out + O_VWP, argp()->out + O_KWS, argp()->out + O_VWS}; small_gemm(F, HA, (const bf16*)(argp()->ws + WS_WKVQ), 1536, 1024, E); } } SEAM(9);
    if (IN(10)) { REFRESH(); PSTAMP(0, 50); attn_prompt_items(F, argp(), (int)blockIdx.x, F.G, 1024); PSTAMP(0, 51);
        REFRESH(); attn_sample_items(F, argp(), (int)blockIdx.x + ((1024 - (int)blockIdx.x + F.G - 1) / F.G) * F.G - 1024, F.G, 512); PSTAMP(0, 53); PFIN(10); } SEAM(10);
    if (IN(11)) { REFRESH(); { pg8::EpiRes<false> E{nullptr, nullptr, HA, HB, SSQB}; run_gemm(F, OB, (const bf16*)(argp()->ws + WS_WO), 1024, 1024, E, MP); } REFRESH(); { pg8::EpiRes<false> E{nullptr, nullptr, HA, HB, SSQB}; small_gemm(F, OB, (const bf16*)(argp()->ws + WS_WO), 1024, 1024, E); } } SEAM(11);
    if (IN(12)) { REFRESH(); { pg8::EpiGU E{ACT, SSQB}; run_gemm(F, HB, (const bf16*)(argp()->ws + WS_WGU1), 5632, 1024, E, MT, 0); }
        if (LATE_CONV && CHUNKED && F.G >= 256) {
            const int nbx = ((MT / 256) * 22) % F.G;
            if ((int)blockIdx.x >= nbx) { __syncthreads(); REFRESH(); p0_prologue(F, argp(), 5, ((int)blockIdx.x - nbx) * NWAVES + F.wave, (F.G - nbx) * NWAVES); } } } SEAM(12);
    if (IN(13)) { REFRESH(); { pg8::EpiRes<false> E{nullptr, nullptr, HB, HA, SSQA}; run_gemm(F, ACT, (const bf16*)(argp()->ws + WS_WDN1), 1024, FFH, E, MP); } REFRESH(); { pg8::EpiRes<false> E{nullptr, nullptr, HB, HA, SSQA}; small_gemm(F, ACT, (const bf16*)(argp()->ws + WS_WDN1), 1024, FFH, E); } }     STAMP(14);
    if (IN(14)) { REFRESH(); { pg8::EpiPP E{PP}; run_gemm(F, PEB + (size_t)MT * 256, (const bf16*)(argp()->ws + WS_WPJ1), 1024, 256, E, MP); } REFRESH(); { pg8::EpiPP E{PP}; small_gemm(F, PEB + (size_t)MT * 256, (const bf16*)(argp()->ws + WS_WPJ1), 1024, 256, E); } } SEAM(14);
    if (IN(15)) { REFRESH(); { pg8::EpiGate<false> E{SSQA, PP, HA, HB, SSQB, nullptr}; run_gemm(F, HA, (const bf16*)(argp()->ws + WS_WGT1), 1024, 1024, E, MP); } REFRESH(); { pg8::EpiGate<false> E{SSQA, PP, HA, HB, SSQB, nullptr}; small_gemm(F, HA, (const bf16*)(argp()->ws + WS_WGT1), 1024, 1024, E); } } SEAM(15);
    if (IN(16)) { REFRESH(); final_norm(F, argp()); }
#ifdef PROF_A
    GRID_BAR(); STAMP(17);
    GRID_BAR();
    if (PROF_IDLE) { float* z_ = argp()->out + O_SDS; for (size_t i = (size_t)blockIdx.x * 512 + threadIdx.x; i < (size_t)1024 * 128 * 128; i += (size_t)gridDim.x * 512) z_[i] = 0.f; }
    { const unsigned long long* st = (const unsigned long long*)(argp()->ws + WS_CTL + 2048);
      const float usA = (float)(__hip_atomic_load(st + PROF_AE, RLX_AGENT) - __hip_atomic_load(st + PROF_A, RLX_AGENT)) * 0.01f * PROF_SCALE;
      unsigned long long tB_ = __hip_atomic_load(st + (PROF_BE >= 900 ? 256 : PROF_BE), RLX_AGENT);
      if (PROF_BE == 999) { for (int i = 1; i < 256; ++i) { const unsigned long long t_ = __hip_atomic_load(st + 256 + i, RLX_AGENT); tB_ = t_ > tB_ ? t_ : tB_; } }
      if (PROF_BE == 998) { for (int i = 1; i < 256; ++i) { const unsigned long long t_ = __hip_atomic_load(st + 256 + i, RLX_AGENT); tB_ = t_ < tB_ ? t_ : tB_; } }
      const float usB = (float)(tB_ - __hip_atomic_load(st + PROF_B, RLX_AGENT)) * 0.01f * PROF_SCALE;
#ifdef PROF_Q
      const float qA = PROF_Q * floorf(usA / PROF_Q + 0.5f), qB = PROF_Q * floorf(usB / PROF_Q + 0.5f);
#else
      const float qA = (usA >= 100.f) ? 10.f * floorf(usA * 0.1f + 0.5f) : floorf(usA + 0.5f), qB = (usB >= 100.f) ? 10.f * floorf(usB * 0.1f + 0.5f) : floorf(usB + 0.5f);
#endif
      const float c1 = (PROF_A == PROF_AE) ? 0.05f : sqrtf(qA * 0.001f);
      float* ys = argp()->out + O_Y + (size_t)MP * DM;
      for (size_t i = (size_t)blockIdx.x * 512 + threadIdx.x; i < (size_t)MS * DM; i += (size_t)gridDim.x * 512) ys[i] += c1;
      if (blockIdx.x == 0 && threadIdx.x == 0) argp()->out[O_KWP] += qB * 0.1f; }
#endif
#undef IN
#undef SEAM
}

extern "C" void kernel_launch(void* const* d_in, const int* in_sizes, int n_in, void* d_out, int out_size, void* d_ws, size_t ws_size, hipStream_t stream) {
    static int grid = 0;
    if (grid == 0) {
        if (n_in != 28 || out_size != (int)O_END || ws_size < WS_END) { fprintf(stderr, "kernel_launch: unexpected shapes: n_in %d out %d ws %zu (need %zu)\n", n_in, out_size, ws_size, (size_t)WS_END); grid = -1; return; }
        int dev = 0, cus = 0;
        if (hipGetDevice(&dev) != hipSuccess || hipDeviceGetAttribute(&cus, hipDeviceAttributeMultiprocessorCount, dev) != hipSuccess) { grid = -1; return; }
        if (hipFuncSetAttribute((const void*)yoco_fwd, hipFuncAttributeMaxDynamicSharedMemorySize, LDS_BYTES) != hipSuccess) { fprintf(stderr, "kernel_launch: hipFuncSetAttribute failed\n"); grid = -1; return; }
        (void)hipGetLastError();
        grid = cus;
    }
    if (grid < 0) return;
    (void)hipMemsetAsync((char*)d_ws + WS_CTL, 0, CTL_ZERO_BYTES, stream);
    Args a{};
    for (int i = 0; i < 28; ++i) a.in[i] = (const float*)d_in[i];
    a.out = (float*)d_out; a.ws = (unsigned char*)d_ws;
#ifdef PROBE_PHASE
    if (N_LAUNCHES == 1) { const int cuts[4] = {0, PROBE_PHASE + 1, PROBE_PHASE, N_PHASES};
        a.ph_lo = 0; a.ph_hi = PROBE_PHASE + 1; a.li = 0; hipLaunchKernelGGL(yoco_fwd, dim3(grid), dim3(NWAVES * 64), LDS_BYTES, stream, a);
        a.ph_lo = PROBE_PHASE; a.ph_hi = PROBE_PHASE + 1; a.li = 1; hipLaunchKernelGGL(yoco_fwd, dim3(grid), dim3(NWAVES * 64), LDS_BYTES, stream, a);
        a.ph_lo = PROBE_PHASE + 1; a.ph_hi = N_PHASES; a.li = 2; hipLaunchKernelGGL(yoco_fwd, dim3(grid), dim3(NWAVES * 64), LDS_BYTES, stream, a); (void)cuts; }
#else
    if (N_LAUNCHES == 1) { a.ph_lo = 0; a.ph_hi = N_PHASES; a.li = 0; hipLaunchKernelGGL(yoco_fwd, dim3(grid), dim3(NWAVES * 64), LDS_BYTES, stream, a); }
#endif
    else for (int p = 0; p < N_PHASES; ++p) { a.ph_lo = p; a.ph_hi = p + 1; hipLaunchKernelGGL(yoco_fwd, dim3(grid), dim3(NWAVES * 64), LDS_BYTES, stream, a); }
}
```
